# Optimizing an MI355X kernel written in HIP

```python
import math
import jax
import jax.numpy as jnp
from jax import lax
import numpy as np

D_MODEL = 2048
BATCH = 1
SEQ = 8192
DEPTH = 1

CHUNK = 64
Q_BLOCK = 128
DIFF_HEADS = 8
DIFF_HEAD_DIM = 64
DIFF_V_DIM = 2 * DIFF_HEAD_DIM
DIFF_QK_WIDTH = DIFF_HEADS * 2 * DIFF_HEAD_DIM
DIFF_WIDTH = DIFF_HEADS * DIFF_V_DIM
GDN_HEADS = 8
GDN_HEAD_DIM = 128
GDN_WIDTH = GDN_HEADS * GDN_HEAD_DIM
CONV_WIDTH = 4
REL_BUCKETS = 32
REL_MAX_DISTANCE = 128
N_EXPERTS = 64
TOP_K = 8
N_GROUPS = 8
TOPK_GROUPS = 4
EXPERT_FF = 512
SHARED_FF = 512
ROUTED_SCALE = 2.5
EXPERT_BLOCK = 128
DEEPNORM_ALPHA = (2 * DEPTH) ** 0.25
DEEPNORM_BETA = (8 * DEPTH) ** -0.25
LN_EPS = 1e-5
NORM_EPS = 1e-6
IN_SPLIT = (DIFF_QK_WIDTH, DIFF_QK_WIDTH, DIFF_WIDTH,
            GDN_WIDTH, GDN_WIDTH, GDN_WIDTH, GDN_WIDTH, GDN_HEADS, GDN_HEADS,
            D_MODEL, D_MODEL)
IN_WIDTH = sum(IN_SPLIT)

kernel_name = "chunk_causal_hybrid_diffattn_gdn_moe"


def layer_norm(x, g, b):
    xf = x.astype(jnp.float32)
    mu = jnp.mean(xf, axis=-1, keepdims=True)
    var = jnp.mean(jnp.square(xf - mu), axis=-1, keepdims=True)
    y = (xf - mu) * lax.rsqrt(var + LN_EPS) * g.astype(jnp.float32) + b.astype(jnp.float32)
    return y.astype(x.dtype)


def rms_norm(x, w):
    xf = x.astype(jnp.float32)
    y = xf * lax.rsqrt(jnp.mean(jnp.square(xf), axis=-1, keepdims=True) + NORM_EPS) * w.astype(jnp.float32)
    return y.astype(x.dtype)


def l2_normalize(x):
    return x * lax.rsqrt(jnp.sum(jnp.square(x), axis=-1, keepdims=True) + NORM_EPS)


def t5_bucket(rel):
    nb = REL_BUCKETS // 2
    base = jnp.where(rel > 0, nb, 0)
    n = jnp.abs(rel)
    max_exact = nb // 2
    nf = jnp.maximum(n, 1).astype(jnp.float32)
    large = max_exact + (jnp.log(nf / max_exact) / math.log(REL_MAX_DISTANCE / max_exact)
                         * (nb - max_exact)).astype(jnp.int32)
    large = jnp.minimum(large, nb - 1)
    return base + jnp.where(n < max_exact, n, large)


def causal_conv(x, w):
    T = x.shape[1]
    xp = jnp.pad(x, ((0, 0), (CONV_WIDTH - 1, 0), (0, 0)))
    out = xp[:, 0:T] * w[0]
    for j in range(1, CONV_WIDTH):
        out = out + xp[:, j:j + T] * w[j]
    return out


def diff_attention(q, k, v, lam_vecs, subln_w, rel_table, lambda_init):
    B, T, _ = q.shape
    H, dh, dv = DIFF_HEADS, DIFF_HEAD_DIM, DIFF_V_DIM
    q = q.reshape(B, T, H, 2, dh).transpose(3, 0, 2, 1, 4)
    k = k.reshape(B, T, H, 2, dh).transpose(3, 0, 2, 1, 4)
    v = v.reshape(B, T, H, dv).transpose(0, 2, 1, 3)
    lf = lam_vecs.astype(jnp.float32)
    lam = jnp.exp(jnp.sum(lf[0] * lf[1])) - jnp.exp(jnp.sum(lf[2] * lf[3])) + lambda_init
    n_blocks = T // Q_BLOCK
    qb = q.reshape(2, B, H, n_blocks, Q_BLOCK, dh).transpose(3, 0, 1, 2, 4, 5)
    kpos = jnp.arange(T)
    scale = dh ** -0.5

    def block(args):
        qblk, bi = args
        qpos = bi * Q_BLOCK + jnp.arange(Q_BLOCK)
        visible = (kpos[None, :] // CHUNK) <= (qpos[:, None] // CHUNK)
        bias = rel_table[t5_bucket(kpos[None, :] - qpos[:, None])]
        bias = jnp.transpose(bias, (2, 0, 1)).astype(jnp.float32)
        s = jnp.einsum('mbhqd,mbhkd->mbhqk', qblk, k).astype(jnp.float32) * scale + bias
        p = jax.nn.softmax(jnp.where(visible, s, -jnp.inf), axis=-1)
        a = p[0] - lam * p[1]
        return jnp.einsum('bhqk,bhkd->bhqd', a.astype(v.dtype), v)

    o = lax.map(block, (qb, jnp.arange(n_blocks)))
    o = o.transpose(1, 0, 3, 2, 4).reshape(B, T, H, dv)
    o = rms_norm(o, subln_w) * (1.0 - lambda_init)
    return o.reshape(B, T, DIFF_WIDTH)


def gated_delta_chunked(q, k, v, g, beta):
    B, H, T, dk = q.shape
    dv = v.shape[-1]
    C = CHUNK
    N = T // C
    q = q * (dk ** -0.5)
    q = q.reshape(B, H, N, C, dk)
    k = k.reshape(B, H, N, C, dk)
    v = v.reshape(B, H, N, C, dv)
    beta = beta.reshape(B, H, N, C)
    gc = jnp.cumsum(g.reshape(B, H, N, C), axis=-1)
    tri = jnp.tril(jnp.ones((C, C), dtype=bool))
    strict = jnp.tril(jnp.ones((C, C), dtype=bool), -1)
    decay = jnp.exp(jnp.where(tri, gc[..., :, None] - gc[..., None, :], -jnp.inf))
    kb = k * beta[..., None]
    L = jnp.where(strict, jnp.einsum('bhncd,bhnsd->bhncs', kb, k) * decay, 0.0)
    eye = jnp.broadcast_to(jnp.eye(C, dtype=L.dtype), L.shape)
    Tm = lax.linalg.triangular_solve(L + eye, eye, left_side=True, lower=True, unit_diagonal=True)
    u = jnp.einsum('bhncs,bhnsd->bhncd', Tm, v * beta[..., None])
    w = jnp.einsum('bhncs,bhnsd->bhncd', Tm, kb * jnp.exp(gc)[..., None])
    a_qk = jnp.where(tri, jnp.einsum('bhncd,bhnsd->bhncs', q, k) * decay, 0.0)
    q_dec = q * jnp.exp(gc)[..., None]
    k_dec = k * jnp.exp(gc[..., -1:] - gc)[..., None]
    g_last = jnp.exp(gc[..., -1])

    def step(S, inp):
        u_n, w_n, qd_n, aqk_n, kd_n, gl_n = inp
        v_new = u_n - jnp.einsum('bhck,bhkv->bhcv', w_n, S)
        o_n = jnp.einsum('bhck,bhkv->bhcv', qd_n, S) + jnp.einsum('bhcs,bhsv->bhcv', aqk_n, v_new)
        S = S * gl_n[..., None, None] + jnp.einsum('bhck,bhcv->bhkv', kd_n, v_new)
        return S, o_n

    xs = tuple(jnp.moveaxis(t, 2, 0) for t in (u, w, q_dec, a_qk, k_dec, g_last))
    S0 = jnp.zeros((B, H, dk, dv), jnp.float32)
    _, o = lax.scan(step, S0, xs)
    return jnp.moveaxis(o, 0, 2).reshape(B, H, T, dv)


def hybrid_mixer(x, w_in, conv_w, a_log, dt_bias, gdn_norm_w, diff_lambda, diff_subln_w,
                 rel_table, w_branch_a, w_branch_b, w_out, lambda_init):
    B, T, _ = x.shape
    proj = x @ w_in
    points = np.cumsum(IN_SPLIT)[:-1].tolist()
    dq, dk, dvv, gq, gk, gv, gz, ga, gb, gate_a, gate_b = jnp.split(proj, points, axis=-1)
    ya = diff_attention(dq, dk, dvv, diff_lambda, diff_subln_w, rel_table, lambda_init)
    qkv = jax.nn.silu(causal_conv(jnp.concatenate([gq, gk, gv], axis=-1), conv_w))
    gq, gk, gv = jnp.split(qkv, 3, axis=-1)
    heads = lambda t: t.reshape(B, T, GDN_HEADS, GDN_HEAD_DIM).transpose(0, 2, 1, 3).astype(jnp.float32)
    q = l2_normalize(heads(gq))
    k = l2_normalize(heads(gk))
    v = heads(gv)
    beta = jax.nn.sigmoid(gb.astype(jnp.float32)).transpose(0, 2, 1)
    g = (-jnp.exp(a_log.astype(jnp.float32))
         * jax.nn.softplus(ga.astype(jnp.float32) + dt_bias.astype(jnp.float32))).transpose(0, 2, 1)
    o = gated_delta_chunked(q, k, v, g, beta).transpose(0, 2, 1, 3)
    z = gz.reshape(B, T, GDN_HEADS, GDN_HEAD_DIM).astype(jnp.float32)
    o = rms_norm(o, gdn_norm_w) * jax.nn.silu(z)
    yb = o.reshape(B, T, GDN_WIDTH).astype(x.dtype)
    merged = jax.nn.sigmoid(gate_a) * (ya @ w_branch_a) + jax.nn.sigmoid(gate_b) * (yb @ w_branch_b)
    return merged @ w_out


def moe_ffn(x, w_router, router_bias, w_gate, w_up, w_down, ws_gate, ws_up, ws_down):
    B, T, D = x.shape
    n_tok = B * T
    xf = x.reshape(n_tok, D)
    scores = jax.nn.sigmoid(xf.astype(jnp.float32) @ w_router.astype(jnp.float32))
    choice = scores + router_bias.astype(jnp.float32)
    grp = choice.reshape(n_tok, N_GROUPS, N_EXPERTS // N_GROUPS)
    grp_score = lax.top_k(grp, 2)[0].sum(-1)
    _, gidx = lax.top_k(grp_score, TOPK_GROUPS)
    gmask = jax.nn.one_hot(gidx, N_GROUPS, dtype=jnp.float32).sum(1)
    emask = jnp.repeat(gmask, N_EXPERTS // N_GROUPS, axis=-1) > 0
    _, eidx = lax.top_k(jnp.where(emask, choice, -jnp.inf), TOP_K)
    wsel = jnp.take_along_axis(scores, eidx, axis=-1)
    wsel = wsel / jnp.sum(wsel, axis=-1, keepdims=True) * ROUTED_SCALE
    n_assign = n_tok * TOP_K
    n_blocks = -(-n_assign // EXPERT_BLOCK) + N_EXPERTS
    n_rows = n_blocks * EXPERT_BLOCK
    flat_e = eidx.reshape(-1)
    flat_w = wsel.reshape(-1)
    order = jnp.argsort(flat_e)
    sorted_e = flat_e[order]
    counts = jnp.bincount(flat_e, length=N_EXPERTS)
    starts = jnp.cumsum(counts) - counts
    padded = (counts + EXPERT_BLOCK - 1) // EXPERT_BLOCK * EXPERT_BLOCK
    pad_ends = jnp.cumsum(padded)
    pad_starts = pad_ends - padded
    dest = pad_starts[sorted_e] + jnp.arange(n_assign) - starts[sorted_e]
    row_token = jnp.full((n_rows,), n_tok, jnp.int32).at[dest].set((order // TOP_K).astype(jnp.int32))
    row_gate = jnp.zeros((n_rows,), jnp.float32).at[dest].set(flat_w[order])
    block_expert = jnp.minimum(jnp.searchsorted(pad_ends, jnp.arange(n_blocks) * EXPERT_BLOCK, side='right'),
                               N_EXPERTS - 1)
    x_pad = jnp.concatenate([xf, jnp.zeros((1, D), xf.dtype)], axis=0)

    def block(args):
        tok, gate, e = args
        xb = x_pad[tok]
        h = jax.nn.silu(xb @ w_gate[e]) * (xb @ w_up[e])
        return (h @ w_down[e]) * gate[:, None].astype(xb.dtype)

    y = lax.map(block, (row_token.reshape(n_blocks, EXPERT_BLOCK),
                        row_gate.reshape(n_blocks, EXPERT_BLOCK), block_expert))
    routed = jax.ops.segment_sum(y.reshape(n_rows, D), row_token, num_segments=n_tok + 1)[:n_tok]
    shared = (jax.nn.silu(xf @ ws_gate) * (xf @ ws_up)) @ ws_down
    return (routed + shared).reshape(B, T, D)


def setup_inputs(seed: int = 0) -> dict:
    key = jax.random.key(seed)
    ks = jax.random.split(key, 26)
    L, D = DEPTH, D_MODEL
    f32 = jnp.float32
    nrm = lambda k, shape, s: jax.random.normal(k, shape, f32) * s
    x = nrm(ks[0], (BATCH, SEQ, D), 1.0)
    col_scale = jnp.concatenate([
        jnp.ones((2 * DIFF_QK_WIDTH,), f32), jnp.full((DIFF_WIDTH,), DEEPNORM_BETA, f32),
        jnp.ones((2 * GDN_WIDTH,), f32), jnp.full((GDN_WIDTH,), DEEPNORM_BETA, f32),
        jnp.ones((GDN_WIDTH + 2 * GDN_HEADS + 2 * D,), f32)])
    w_in = nrm(ks[1], (L, D, IN_WIDTH), D ** -0.5) * col_scale
    conv_w = nrm(ks[2], (L, CONV_WIDTH, 3 * GDN_WIDTH), CONV_WIDTH ** -0.5)
    gdn_a_log = jnp.log(jax.random.uniform(ks[3], (L, GDN_HEADS), f32, 1.0, 16.0))
    dt = jnp.exp(jax.random.uniform(ks[4], (L, GDN_HEADS), f32, math.log(1e-3), math.log(1e-1)))
    gdn_dt_bias = dt + jnp.log(-jnp.expm1(-dt))
    gdn_norm_w = 1.0 + nrm(ks[5], (L, GDN_HEAD_DIM), 0.02)
    diff_lambda = nrm(ks[6], (L, 4, DIFF_HEAD_DIM), 0.1)
    diff_subln_w = 1.0 + nrm(ks[7], (L, DIFF_V_DIM), 0.02)
    rel_bias_table = nrm(ks[8], (REL_BUCKETS, DIFF_HEADS), 0.5)
    w_branch_a = nrm(ks[9], (L, DIFF_WIDTH, D), DIFF_WIDTH ** -0.5)
    w_branch_b = nrm(ks[10], (L, GDN_WIDTH, D), GDN_WIDTH ** -0.5)
    w_out = nrm(ks[11], (L, D, D), D ** -0.5 * DEEPNORM_BETA)
    ln1_g = 1.0 + nrm(ks[12], (L, D), 0.02)
    ln1_b = nrm(ks[13], (L, D), 0.02)
    w_router = nrm(ks[14], (L, D, N_EXPERTS), D ** -0.5)
    router_bias = nrm(ks[15], (L, N_EXPERTS), 0.01)
    w_gate = nrm(ks[16], (L, N_EXPERTS, D, EXPERT_FF), D ** -0.5)
    w_up = nrm(ks[17], (L, N_EXPERTS, D, EXPERT_FF), D ** -0.5)
    w_down = nrm(ks[18], (L, N_EXPERTS, EXPERT_FF, D), EXPERT_FF ** -0.5 * DEEPNORM_BETA)
    ws_gate = nrm(ks[19], (L, D, SHARED_FF), D ** -0.5)
    ws_up = nrm(ks[20], (L, D, SHARED_FF), D ** -0.5)
    ws_down = nrm(ks[21], (L, SHARED_FF, D), SHARED_FF ** -0.5 * DEEPNORM_BETA)
    ln2_g = 1.0 + nrm(ks[22], (L, D), 0.02)
    ln2_b = nrm(ks[23], (L, D), 0.02)
    return {"x": x, "w_in": w_in, "conv_w": conv_w, "gdn_a_log": gdn_a_log, "gdn_dt_bias": gdn_dt_bias,
            "gdn_norm_w": gdn_norm_w, "diff_lambda": diff_lambda, "diff_subln_w": diff_subln_w,
            "rel_bias_table": rel_bias_table, "w_branch_a": w_branch_a, "w_branch_b": w_branch_b,
            "w_out": w_out, "ln1_g": ln1_g, "ln1_b": ln1_b, "w_router": w_router,
            "router_bias": router_bias, "w_gate": w_gate, "w_up": w_up, "w_down": w_down,
            "ws_gate": ws_gate, "ws_up": ws_up, "ws_down": ws_down, "ln2_g": ln2_g, "ln2_b": ln2_b}


def reference(x, w_in, conv_w, gdn_a_log, gdn_dt_bias, gdn_norm_w, diff_lambda, diff_subln_w,
              rel_bias_table, w_branch_a, w_branch_b, w_out, ln1_g, ln1_b, w_router, router_bias,
              w_gate, w_up, w_down, ws_gate, ws_up, ws_down, ln2_g, ln2_b):
    for l in range(DEPTH):
        lambda_init = 0.8 - 0.6 * math.exp(-0.3 * l)
        h = hybrid_mixer(x, w_in[l], conv_w[l], gdn_a_log[l], gdn_dt_bias[l], gdn_norm_w[l],
                         diff_lambda[l], diff_subln_w[l], rel_bias_table, w_branch_a[l],
                         w_branch_b[l], w_out[l], lambda_init)
        x = layer_norm(DEEPNORM_ALPHA * x + h, ln1_g[l], ln1_b[l])
        h = moe_ffn(x, w_router[l], router_bias[l], w_gate[l], w_up[l], w_down[l],
                    ws_gate[l], ws_up[l], ws_down[l])
        x = layer_norm(DEEPNORM_ALPHA * x + h, ln2_g[l], ln2_b[l])
    return x
```

```cpp
#include <hip/hip_runtime.h>
#include <cstdio>
#include <cstdint>

#ifndef MK_N_LAUNCHES
#define MK_N_LAUNCHES 0
#endif

namespace pg8 {
#define PG8_LAS __attribute__((address_space(3)))
typedef unsigned short bf16_t;
typedef short bf16x8 __attribute__((ext_vector_type(8)));
typedef float f32x4 __attribute__((ext_vector_type(4)));
typedef unsigned u32x4 __attribute__((ext_vector_type(4)));
typedef unsigned u32x2 __attribute__((ext_vector_type(2)));
constexpr int BM = 256, BK = 64, HALF = 128, HTB = HALF * BK * 2  , STAGE_BYTES = 8 * HTB, NXCD = 8, WGM = 8;

__host__ __device__ __forceinline__ int lds_byte(int r, int c) { const int st = (r >> 4) * 2 + (c >> 5), rr = r & 15, cc = c & 31, ob = rr * 64 + cc * 2; return st * 1024 + (ob ^ (((ob >> 9) & 1) << 5)); }
__host__ __device__ __forceinline__ void stage_rc(int b, int& R, int& C) { const int st = b / 1024, sb = b % 1024, swz = sb ^ (((sb >> 9) & 1) << 5); R = (st >> 1) * 16 + swz / 64; C = (st & 1) * 32 + (swz % 64) / 2; }
__host__ __device__ __forceinline__ int perm32(int rho) { const int n = rho >> 4, i = rho & 15; return 8 * (i >> 2) + 4 * n + (i & 3); }

struct Unit { int pm, pn, arow, brow, r0, nv, e, lb; };
struct Gemm { const bf16_t* A; const bf16_t* Bt; int M, N, K; };

struct StaticOrder {
    int nM, nN, nwg, G, c;
    __host__ __device__ void init(int M, int N, int G_, int c_) { nM = M / BM; nN = N / BM; nwg = nM * nN; G = G_; c = c_; }
    __host__ __device__ bool next(int i, Unit& u) const {
        const long L = (long)i * G + c; if (L >= nwg) return false;
        int wgid = (int)L; { const int q = nwg / NXCD, r = nwg % NXCD, xcd = wgid % NXCD, off = wgid / NXCD; wgid = (xcd < r ? xcd * (q + 1) : r * (q + 1) + (xcd - r) * q) + off; }
        const int nig = WGM * nN, gid = wgid / nig, fm = gid * WGM, gsz = (nM - fm) < WGM ? (nM - fm) : WGM;
        u.pm = fm + ((wgid % nig) % gsz); u.pn = (wgid % nig) / gsz; u.arow = u.pm * BM; u.brow = u.pn * BM; u.r0 = u.arow; u.nv = BM; u.e = 0; u.lb = 0; return true;
    }
    __device__ __forceinline__ int row_of(const Unit&, int) const { return 0; }
};

__device__ __forceinline__ unsigned cvt_pk_bf16(float lo, float hi) { unsigned r; asm volatile("v_cvt_pk_bf16_f32 %0, %1, %2" : "=v"(r) : "v"(lo), "v"(hi)); return r; }

template <class Epi, class Sched, bool ALIGN_EPI, bool GATHER>
__device__ __forceinline__ void gemm_phase(PG8_LAS unsigned char* lds, const Gemm g, const Sched& S, const Epi& E) {
    static_assert(Epi::PERM, "epilogues use the PERM column layout");
    const int tid = threadIdx.x, wid = __builtin_amdgcn_readfirstlane(tid >> 6), lane = tid & 63, wr = wid >> 2, wc = wid & 3, fr = lane & 15, fq = lane >> 4;
    const int K = g.K, nt = K / BK;
    unsigned voffA[2], voffB[2]; int stR[2], stC[2];
#pragma unroll
    for (int i = 0; i < 2; ++i) { int R, C; stage_rc(tid * 16 + i * 8192, R, C); const int Rb = (R & ~31) + perm32(R & 31); stR[i] = R; stC[i] = C;
        voffA[i] = (unsigned)(R * K + C) * 2u; voffB[i] = (unsigned)(Rb * K + C) * 2u; }
    const size_t kstep = (size_t)(BK * 2);
    const size_t hstep = (size_t)HALF * K * 2;
    const size_t rstep = (size_t)K * 2;
    const unsigned ldsw = (unsigned)wid * 1024u;
    const int aoff = lds_byte(wr * 64 + fr, fq * 8), boff = lds_byte(wc * 32 + fr, fq * 8);
#define PG8_SA(b, h) (((b) * 2 + (h)) * HTB)
#define PG8_SB(b, h) ((4 + (b) * 2 + (h)) * HTB)
#define PG8_STAGE(bufoff, gbase, voff) do { _Pragma("unroll") for (int _i = 0; _i < 2; ++_i) \
        __builtin_amdgcn_global_load_lds((const unsigned*)((const char*)(gbase) + (voff)[_i]), (PG8_LAS unsigned*)(lds + (bufoff) + ldsw + _i * 8192), 16, 0, 0); } while (0)
#define PG8_STAGE_A(b, h, P, V) do { if constexpr (GATHER) { PG8_STAGE(PG8_SA(b, h), P, V[h]); } else { PG8_STAGE(PG8_SA(b, h), (P) + (h) * hstep, voffA); } } while (0)
#define PG8_LDA(dst, b, h) do { _Pragma("unroll") for (int m = 0; m < 4; ++m) _Pragma("unroll") for (int k = 0; k < 2; ++k) dst[m][k] = *(const PG8_LAS bf16x8*)(lds + PG8_SA(b, h) + aoff + m * 2048 + k * 1024); } while (0)
#define PG8_LDB(dst, b, h) do { _Pragma("unroll") for (int n = 0; n < 2; ++n) _Pragma("unroll") for (int k = 0; k < 2; ++k) dst[n][k] = *(const PG8_LAS bf16x8*)(lds + PG8_SB(b, h) + boff + n * 2048 + k * 1024); } while (0)
#define PG8_MMA(ai, bj, At, Bt) do { __builtin_amdgcn_s_setprio(1); _Pragma("unroll") for (int m = 0; m < 4; ++m) _Pragma("unroll") for (int n = 0; n < 2; ++n) _Pragma("unroll") for (int k = 0; k < 2; ++k) \
        acc[ai][bj][m][n] = __builtin_amdgcn_mfma_f32_16x16x32_bf16(Bt[n][k], At[m][k], acc[ai][bj][m][n], 0, 0, 0); __builtin_amdgcn_s_setprio(0); } while (0)
#define PG8_WAIT_V(n) asm volatile("s_waitcnt vmcnt(" #n ")" ::: "memory")
#define PG8_WAIT_L(n) asm volatile("s_waitcnt lgkmcnt(" #n ")" ::: "memory")
#define PG8_BAR __builtin_amdgcn_s_barrier()
#define PG8_SCHED __builtin_amdgcn_sched_barrier(0)
#define PG8_GOFF(V, u) do { if constexpr (GATHER) { _Pragma("unroll") for (int _h = 0; _h < 2; ++_h) _Pragma("unroll") for (int _i = 0; _i < 2; ++_i) \
        V[_h][_i] = (unsigned)(S.row_of(u, _h * HALF + stR[_i]) * K + stC[_i]) * 2u; } } while (0)
    Unit cur, nxt; int ui = 0;
    if (!S.next(0, cur)) return;
    f32x4 acc[2][2][4][2];
#pragma unroll
    for (int a = 0; a < 2; ++a)
#pragma unroll
        for (int b = 0; b < 2; ++b)
#pragma unroll
            for (int m = 0; m < 4; ++m)
#pragma unroll
                for (int n = 0; n < 2; ++n) acc[a][b][m][n] = (f32x4){0.f, 0.f, 0.f, 0.f};
    bf16x8 At[4][2], B0[2][2], B1[2][2];
    unsigned vcur[2][2] = {{0u, 0u}, {0u, 0u}}, vnxt[2][2] = {{0u, 0u}, {0u, 0u}}, v2[2][2] = {{0u, 0u}, {0u, 0u}};
    PG8_GOFF(vcur, cur);
    const char* cA = GATHER ? (const char*)g.A : (const char*)g.A + (size_t)cur.arow * rstep; const char* cB = (const char*)g.Bt + (size_t)cur.brow * rstep;
    PG8_STAGE(PG8_SB(0, 0), cB, voffB); PG8_STAGE(PG8_SB(0, 1), cB + hstep, voffB); PG8_STAGE_A(0, 0, cA, vcur); PG8_STAGE_A(0, 1, cA, vcur);
    if (wr == 1) PG8_BAR;
    PG8_WAIT_V(2); PG8_BAR;
    PG8_STAGE(PG8_SB(1, 0), cB + kstep, voffB); PG8_STAGE_A(1, 0, cA + kstep, vcur); PG8_STAGE(PG8_SB(1, 1), cB + hstep + kstep, voffB);
    PG8_WAIT_V(6); PG8_BAR;
    for (;;) {
        const bool has_next = S.next(ui + 1, nxt);
        if constexpr (GATHER) { if (has_next) { PG8_GOFF(vnxt, nxt); } else {
#pragma unroll
            for (int h = 0; h < 2; ++h)
#pragma unroll
                for (int i = 0; i < 2; ++i) vnxt[h][i] = vcur[h][i]; } }
        const char* nA = GATHER ? cA : (has_next ? (const char*)g.A + (size_t)nxt.arow * rstep : cA); const char* nB = has_next ? (const char*)g.Bt + (size_t)nxt.brow * rstep : cB;
        for (int t = 0; t < nt; t += 2) {
            const bool last = (t == nt - 2);
            const char* a1 = cA + (size_t)(t + 1) * kstep;
            const char* a2 = last ? nA : cA + (size_t)(t + 2) * kstep; const char* b2 = last ? nB : cB + (size_t)(t + 2) * kstep;
            const char* a3 = a2 + kstep; const char* b3 = b2 + kstep;
            if constexpr (GATHER) {
#pragma unroll
                for (int h = 0; h < 2; ++h)
#pragma unroll
                    for (int i = 0; i < 2; ++i) v2[h][i] = last ? vnxt[h][i] : vcur[h][i]; }
            PG8_LDB(B0, 0, 0); PG8_LDB(B1, 0, 1); PG8_SCHED; PG8_LDA(At, 0, 0); PG8_STAGE_A(1, 1, a1, vcur);
            PG8_WAIT_V(8); PG8_WAIT_L(0); PG8_BAR; PG8_MMA(0, 0, At, B0); PG8_MMA(0, 1, At, B1); PG8_BAR; PG8_SCHED;
            PG8_LDA(At, 0, 1); PG8_STAGE(PG8_SB(0, 0), b2, voffB); PG8_STAGE(PG8_SB(0, 1), b2 + hstep, voffB); PG8_STAGE_A(0, 0, a2, v2);
            PG8_WAIT_V(8); PG8_WAIT_L(0); PG8_BAR; PG8_MMA(1, 0, At, B0); PG8_MMA(1, 1, At, B1); PG8_BAR; PG8_SCHED;
            PG8_LDB(B0, 1, 0); PG8_LDB(B1, 1, 1); PG8_SCHED; PG8_LDA(At, 1, 0); PG8_STAGE_A(0, 1, a2, v2);
            PG8_WAIT_V(8); PG8_WAIT_L(0); PG8_BAR; PG8_MMA(0, 0, At, B0); PG8_MMA(0, 1, At, B1); PG8_BAR; PG8_SCHED;
            PG8_LDA(At, 1, 1); PG8_STAGE(PG8_SB(1, 0), b3, voffB); PG8_STAGE(PG8_SB(1, 1), b3 + hstep, voffB); PG8_STAGE_A(1, 0, a3, v2);
            PG8_WAIT_V(8); PG8_WAIT_L(0); PG8_BAR; PG8_MMA(1, 0, At, B0); PG8_MMA(1, 1, At, B1); PG8_BAR; PG8_SCHED;
        }
        if constexpr (ALIGN_EPI) { if (wr == 0) PG8_BAR; }
        E(acc, cur, wr, wc, fr, fq);
        if (!has_next) break;
#pragma unroll
        for (int a = 0; a < 2; ++a)
#pragma unroll
            for (int b = 0; b < 2; ++b)
#pragma unroll
                for (int m = 0; m < 4; ++m)
#pragma unroll
                    for (int n = 0; n < 2; ++n) acc[a][b][m][n] = (f32x4){0.f, 0.f, 0.f, 0.f};
        cur = nxt; cA = nA; cB = nB; ++ui;
        if constexpr (GATHER) {
#pragma unroll
            for (int h = 0; h < 2; ++h)
#pragma unroll
                for (int i = 0; i < 2; ++i) vcur[h][i] = vnxt[h][i]; }
        if constexpr (ALIGN_EPI) { if (wr == 1) PG8_BAR; }
    }
    PG8_WAIT_V(0);
    if constexpr (!ALIGN_EPI) { if (wr == 0) PG8_BAR; }
    PG8_BAR;
#undef PG8_SA
#undef PG8_SB
#undef PG8_STAGE
#undef PG8_STAGE_A
#undef PG8_LDA
#undef PG8_LDB
#undef PG8_MMA
#undef PG8_WAIT_V
#undef PG8_WAIT_L
#undef PG8_BAR
#undef PG8_SCHED
#undef PG8_GOFF
}
}

constexpr int NWAVES = 8, NTHR = 512;
constexpr int T = 8192, D = 2048, NPROJ = 11264, WIN_PITCH = 11280, NH = 8, NE = 64, NEX = 65, FF = 512, TOPK = 8, NCHUNK = 128;
constexpr float ALPHA = 1.18920711500272106672f, LN_EPS = 1e-5f, NORM_EPS = 1e-6f, LAMBDA_INIT = 0.2f, ROUTED_SCALE = 2.5f;
constexpr int NPHASE = 12;

constexpr size_t MiB = 1u << 20;
constexpr size_t WS_CTL = 0, CTL_ZERO_BYTES = 1 * MiB;
constexpr size_t WS_WA = 2 * MiB, WS_WB = 6 * MiB, WS_WO = 10 * MiB, WS_WGU = 18 * MiB, WS_WD = 278 * MiB;
constexpr size_t WS_X1F = 408 * MiB, WS_X1B = 472 * MiB, WS_YA = 504 * MiB, WS_YB = 520 * MiB;
constexpr size_t WS_TOKL = 536 * MiB, WS_WGTL = 539 * MiB, WS_INFO = 542 * MiB, WS_GL = 542 * MiB + 512 * 1024, WS_GAB = 543 * MiB;
constexpr size_t WS_WIN = 544 * MiB, WS_XB = 588 * MiB, WS_P = 620 * MiB;
constexpr size_t WS_U = 796 * MiB, WS_W = 828 * MiB, WS_QD = 860 * MiB, WS_KD = 892 * MiB, WS_AQK = 924 * MiB, WS_SST = 940 * MiB, WS_END = 1004 * MiB;
constexpr size_t WS_TMP = 796 * MiB, WS_MRG = 860 * MiB, WS_Y1 = 892 * MiB;
constexpr size_t WS_HB = 544 * MiB, WS_YAS = 620 * MiB;
constexpr size_t PBUF = (size_t)T * 1024;
constexpr int CW_BAR = 4096;
constexpr int CW_CNT = 32768;

constexpr int RING_BYTES = 131072;
constexpr int LDS_TAB = RING_BYTES;
constexpr int MISC_OFF = RING_BYTES + 16384 - 256;
constexpr int LDS_BYTES = RING_BYTES + 16384;

#define GAS __attribute__((address_space(1)))
#define LAS __attribute__((address_space(3)))
typedef unsigned short bf16;
typedef unsigned v4u __attribute__((ext_vector_type(4)));
typedef unsigned v2u __attribute__((ext_vector_type(2)));
typedef float f32x4 __attribute__((ext_vector_type(4)));
typedef float f32x2 __attribute__((ext_vector_type(2)));
typedef short bf16x8 __attribute__((ext_vector_type(8)));
typedef GAS unsigned gu32;
#define RLX_AGENT __ATOMIC_RELAXED, __HIP_MEMORY_SCOPE_AGENT
#define LDS_WAIT() asm volatile("s_waitcnt lgkmcnt(0)" ::: "memory")
#define VM_WAIT() asm volatile("s_waitcnt vmcnt(0)" ::: "memory")
__device__ __forceinline__ unsigned f2bf(float f) { unsigned u = __builtin_bit_cast(unsigned, f); return (u + 0x7fffu + ((u >> 16) & 1u)) >> 16; }
__device__ __forceinline__ unsigned pk2(float lo, float hi) { return f2bf(lo) | (f2bf(hi) << 16); }
__device__ __forceinline__ float bflo(unsigned w) { return __builtin_bit_cast(float, w << 16); }
__device__ __forceinline__ float bfhi(unsigned w) { return __builtin_bit_cast(float, w & 0xffff0000u); }
__device__ __forceinline__ float bf2f(bf16 b) { return __builtin_bit_cast(float, (unsigned)b << 16); }
__device__ __forceinline__ float sigmoidf_(float x) { return 1.f / (1.f + __expf(-x)); }
__device__ __forceinline__ float siluf_(float x) { return x / (1.f + __expf(-x)); }

#define XB_TMO      128
#define XB_XCNT(j)  (256  + 64 * (j))
#define XB_XSUB(j)  (1280 + 64 * (j))
#define XB_XGEN(j)  (2304 + 64 * (j))
#define XB_TOP      3328
#define XB_TOPGEN   3392
#define XCD_BAR_WORDS 3456
#define XB_SPIN_CAP (1u << 22)

__device__ __forceinline__ unsigned xb_ld(unsigned* p)              { return __hip_atomic_load(p, __ATOMIC_RELAXED, __HIP_MEMORY_SCOPE_AGENT); }
__device__ __forceinline__ unsigned xb_add(unsigned* p, unsigned v) { return __hip_atomic_fetch_add(p, v, __ATOMIC_RELAXED, __HIP_MEMORY_SCOPE_AGENT); }
__device__ __forceinline__ unsigned xb_xcc_id() { return (unsigned)__builtin_amdgcn_s_getreg((3 << 11) | 20) & 0xFu; }
#define XB_SPIN(cond, bar) do { unsigned _sp = 0; while (cond) { __builtin_amdgcn_s_sleep(1); \
    if ((++_sp & 255u) == 0u) { if (xb_ld(&(bar)[XB_TMO])) break; if (_sp > XB_SPIN_CAP) { atomicAdd(&(bar)[XB_TMO], 1u); break; } } } } while (0)

struct XcdBarrier {
    unsigned* bar; unsigned x;
    volatile LAS unsigned* st;
};
__device__ __forceinline__ XcdBarrier xcd_barrier_post(unsigned* bar, volatile LAS unsigned* st) {
    XcdBarrier b; b.bar = bar; b.x = xb_xcc_id(); b.st = st;
    if (threadIdx.x == 0) (void)xb_add(&bar[XB_XCNT(b.x)], 1u);
    return b;
}
__device__ __forceinline__ void xcd_barrier_complete(unsigned* bar, unsigned x, unsigned& nloc, unsigned& nx) {
    const unsigned G = gridDim.x * gridDim.y * gridDim.z;
    unsigned sum, cnt, mine, sp = 0u;
    for (;;) {
        sum = 0u; cnt = 0u; mine = 0u;
#pragma unroll
        for (unsigned j = 0; j < 16; ++j) { const unsigned c = xb_ld(&bar[XB_XCNT(j)]); sum += c; cnt += (c > 0u) ? 1u : 0u; mine = (j == x) ? c : mine; }
        if (sum == G) break;
        __builtin_amdgcn_s_sleep(1);
        if ((++sp & 255u) == 0u) { if (xb_ld(&bar[XB_TMO])) break; if (sp > XB_SPIN_CAP) { atomicAdd(&bar[XB_TMO], 1u); break; } }
    }
    nloc = mine > 0u ? mine : 1u; nx = cnt > 0u ? cnt : 1u;
}
__device__ __forceinline__ void xcd_barrier(const XcdBarrier& b) {
    asm volatile("s_waitcnt vmcnt(0)" ::: "memory");
    __syncthreads();
    if (threadIdx.x == 0) {
        unsigned* bar = b.bar;
        __builtin_amdgcn_s_waitcnt(0);
        unsigned nloc = b.st[0], nx = b.st[1];
        if (nloc == 0u) { xcd_barrier_complete(bar, b.x, nloc, nx); b.st[0] = nloc; b.st[1] = nx; }
        const unsigned old = xb_add(&bar[XB_XSUB(b.x)], 1u);
        const unsigned gen = old / nloc;
        if (old + 1u == (gen + 1u) * nloc) {
            __builtin_amdgcn_fence(__ATOMIC_RELEASE, "agent");
            asm volatile("s_waitcnt vmcnt(0)" ::: "memory");
            const unsigned og = xb_add(&bar[XB_TOP], 1u);
            const unsigned tg = og / nx;
            if (og + 1u == (tg + 1u) * nx) xb_add(&bar[XB_TOPGEN], 1u);
            else XB_SPIN(xb_ld(&bar[XB_TOPGEN]) == tg, bar);
            __builtin_amdgcn_fence(__ATOMIC_ACQUIRE, "agent");
            xb_add(&bar[XB_XGEN(b.x)], 1u);
            asm volatile("s_waitcnt vmcnt(0)" ::: "memory");
        } else {
            XB_SPIN(xb_ld(&bar[XB_XGEN(b.x)]) == gen, bar);
            __builtin_amdgcn_fence(__ATOMIC_ACQUIRE, "agent");
            asm volatile("s_waitcnt vmcnt(0)" ::: "memory");
        }
    }
    __syncthreads();
}

struct Frame {
    LAS unsigned char* lds;
    gu32* ctl;
    int tid, lane, wave;
    int vcu, G;
    const float* in[24]; float* out; unsigned char* ws;
};
__device__ __forceinline__ float wave_sum(float v) {
#pragma unroll
    for (int o = 1; o < 64; o <<= 1) v += __shfl_xor(v, o);
    return v;
}
__device__ __forceinline__ float wave_max(float v) {
#pragma unroll
    for (int o = 1; o < 64; o <<= 1) v = fmaxf(v, __shfl_xor(v, o));
    return v;
}

__device__ __forceinline__ void p0_transpose_item(const float* W, int pitch, int sn0, bf16* WT, int dpitch, int dr0, int k0, LAS float* scr, int lane) {
#pragma unroll 8
    for (int i = 0; i < 32; ++i) { const int kk = 2 * i + (lane >> 5); scr[kk * 33 + (lane & 31)] = W[(size_t)(k0 + kk) * pitch + sn0 + (lane & 31)]; }
    LDS_WAIT(); asm volatile("" ::: "memory");
    const int c = lane & 7;
#pragma unroll
    for (int j = 0; j < 4; ++j) { const int n = (lane >> 3) + 8 * j; const LAS float* s = scr + (8 * c) * 33 + n;
        v4u o; o.x = pk2(s[0 * 33], s[1 * 33]); o.y = pk2(s[2 * 33], s[3 * 33]); o.z = pk2(s[4 * 33], s[5 * 33]); o.w = pk2(s[6 * 33], s[7 * 33]);
        *(GAS v4u*)(WT + (size_t)(dr0 + n) * dpitch + k0 + 8 * c) = o; }
    LDS_WAIT(); asm volatile("" ::: "memory");
}
__device__ __forceinline__ void p0_prologue(Frame& F) {
    unsigned char* ws = F.ws;
    {
        LAS float* w16 = (LAS float*)F.lds;
        for (int idx = F.tid; idx < 2048 * 4; idx += NTHR) { const int k = idx >> 2, q = idx & 3;
            const f32x4 v = *(const GAS f32x4*)(F.in[1] + (size_t)k * WIN_PITCH + 7168 + 4 * q); *(LAS f32x4*)(w16 + k * 16 + 4 * q) = v; }
        __syncthreads();
        float* gab = (float*)(ws + WS_GAB);
        for (int tok = F.vcu * NWAVES + F.wave; tok < T; tok += F.G * NWAVES) {
            float acc[16];
#pragma unroll
            for (int e = 0; e < 16; ++e) acc[e] = 0.f;
            const float* xr = F.in[0] + (size_t)tok * D;
#pragma unroll 2
            for (int j = 0; j < 32; ++j) { const int k = j * 64 + F.lane; const float xv = xr[k];
#pragma unroll
                for (int q = 0; q < 4; ++q) { const f32x4 w = *(const LAS f32x4*)(w16 + k * 16 + 4 * q);
                    acc[4 * q + 0] += xv * w.x; acc[4 * q + 1] += xv * w.y; acc[4 * q + 2] += xv * w.z; acc[4 * q + 3] += xv * w.w; } }
#pragma unroll
            for (int e = 0; e < 16; ++e) acc[e] = wave_sum(acc[e]);
            if (F.lane == 0) {
#pragma unroll
                for (int q = 0; q < 4; ++q) *(GAS f32x4*)(gab + (size_t)tok * 16 + 4 * q) = (f32x4){acc[4 * q], acc[4 * q + 1], acc[4 * q + 2], acc[4 * q + 3]}; }
        }
        __syncthreads();
    }
    LAS float* scr = (LAS float*)(F.lds + F.wave * 16384);
    const int gw = F.vcu * NWAVES + F.wave, NGW = F.G * NWAVES;
    constexpr int I_IN = 32 * 352, I_A = 16 * 64, I_O = 32 * 64, I_GU = NEX * 2 * 512, I_D = NEX * 512;
    constexpr int NITEMS = I_IN + 2 * I_A + I_O + I_GU + I_D;
    for (int it = gw; it < NITEMS; it += NGW) {
        int r = it;
        if (r < I_IN) { const int kb = r / 352, nb = r % 352, n0 = 32 * nb; p0_transpose_item(F.in[1], WIN_PITCH, n0 + (n0 >= 7168 ? 16 : 0), (bf16*)(ws + WS_WIN), D, n0, 64 * kb, scr, F.lane); continue; } r -= I_IN;
        if (r < I_A) { const int kb = r / 64, nb = r % 64; p0_transpose_item(F.in[9], D, 32 * nb, (bf16*)(ws + WS_WA), 1024, 32 * nb, 64 * kb, scr, F.lane); continue; } r -= I_A;
        if (r < I_A) { const int kb = r / 64, nb = r % 64; p0_transpose_item(F.in[10], D, 32 * nb, (bf16*)(ws + WS_WB), 1024, 32 * nb, 64 * kb, scr, F.lane); continue; } r -= I_A;
        if (r < I_O) { const int kb = r / 64, nb = r % 64; p0_transpose_item(F.in[11], D, 32 * nb, (bf16*)(ws + WS_WO), D, 32 * nb, 64 * kb, scr, F.lane); continue; } r -= I_O;
        if (r < I_GU) { const int e = r / 1024, which = (r >> 9) & 1, q = r & 511, kb = q / 16, nb = q % 16;
            const float* src = e < NE ? (which ? F.in[17] : F.in[16]) + (size_t)e * D * FF : (which ? F.in[20] : F.in[19]);
            p0_transpose_item(src, FF, 32 * nb, (bf16*)(ws + WS_WGU) + (size_t)e * 1024 * D, D, 256 * (nb >> 2) + 32 * (nb & 3) + 128 * which, 64 * kb, scr, F.lane); continue; } r -= I_GU;
        { const int e = r / 512, q = r & 511, kb = q / 64, nb = q % 64;
            const float* src = e < NE ? F.in[18] + (size_t)e * FF * D : F.in[21];
            p0_transpose_item(src, D, 32 * nb, (bf16*)(ws + WS_WD) + (size_t)e * D * FF, FF, 32 * nb, 64 * kb, scr, F.lane); }
    }
    { const GAS f32x4* x4 = (const GAS f32x4*)F.in[0]; GAS v4u* o = (GAS v4u*)(ws + WS_XB);
      for (size_t i = (size_t)F.vcu * NTHR + F.tid; i < (size_t)T * D / 8; i += (size_t)F.G * NTHR) { const f32x4 a = x4[2 * i], b = x4[2 * i + 1];
          v4u w; w.x = pk2(a.x, a.y); w.y = pk2(a.z, a.w); w.z = pk2(b.x, b.y); w.w = pk2(b.z, b.w); o[i] = w; } }
}

using pg8::Unit;
struct EpiProj {
    static constexpr bool PERM = true;
    bf16* P;
    __device__ __forceinline__ void operator()(const f32x4 (&acc)[2][2][4][2], const Unit& u, int wr, int wc, int fr, int fq) const {
        const int buf = u.pn >> 2, colt = (u.pn & 3) * 256; bf16* base = P + (size_t)buf * PBUF;
        const int row0 = u.r0 + wr * 64 + fr, col0 = colt + wc * 32 + 8 * fq; const bool sg = buf >= 7;
#pragma unroll
        for (int ai = 0; ai < 2; ++ai)
#pragma unroll
            for (int m = 0; m < 4; ++m) { bf16* rowp = base + (size_t)(row0 + ai * 128 + m * 16) * 1024 + col0;
#pragma unroll
                for (int bj = 0; bj < 2; ++bj) { f32x4 v0 = acc[ai][bj][m][0], v1 = acc[ai][bj][m][1];
                    if (sg) { v0 = (f32x4){sigmoidf_(v0.x), sigmoidf_(v0.y), sigmoidf_(v0.z), sigmoidf_(v0.w)}; v1 = (f32x4){sigmoidf_(v1.x), sigmoidf_(v1.y), sigmoidf_(v1.z), sigmoidf_(v1.w)}; }
                    v4u w; w.x = pk2(v0.x, v0.y); w.y = pk2(v0.z, v0.w); w.z = pk2(v1.x, v1.y); w.w = pk2(v1.z, v1.w);
                    *(GAS v4u*)(rowp + bj * 128) = w; } }
    }
};
template <int STEP> struct EpiBranch {
    static constexpr bool PERM = true;
    const bf16* SG; float* tmp; bf16* mrg;
    __device__ __forceinline__ void operator()(const f32x4 (&acc)[2][2][4][2], const Unit& u, int wr, int wc, int fr, int fq) const {
        const int row0 = u.r0 + wr * 64 + fr, colu = u.pn * 256 + wc * 32 + 8 * fq;
#pragma unroll
        for (int ai = 0; ai < 2; ++ai)
#pragma unroll
            for (int m = 0; m < 4; ++m) { const int row = row0 + ai * 128 + m * 16;
#pragma unroll
                for (int bj = 0; bj < 2; ++bj) { const int col = colu + bj * 128;
                    const v4u g = *(const GAS v4u*)(SG + (size_t)(col >> 10) * PBUF + (size_t)row * 1024 + (col & 1023));
                    f32x4 v0 = acc[ai][bj][m][0], v1 = acc[ai][bj][m][1];
                    v0 = v0 * (f32x4){bflo(g.x), bfhi(g.x), bflo(g.y), bfhi(g.y)}; v1 = v1 * (f32x4){bflo(g.z), bfhi(g.z), bflo(g.w), bfhi(g.w)};
                    float* tp = tmp + (size_t)row * D + col;
                    if (STEP == 0) { *(GAS f32x4*)tp = v0; *(GAS f32x4*)(tp + 4) = v1; }
                    else { v0 = v0 + *(const GAS f32x4*)tp; v1 = v1 + *(const GAS f32x4*)(tp + 4);
                        v4u w; w.x = pk2(v0.x, v0.y); w.y = pk2(v0.z, v0.w); w.z = pk2(v1.x, v1.y); w.w = pk2(v1.z, v1.w);
                        *(GAS v4u*)(mrg + (size_t)row * D + col) = w; } } }
    }
};
struct EpiOut {
    static constexpr bool PERM = true;
    const float* x; float* y1;
    __device__ __forceinline__ void operator()(const f32x4 (&acc)[2][2][4][2], const Unit& u, int wr, int wc, int fr, int fq) const {
        const int row0 = u.r0 + wr * 64 + fr, colu = u.pn * 256 + wc * 32 + 8 * fq;
#pragma unroll
        for (int ai = 0; ai < 2; ++ai)
#pragma unroll
            for (int m = 0; m < 4; ++m) { const size_t ro = (size_t)(row0 + ai * 128 + m * 16) * D;
#pragma unroll
                for (int bj = 0; bj < 2; ++bj) { const size_t o = ro + colu + bj * 128;
                    const f32x4 x0 = *(const GAS f32x4*)(x + o), x1 = *(const GAS f32x4*)(x + o + 4);
                    *(GAS f32x4*)(y1 + o) = x0 * ALPHA + acc[ai][bj][m][0]; *(GAS f32x4*)(y1 + o + 4) = x1 * ALPHA + acc[ai][bj][m][1]; } }
    }
};
struct EpiGU {
    static constexpr bool PERM = true;
    bf16* HB;
    __device__ __forceinline__ void operator()(const f32x4 (&acc)[2][2][4][2], const Unit& u, int wr, int wc, int fr, int fq) const {
        const int col = u.pn * 128 + wc * 32 + 8 * fq;
#pragma unroll
        for (int ai = 0; ai < 2; ++ai)
#pragma unroll
            for (int m = 0; m < 4; ++m) { const int r = ai * 128 + wr * 64 + m * 16 + fr;
                if (r < u.nv) { const f32x4 g0 = acc[ai][0][m][0], g1 = acc[ai][0][m][1], u0 = acc[ai][1][m][0], u1 = acc[ai][1][m][1];
                    v4u w; w.x = pk2(siluf_(g0.x) * u0.x, siluf_(g0.y) * u0.y); w.y = pk2(siluf_(g0.z) * u0.z, siluf_(g0.w) * u0.w);
                    w.z = pk2(siluf_(g1.x) * u1.x, siluf_(g1.y) * u1.y); w.w = pk2(siluf_(g1.z) * u1.z, siluf_(g1.w) * u1.w);
                    *(GAS v4u*)(HB + (size_t)(u.r0 + r) * FF + col) = w; } }
    }
};
struct EpiDown {
    static constexpr bool PERM = true;
    bf16* YAS; const float* wgtl;
    __device__ __forceinline__ void operator()(const f32x4 (&acc)[2][2][4][2], const Unit& u, int wr, int wc, int fr, int fq) const {
        const int colu = u.pn * 256 + wc * 32 + 8 * fq;
#pragma unroll
        for (int ai = 0; ai < 2; ++ai)
#pragma unroll
            for (int m = 0; m < 4; ++m) { const int r = ai * 128 + wr * 64 + m * 16 + fr;
                if (r < u.nv) { const float wg = wgtl[u.lb + r];
#pragma unroll
                    for (int bj = 0; bj < 2; ++bj) { const f32x4 v0 = acc[ai][bj][m][0] * wg, v1 = acc[ai][bj][m][1] * wg;
                        v4u w; w.x = pk2(v0.x, v0.y); w.y = pk2(v0.z, v0.w); w.z = pk2(v1.x, v1.y); w.w = pk2(v1.z, v1.w);
                        *(GAS v4u*)(YAS + (size_t)(u.r0 + r) * D + colu + bj * 128) = w; } } }
    }
};
struct MoeOrder {
    const LAS int* tpref; const LAS int* rbase; const LAS int* cnts; const int* tokl; int NT, G, c, brows;
    __device__ __forceinline__ bool next(int i, Unit& u) const {
        const int L = i * G + c; if (L >= tpref[NEX] * NT) return false;
        const int tg = L / NT, nt = L % NT; int e = 0;
        while (tpref[e + 1] <= tg) ++e;
        const int mt = tg - tpref[e];
        u.e = e; u.pm = mt; u.pn = nt; u.lb = e * T + mt * 256; u.nv = min(256, cnts[e] - mt * 256); u.r0 = rbase[e] + mt * 256; u.arow = u.r0; u.brow = e * brows + nt * 256; return true;
    }
    __device__ __forceinline__ int row_of(const Unit& u, int r) const { return r < u.nv ? tokl[u.lb + r] : 0; }
};
__device__ __forceinline__ void moe_tables(Frame& F) {
    LAS int* tpref = (LAS int*)(F.lds + LDS_TAB); LAS int* rbase = tpref + 72; LAS int* cnts = rbase + 72;
    __syncthreads();
    if (F.wave == 0) {
        const int c = (int)__hip_atomic_load(F.ctl + CW_CNT + 64 * F.lane, RLX_AGENT);
        int tl = (c + 255) >> 8, tp = tl, rb = c;
#pragma unroll
        for (int o = 1; o < 64; o <<= 1) { const int a = __shfl_up(tp, o), b = __shfl_up(rb, o); if (F.lane >= o) { tp += a; rb += b; } }
        tpref[F.lane] = tp - tl; rbase[F.lane] = rb - c; cnts[F.lane] = c;
        if (F.lane == 63) { tpref[64] = tp; rbase[64] = rb; cnts[64] = T; tpref[65] = tp + T / 256; rbase[65] = rb + T; }
    }
    __syncthreads();
}

__device__ __forceinline__ int t5_bucket(int rel) {
    const int n = rel < 0 ? -rel : rel; int b;
    if (n < 8) b = n; else if (n < 12) b = 8; else if (n < 16) b = 9; else if (n < 23) b = 10; else if (n < 32) b = 11; else if (n < 46) b = 12; else if (n < 64) b = 13; else if (n < 91) b = 14; else b = 15;
    return b + (rel > 0 ? 16 : 0);
}
typedef short s16x4 __attribute__((ext_vector_type(4)));
__device__ __forceinline__ void attn_v1(Frame& F) {
    LAS bf16* Kl = (LAS bf16*)F.lds;
    LAS bf16* Vt = Kl + 64 * 136;
    LAS float* Ox = (LAS float*)(F.lds + 65536);
    LAS float* relb = (LAS float*)(F.lds + LDS_TAB);
    const bf16* Pq = (const bf16*)(F.ws + WS_P); const bf16* Pk = Pq + PBUF; const bf16* Pv = Pq + 2 * PBUF;
    bf16* ya = (bf16*)(F.ws + WS_YA);
    const int tid = F.tid, lane = F.lane, l15 = lane & 15, g = lane >> 4, qs = F.wave & 3, map = F.wave >> 2;
    float lam;
    { const float* dl = F.in[6]; float s01 = 0.f, s23 = 0.f;
      for (int d = 0; d < 64; ++d) { s01 += dl[d] * dl[64 + d]; s23 += dl[128 + d] * dl[192 + d]; }
      lam = expf(s01) - expf(s23) + LAMBDA_INIT; }
    for (int L = blockIdx.x; L < NH * NCHUNK; L += F.G) {
        const int h = L & 7, c = NCHUNK - 1 - (L >> 3);
        __syncthreads();
        if (tid < 256) relb[tid] = F.in[8][t5_bucket(tid - 191) * 8 + h];
        const int qrow = 16 * qs + l15;
        bf16x8 qf[2];
#pragma unroll
        for (int s = 0; s < 2; ++s) qf[s] = *(const GAS bf16x8*)(Pq + (size_t)(c * 64 + qrow) * 1024 + h * 128 + map * 64 + 32 * s + 8 * g);
        float mrun = -INFINITY, lrun = 0.f; f32x4 o[8];
#pragma unroll
        for (int rb = 0; rb < 8; ++rb) o[rb] = (f32x4){0.f, 0.f, 0.f, 0.f};
        for (int j = 0; j <= c; ++j) {
            __syncthreads();
            { const int r = tid >> 3, cs = (tid & 7) * 16; const size_t go = (size_t)(j * 64 + r) * 1024 + h * 128 + cs;
              const v4u a0 = *(const GAS v4u*)(Pk + go), a1 = *(const GAS v4u*)(Pk + go + 8), b0 = *(const GAS v4u*)(Pv + go), b1 = *(const GAS v4u*)(Pv + go + 8);
              *(LAS v4u*)(Kl + r * 136 + cs) = a0; *(LAS v4u*)(Kl + r * 136 + cs + 8) = a1;
              const unsigned bw[8] = {b0.x, b0.y, b0.z, b0.w, b1.x, b1.y, b1.z, b1.w};
#pragma unroll
              for (int i = 0; i < 8; ++i) { Vt[(cs + 2 * i) * 72 + r] = (bf16)(bw[i] & 0xffffu); Vt[(cs + 2 * i + 1) * 72 + r] = (bf16)(bw[i] >> 16); } }
            __syncthreads();
            f32x4 st[4];
#pragma unroll
            for (int t = 0; t < 4; ++t) { st[t] = (f32x4){0.f, 0.f, 0.f, 0.f};
#pragma unroll
                for (int s = 0; s < 2; ++s) { const bf16x8 kf = *(const LAS bf16x8*)(Kl + (16 * t + l15) * 136 + map * 64 + 32 * s + 8 * g);
                    st[t] = __builtin_amdgcn_mfma_f32_16x16x32_bf16(kf, qf[s], st[t], 0, 0, 0); } }
            float mt = -INFINITY;
            if (j >= c - 2) {
#pragma unroll
                for (int t = 0; t < 4; ++t)
#pragma unroll
                    for (int r = 0; r < 4; ++r) { st[t][r] = st[t][r] * 0.125f + relb[(j - c) * 64 + 16 * t + 4 * g + r - qrow + 191]; mt = fmaxf(mt, st[t][r]); }
            } else { const float bfar = relb[0];
#pragma unroll
                for (int t = 0; t < 4; ++t)
#pragma unroll
                    for (int r = 0; r < 4; ++r) { st[t][r] = st[t][r] * 0.125f + bfar; mt = fmaxf(mt, st[t][r]); } }
            mt = fmaxf(mt, __shfl_xor(mt, 16)); mt = fmaxf(mt, __shfl_xor(mt, 32));
            const float mn = fmaxf(mrun, mt), corr = __expf(mrun - mn);
            lrun *= corr; mrun = mn;
#pragma unroll
            for (int rb = 0; rb < 8; ++rb) o[rb] = o[rb] * corr;
            float ps = 0.f;
#pragma unroll
            for (int t = 0; t < 4; ++t)
#pragma unroll
                for (int r = 0; r < 4; ++r) { st[t][r] = __expf(st[t][r] - mn); ps += st[t][r]; }
            lrun += ps;
            bf16x8 pf[2];
#pragma unroll
            for (int s = 0; s < 2; ++s) { const v4u w = (v4u){pk2(st[2 * s][0], st[2 * s][1]), pk2(st[2 * s][2], st[2 * s][3]), pk2(st[2 * s + 1][0], st[2 * s + 1][1]), pk2(st[2 * s + 1][2], st[2 * s + 1][3])};
                pf[s] = __builtin_bit_cast(bf16x8, w); }
#pragma unroll
            for (int rb = 0; rb < 8; ++rb)
#pragma unroll
                for (int s = 0; s < 2; ++s) { const LAS bf16* vp = Vt + (16 * rb + l15) * 72 + 32 * s + 4 * g;
                    const v2u lo = *(const LAS v2u*)vp, hi = *(const LAS v2u*)(vp + 16);
                    const bf16x8 vf = __builtin_bit_cast(bf16x8, (v4u){lo.x, lo.y, hi.x, hi.y});
                    o[rb] = __builtin_amdgcn_mfma_f32_16x16x32_bf16(vf, pf[s], o[rb], 0, 0, 0); }
        }
        lrun += __shfl_xor(lrun, 16); lrun += __shfl_xor(lrun, 32);
        __syncthreads();
        { const float inv = 1.f / lrun; LAS float* od = Ox + (map * 64 + qrow) * 128;
#pragma unroll
          for (int rb = 0; rb < 8; ++rb) *(LAS f32x4*)(od + 16 * rb + 4 * g) = o[rb] * inv; }
        __syncthreads();
        { const int qq = tid >> 3, seg = (tid & 7) * 16; float a[16], ss = 0.f;
#pragma unroll
          for (int i = 0; i < 16; ++i) { a[i] = Ox[qq * 128 + seg + i] - lam * Ox[(64 + qq) * 128 + seg + i]; ss += a[i] * a[i]; }
          ss += __shfl_xor(ss, 1); ss += __shfl_xor(ss, 2); ss += __shfl_xor(ss, 4);
          const float r = rsqrtf(ss * (1.f / 128.f) + NORM_EPS) * (1.f - LAMBDA_INIT);
          unsigned w[8];
#pragma unroll
          for (int i = 0; i < 8; ++i) w[i] = pk2(a[2 * i] * r * F.in[7][seg + 2 * i], a[2 * i + 1] * r * F.in[7][seg + 2 * i + 1]);
          GAS v4u* op = (GAS v4u*)(ya + (size_t)(c * 64 + qq) * 1024 + h * 128 + seg);
          op[0] = (v4u){w[0], w[1], w[2], w[3]}; op[1] = (v4u){w[4], w[5], w[6], w[7]}; }
    }
}

__device__ __forceinline__ void gdn_prep_v1(Frame& F) {
    LAS float* Ks = (LAS float*)F.lds;
    LAS float* Qs = Ks + 64 * 129;
    LAS float* Vs = Qs + 64 * 129;
    LAS float* As = Vs + 64 * 128;
    LAS float* Tm = As + 64 * 68;
    LAS float* gcs = Tm + 64 * 68;
    LAS float* bts = gcs + 64;
    LAS float* egs = bts + 64;
    const bf16* P3 = (const bf16*)(F.ws + WS_P) + 3 * PBUF;
    const float* gab = (const float*)(F.ws + WS_GAB);
    float* Ug = (float*)(F.ws + WS_U); float* Wg = (float*)(F.ws + WS_W); float* QDg = (float*)(F.ws + WS_QD); float* KDg = (float*)(F.ws + WS_KD);
    float* AQg = (float*)(F.ws + WS_AQK); float* GLg = (float*)(F.ws + WS_GL);
    const int tid = F.tid, lane = F.lane;
    for (int L = blockIdx.x; L < NH * NCHUNK; L += F.G) {
        const int n = L >> 3, h = L & 7, t0 = n * 64;
        __syncthreads();
        for (int idx = tid; idx < 64 * 384; idx += NTHR) { const int t = idx / 384, ch = idx % 384, which = ch >> 7, i = ch & 127, cg = which * 1024 + h * 128 + i;
            const bf16* src = P3 + (size_t)which * PBUF + h * 128 + i; float a = 0.f;
#pragma unroll
            for (int j = 0; j < 4; ++j) { const int tt = t0 + t - 3 + j; if (tt >= 0) a += bf2f(src[(size_t)tt * 1024]) * F.in[2][j * 3072 + cg]; }
            a = siluf_(a);
            if (which == 0) Qs[t * 129 + i] = a; else if (which == 1) Ks[t * 129 + i] = a; else Vs[t * 128 + i] = a; }
        __syncthreads();
        for (int t = F.wave * 8; t < F.wave * 8 + 8; ++t) {
            const float q0 = Qs[t * 129 + lane], q1 = Qs[t * 129 + 64 + lane], k0 = Ks[t * 129 + lane], k1 = Ks[t * 129 + 64 + lane];
            const float rq = rsqrtf(wave_sum(q0 * q0 + q1 * q1) + NORM_EPS) * 0.08838834764831845f, rk = rsqrtf(wave_sum(k0 * k0 + k1 * k1) + NORM_EPS);
            Qs[t * 129 + lane] = q0 * rq; Qs[t * 129 + 64 + lane] = q1 * rq; Ks[t * 129 + lane] = k0 * rk; Ks[t * 129 + 64 + lane] = k1 * rk; }
        if (F.wave == 0) { const int tok = t0 + lane; const float ga = gab[(size_t)tok * 16 + h] + F.in[4][h], gb = gab[(size_t)tok * 16 + 8 + h];
            const float sp = fmaxf(ga, 0.f) + log1pf(expf(-fabsf(ga))); float g = -expf(F.in[3][h]) * sp;
#pragma unroll
            for (int o = 1; o < 64; o <<= 1) { const float v = __shfl_up(g, o); if (lane >= o) g += v; }
            gcs[lane] = g; bts[lane] = 1.f / (1.f + expf(-gb)); egs[lane] = expf(g); }
        __syncthreads();
        for (int idx = tid; idx < 4096; idx += NTHR) { const int c = idx >> 6, s = idx & 63; float kk = 0.f, qk = 0.f;
            if (s <= c) { for (int i = 0; i < 128; ++i) { const float ks = Ks[s * 129 + i]; kk += Ks[c * 129 + i] * ks; qk += Qs[c * 129 + i] * ks; }
                const float dec = expf(gcs[c] - gcs[s]); kk *= dec * bts[c]; qk *= dec; }
            As[c * 68 + s] = (s < c) ? kk : 0.f; AQg[(size_t)L * 4096 + idx] = (s <= c) ? qk : 0.f; }
        __syncthreads();
        if (F.wave == 0) {
            for (int i = 0; i < 64; ++i) { float a = (i == lane) ? 1.f : 0.f;
#pragma unroll 4
                for (int j = 0; j < i; ++j) a -= As[i * 68 + j] * Tm[j * 68 + lane];
                Tm[i * 68 + lane] = a; }
        }
        __syncthreads();
        for (int idx = tid; idx < 64 * 256; idx += NTHR) { const int c = idx >> 8, col = idx & 255; float a = 0.f;
            if (col < 128) { for (int s = 0; s <= c; ++s) a += Tm[c * 68 + s] * bts[s] * Vs[s * 128 + col]; Ug[((size_t)h * T + t0 + c) * 128 + col] = a; }
            else { const int i = col - 128; for (int s = 0; s <= c; ++s) a += Tm[c * 68 + s] * bts[s] * egs[s] * Ks[s * 129 + i]; Wg[((size_t)h * T + t0 + c) * 128 + i] = a; } }
        const float glast = gcs[63];
        for (int idx = tid; idx < 64 * 128; idx += NTHR) { const int t = idx >> 7, i = idx & 127; const size_t o = ((size_t)h * T + t0 + t) * 128 + i;
            QDg[o] = Qs[t * 129 + i] * egs[t]; KDg[o] = Ks[t * 129 + i] * expf(glast - gcs[t]); }
        if (tid == 0) GLg[L] = expf(glast);
    }
}
__device__ __forceinline__ void gdn_scan_v1(Frame& F) {
    if (blockIdx.x >= 64) return;
    LAS float* Ssh = (LAS float*)F.lds;
    LAS float* Wsh = Ssh + 2048;
    LAS float* KDs = Wsh + 64 * 129;
    LAS float* Ush = KDs + 64 * 129;
    LAS float* VNs = Ush + 1024;
    const float* Ug = (const float*)(F.ws + WS_U); const float* Wg = (const float*)(F.ws + WS_W); const float* KDg = (const float*)(F.ws + WS_KD);
    const float* GLg = (const float*)(F.ws + WS_GL); float* SST = (float*)(F.ws + WS_SST);
    const int tid = F.tid, h = blockIdx.x >> 3, cb = blockIdx.x & 7;
    for (int idx = tid; idx < 2048; idx += NTHR) Ssh[idx] = 0.f;
    for (int n = 0; n < NCHUNK; ++n) {
        __syncthreads();
        const size_t base = ((size_t)h * T + n * 64) * 128;
        for (int idx = tid; idx < 64 * 128; idx += NTHR) { const int c = idx >> 7, i = idx & 127; Wsh[c * 129 + i] = Wg[base + idx]; KDs[c * 129 + i] = KDg[base + idx]; }
        for (int idx = tid; idx < 1024; idx += NTHR) { const int c = idx >> 4, j = idx & 15; Ush[idx] = Ug[base + c * 128 + cb * 16 + j]; }
        for (int idx = tid; idx < 2048; idx += NTHR) { const int i = idx >> 4, j = idx & 15; SST[(((size_t)h * NCHUNK + n) * 128 + i) * 128 + cb * 16 + j] = Ssh[idx]; }
        const float gl = GLg[n * 8 + h];
        __syncthreads();
        { const int c = tid >> 3, jp = (tid & 7) * 2; float a0 = 0.f, a1 = 0.f;
          for (int i = 0; i < 128; ++i) { const float w = Wsh[c * 129 + i]; a0 += w * Ssh[i * 16 + jp]; a1 += w * Ssh[i * 16 + jp + 1]; }
          VNs[c * 16 + jp] = Ush[c * 16 + jp] - a0; VNs[c * 16 + jp + 1] = Ush[c * 16 + jp + 1] - a1; }
        __syncthreads();
        { const int i = tid >> 2, jq = (tid & 3) * 4; float a[4];
#pragma unroll
          for (int x = 0; x < 4; ++x) a[x] = gl * Ssh[i * 16 + jq + x];
          for (int c = 0; c < 64; ++c) { const float kd = KDs[c * 129 + i];
#pragma unroll
              for (int x = 0; x < 4; ++x) a[x] += kd * VNs[c * 16 + jq + x]; }
#pragma unroll
          for (int x = 0; x < 4; ++x) Ssh[i * 16 + jq + x] = a[x]; }
    }
}
__device__ __forceinline__ void gdn_out_v1(Frame& F) {
    LAS float* Sh = (LAS float*)F.lds;
    LAS float* Wsh = Sh + 8192;
    LAS float* QDs = Wsh + 64 * 129;
    LAS float* VNh = QDs + 64 * 129;
    LAS float* AQ = VNh + 4096;
    const float* Ug = (const float*)(F.ws + WS_U); const float* Wg = (const float*)(F.ws + WS_W); const float* QDg = (const float*)(F.ws + WS_QD);
    const float* AQg = (const float*)(F.ws + WS_AQK); const float* SST = (const float*)(F.ws + WS_SST);
    const bf16* Pz = (const bf16*)(F.ws + WS_P) + 6 * PBUF; bf16* yb = (bf16*)(F.ws + WS_YB);
    const int tid = F.tid, c = tid >> 3, jg = tid & 7;
    for (int L = blockIdx.x; L < NH * NCHUNK; L += F.G) {
        const int n = L >> 3, h = L & 7, t0 = n * 64;
        const size_t base = ((size_t)h * T + t0) * 128;
        __syncthreads();
        for (int idx = tid; idx < 64 * 128; idx += NTHR) { const int cc = idx >> 7, i = idx & 127; Wsh[cc * 129 + i] = Wg[base + idx]; QDs[cc * 129 + i] = QDg[base + idx]; }
        for (int idx = tid; idx < 4096; idx += NTHR) AQ[(idx >> 6) * 68 + (idx & 63)] = AQg[(size_t)L * 4096 + idx];
        float oo[2][8];
#pragma unroll
        for (int half = 0; half < 2; ++half) {
            __syncthreads();
            for (int idx = tid; idx < 128 * 64; idx += NTHR) { const int i = idx >> 6, j = idx & 63; Sh[idx] = SST[(((size_t)h * NCHUNK + n) * 128 + i) * 128 + half * 64 + j]; }
            __syncthreads();
            float t1[8], qs[8];
#pragma unroll
            for (int x = 0; x < 8; ++x) { t1[x] = 0.f; qs[x] = 0.f; }
            for (int i = 0; i < 128; ++i) { const float w = Wsh[c * 129 + i], qd = QDs[c * 129 + i]; const LAS float* sr = Sh + i * 64 + jg * 8;
#pragma unroll
                for (int x = 0; x < 8; ++x) { t1[x] += w * sr[x]; qs[x] += qd * sr[x]; } }
#pragma unroll
            for (int x = 0; x < 8; ++x) VNh[c * 64 + jg * 8 + x] = Ug[base + (size_t)c * 128 + half * 64 + jg * 8 + x] - t1[x];
            __syncthreads();
            for (int s = 0; s <= c; ++s) { const float a = AQ[c * 68 + s]; const LAS float* vr = VNh + s * 64 + jg * 8;
#pragma unroll
                for (int x = 0; x < 8; ++x) qs[x] += a * vr[x]; }
#pragma unroll
            for (int x = 0; x < 8; ++x) oo[half][x] = qs[x];
        }
        float ss = 0.f;
#pragma unroll
        for (int half = 0; half < 2; ++half)
#pragma unroll
            for (int x = 0; x < 8; ++x) ss += oo[half][x] * oo[half][x];
        ss += __shfl_xor(ss, 1); ss += __shfl_xor(ss, 2); ss += __shfl_xor(ss, 4);
        const float r = rsqrtf(ss * (1.f / 128.f) + NORM_EPS);
#pragma unroll
        for (int half = 0; half < 2; ++half) { const int col = half * 64 + jg * 8; const size_t o = (size_t)(t0 + c) * 1024 + h * 128 + col;
            const v4u z = *(const GAS v4u*)(Pz + o); const float zz[8] = {bflo(z.x), bfhi(z.x), bflo(z.y), bfhi(z.y), bflo(z.z), bfhi(z.z), bflo(z.w), bfhi(z.w)};
            unsigned w[4];
#pragma unroll
            for (int x = 0; x < 4; ++x) w[x] = pk2(oo[half][2 * x] * r * F.in[5][col + 2 * x] * siluf_(zz[2 * x]), oo[half][2 * x + 1] * r * F.in[5][col + 2 * x + 1] * siluf_(zz[2 * x + 1]));
            *(GAS v4u*)(yb + o) = (v4u){w[0], w[1], w[2], w[3]}; }
    }
}

__device__ __forceinline__ void ln_router(Frame& F) {
    LAS float* X1s = (LAS float*)F.lds;
    LAS float* LG = (LAS float*)(F.lds + LDS_TAB);
    LAS int* hist = (LAS int*)(LG + 1024);
    LAS int* gbs = hist + 64;
    const float* y1 = (const float*)(F.ws + WS_Y1); float* x1f = (float*)(F.ws + WS_X1F); bf16* x1b = (bf16*)(F.ws + WS_X1B);
    int* tokl = (int*)(F.ws + WS_TOKL); float* wgtl = (float*)(F.ws + WS_WGTL); unsigned* info = (unsigned*)(F.ws + WS_INFO);
    const float* g1 = F.in[12]; const float* b1 = F.in[13]; const float* wr = F.in[14]; const float* rb = F.in[15];
    const int tid = F.tid, lane = F.lane;
    for (int blk = blockIdx.x; blk < T / 16; blk += F.G) {
        const int tb = blk * 16;
        __syncthreads();
        if (tid < 64) hist[tid] = 0;
#pragma unroll 1
        for (int tt = 0; tt < 2; ++tt) { const int tl = F.wave * 2 + tt, tok = tb + tl;
            const GAS f32x4* yr = (const GAS f32x4*)(y1 + (size_t)tok * D) + lane; f32x4 v[8]; float s = 0.f;
#pragma unroll
            for (int j = 0; j < 8; ++j) { v[j] = yr[64 * j]; s += (v[j].x + v[j].y) + (v[j].z + v[j].w); }
            const float mean = wave_sum(s) * (1.f / D); float s2 = 0.f;
#pragma unroll
            for (int j = 0; j < 8; ++j) { v[j] = v[j] - mean; s2 += (v[j].x * v[j].x + v[j].y * v[j].y) + (v[j].z * v[j].z + v[j].w * v[j].w); }
            const float rstd = rsqrtf(wave_sum(s2) * (1.f / D) + LN_EPS);
#pragma unroll
            for (int j = 0; j < 8; ++j) { const int col = j * 256 + lane * 4; const f32x4 gg = *(const GAS f32x4*)(g1 + col), bb = *(const GAS f32x4*)(b1 + col);
                const f32x4 xo = v[j] * rstd * gg + bb;
                *(GAS f32x4*)(x1f + (size_t)tok * D + col) = xo; *(GAS v2u*)(x1b + (size_t)tok * D + col) = (v2u){pk2(xo.x, xo.y), pk2(xo.z, xo.w)};
                *(LAS f32x4*)(X1s + tl * 2048 + col) = xo; }
            if (lane == 0) { tokl[NE * T + tok] = tok; wgtl[NE * T + tok] = 1.f; } }
        __syncthreads();
        { const int tl = tid >> 5, e0 = (tid & 31) * 2; const LAS float* xr = X1s + tl * 2048; float a0 = 0.f, a1 = 0.f;
#pragma unroll 4
          for (int d = 0; d < D; ++d) { const f32x2 w = *(const GAS f32x2*)(wr + (size_t)d * NE + e0); const float xv = xr[d]; a0 += xv * w.x; a1 += xv * w.y; }
          LG[tl * 64 + e0] = a0; LG[tl * 64 + e0 + 1] = a1; }
        __syncthreads();
        bool sel[2]; int loc[2]; float wsl[2]; unsigned long long msk[2];
#pragma unroll
        for (int tt = 0; tt < 2; ++tt) { const int tl = F.wave * 2 + tt;
            const float score = 1.f / (1.f + expf(-LG[tl * 64 + lane])), ch = score + rb[lane];
            int rk = 0;
#pragma unroll
            for (int x = 1; x < 8; ++x) { const float cj = __shfl_xor(ch, x); rk += (cj > ch || (cj == ch && (lane ^ x) < lane)) ? 1 : 0; }
            float gs = rk < 2 ? ch : 0.f; gs += __shfl_xor(gs, 1); gs += __shfl_xor(gs, 2); gs += __shfl_xor(gs, 4);
            const int g = lane >> 3; int grk = 0;
#pragma unroll
            for (int x = 1; x < 8; ++x) { const float gj = __shfl_xor(gs, 8 * x); grk += (gj > gs || (gj == gs && (g ^ x) < g)) ? 1 : 0; }
            const float mk = grk < 4 ? ch : -INFINITY; int erk = 0;
#pragma unroll
            for (int j = 0; j < 64; ++j) { const float mj = __builtin_bit_cast(float, __builtin_amdgcn_readlane(__builtin_bit_cast(int, mk), j)); erk += (mj > mk || (mj == mk && j < lane)) ? 1 : 0; }
            sel[tt] = (grk < 4) && (erk < TOPK);
            const float ssum = wave_sum(sel[tt] ? score : 0.f); wsl[tt] = score / ssum * ROUTED_SCALE;
            msk[tt] = __ballot(sel[tt]);
            loc[tt] = sel[tt] ? atomicAdd((int*)&hist[lane], 1) : 0; }
        __syncthreads();
        if (tid < 64) { const int hc = hist[tid]; gbs[tid] = hc ? (int)__hip_atomic_fetch_add(F.ctl + CW_CNT + 64 * tid, (unsigned)hc, RLX_AGENT) : 0; }
        __syncthreads();
#pragma unroll
        for (int tt = 0; tt < 2; ++tt) if (sel[tt]) { const int tok = tb + F.wave * 2 + tt, slot = gbs[lane] + loc[tt];
            tokl[lane * T + slot] = tok; wgtl[lane * T + slot] = wsl[tt];
            const int k = __popcll(msk[tt] & ((1ull << lane) - 1ull)); info[tok * 8 + k] = ((unsigned)lane << 16) | (unsigned)slot; }
    }
}
__device__ __forceinline__ void final_ln(Frame& F) {
    moe_tables(F);
    const LAS int* rbase = (const LAS int*)(F.lds + LDS_TAB) + 72;
    const float* x1f = (const float*)(F.ws + WS_X1F); const bf16* yas = (const bf16*)(F.ws + WS_YAS); const unsigned* info = (const unsigned*)(F.ws + WS_INFO);
    const float* g2 = F.in[22]; const float* b2 = F.in[23];
    const int lane = F.lane;
    for (int tok = F.vcu * NWAVES + F.wave; tok < T; tok += F.G * NWAVES) {
        f32x4 v[8];
        const GAS f32x4* xr = (const GAS f32x4*)(x1f + (size_t)tok * D) + lane;
#pragma unroll
        for (int j = 0; j < 8; ++j) v[j] = xr[64 * j] * ALPHA;
        for (int k = 0; k < 9; ++k) { int row;
            if (k < 8) { const unsigned w = info[tok * 8 + k]; row = rbase[w >> 16] + (int)(w & 0xffffu); } else row = NE * T * 0 + 65536 + tok;
            const GAS v2u* yr = (const GAS v2u*)(yas + (size_t)row * D) + lane;
#pragma unroll
            for (int j = 0; j < 8; ++j) { const v2u w = yr[64 * j]; v[j] = v[j] + (f32x4){bflo(w.x), bfhi(w.x), bflo(w.y), bfhi(w.y)}; } }
        float s = 0.f;
#pragma unroll
        for (int j = 0; j < 8; ++j) s += (v[j].x + v[j].y) + (v[j].z + v[j].w);
        const float mean = wave_sum(s) * (1.f / D); float s2 = 0.f;
#pragma unroll
        for (int j = 0; j < 8; ++j) { v[j] = v[j] - mean; s2 += (v[j].x * v[j].x + v[j].y * v[j].y) + (v[j].z * v[j].z + v[j].w * v[j].w); }
        const float rstd = rsqrtf(wave_sum(s2) * (1.f / D) + LN_EPS);
#pragma unroll
        for (int j = 0; j < 8; ++j) { const int col = j * 256 + lane * 4; const f32x4 gg = *(const GAS f32x4*)(g2 + col), bb = *(const GAS f32x4*)(b2 + col);
            *(GAS f32x4*)(F.out + (size_t)tok * D + col) = v[j] * rstd * gg + bb; }
    }
}

struct Args { const float* in[24]; float* out; unsigned char* ws; int ph_lo, ph_hi; };
__global__ void __launch_bounds__(NTHR, 2) fwd(Args args) {
    extern __shared__ __attribute__((aligned(16))) unsigned char lds[];
    Frame F;
    F.lds = (LAS unsigned char*)lds;
    F.tid = threadIdx.x; F.lane = F.tid & 63; F.wave = __builtin_amdgcn_readfirstlane(F.tid >> 6);
    F.G = gridDim.x; { const int bx = blockIdx.x; F.vcu = (F.G % 8 == 0) ? (bx % 8) * (F.G / 8) + bx / 8 : bx; }
    F.ws = args.ws; F.ctl = (gu32*)(args.ws + WS_CTL); F.out = args.out;
#pragma unroll
    for (int i = 0; i < 24; ++i) F.in[i] = args.in[i];
    volatile LAS unsigned* MISC = (volatile LAS unsigned*)(F.lds + MISC_OFF);
    if (F.tid < 64) MISC[F.tid] = 0u;
    __syncthreads();
    const int lo = args.ph_lo, hi = args.ph_hi;
    const bool multi = (hi - lo) > 1;
    XcdBarrier bar; bar.bar = (unsigned*)(F.ctl + CW_BAR); bar.x = 0; bar.st = nullptr;
    if (multi) bar = xcd_barrier_post((unsigned*)(F.ctl + CW_BAR), MISC + 8);
#ifndef ONLY_PHASE
#define ONLY_PHASE -1
#endif
#define IN(k) ((ONLY_PHASE < 0 || ONLY_PHASE == (k)) && lo <= (k) && (k) < hi)
#define SEAM(k) do { if (IN(k) && IN((k) + 1)) xcd_barrier(bar); } while (0)
    unsigned char* ws = args.ws;
    if (IN(0)) { p0_prologue(F); SEAM(0); }
    if (IN(1)) {
        pg8::Gemm g{(const bf16*)(ws + WS_XB), (const bf16*)(ws + WS_WIN), T, NPROJ, D}; pg8::StaticOrder S; S.init(T, NPROJ, F.G, (int)blockIdx.x);
        EpiProj E{(bf16*)(ws + WS_P)};
        pg8::gemm_phase<EpiProj, pg8::StaticOrder, true, false>(F.lds, g, S, E);
        SEAM(1);
    }
    if (IN(2)) { attn_v1(F); SEAM(2); }
    if (IN(3)) { gdn_prep_v1(F); SEAM(3); }
    if (IN(4)) { gdn_scan_v1(F); SEAM(4); }
    if (IN(5)) { gdn_out_v1(F); SEAM(5); }
    if (IN(6)) {
        { pg8::Gemm g{(const bf16*)(ws + WS_YA), (const bf16*)(ws + WS_WA), T, D, 1024}; pg8::StaticOrder S; S.init(T, D, F.G, (int)blockIdx.x);
          EpiBranch<0> E{(const bf16*)(ws + WS_P) + 7 * PBUF, (float*)(ws + WS_TMP), (bf16*)(ws + WS_MRG)};
          pg8::gemm_phase<EpiBranch<0>, pg8::StaticOrder, true, false>(F.lds, g, S, E); }
        VM_WAIT(); __syncthreads();
        { pg8::Gemm g{(const bf16*)(ws + WS_YB), (const bf16*)(ws + WS_WB), T, D, 1024}; pg8::StaticOrder S; S.init(T, D, F.G, (int)blockIdx.x);
          EpiBranch<1> E{(const bf16*)(ws + WS_P) + 9 * PBUF, (float*)(ws + WS_TMP), (bf16*)(ws + WS_MRG)};
          pg8::gemm_phase<EpiBranch<1>, pg8::StaticOrder, true, false>(F.lds, g, S, E); }
        SEAM(6);
    }
    if (IN(7)) {
        pg8::Gemm g{(const bf16*)(ws + WS_MRG), (const bf16*)(ws + WS_WO), T, D, D}; pg8::StaticOrder S; S.init(T, D, F.G, (int)blockIdx.x);
        EpiOut E{F.in[0], (float*)(ws + WS_Y1)};
        pg8::gemm_phase<EpiOut, pg8::StaticOrder, true, false>(F.lds, g, S, E);
        SEAM(7);
    }
    if (IN(8)) { ln_router(F); SEAM(8); }
    if (IN(9)) {
        moe_tables(F);
        const LAS int* tp = (const LAS int*)(F.lds + LDS_TAB);
        MoeOrder S{tp, tp + 72, tp + 144, (const int*)(ws + WS_TOKL), 4, F.G, (int)blockIdx.x, 1024};
        pg8::Gemm g{(const bf16*)(ws + WS_X1B), (const bf16*)(ws + WS_WGU), T, 1024, D};
        EpiGU E{(bf16*)(ws + WS_HB)};
        pg8::gemm_phase<EpiGU, MoeOrder, true, true>(F.lds, g, S, E);
        SEAM(9);
    }
    if (IN(10)) {
        moe_tables(F);
        const LAS int* tp = (const LAS int*)(F.lds + LDS_TAB);
        MoeOrder S{tp, tp + 72, tp + 144, (const int*)(ws + WS_TOKL), 8, F.G, (int)blockIdx.x, D};
        pg8::Gemm g{(const bf16*)(ws + WS_HB), (const bf16*)(ws + WS_WD), T, D, FF};
        EpiDown E{(bf16*)(ws + WS_YAS), (const float*)(ws + WS_WGTL)};
        pg8::gemm_phase<EpiDown, MoeOrder, true, false>(F.lds, g, S, E);
        SEAM(10);
    }
    if (IN(11)) { final_ln(F); }
#undef IN
#undef SEAM
}

extern "C" void kernel_launch(void* const* d_in, const int* in_sizes, int n_in, void* d_out, int out_size, void* d_ws, size_t ws_size, hipStream_t stream) {
    static int grid = 0;
    if (grid == 0) {
        if (n_in != 24 || in_sizes[0] != T * D || out_size != T * D || ws_size < WS_END) { fprintf(stderr, "kernel_launch: unexpected shapes (n_in %d, ws %zu); nothing launched\n", n_in, ws_size); grid = -1; return; }
        int dev = 0, cus = 0, per_cu = 0;
        if (hipGetDevice(&dev) != hipSuccess || hipDeviceGetAttribute(&cus, hipDeviceAttributeMultiprocessorCount, dev) != hipSuccess) { grid = -1; return; }
        if (hipFuncSetAttribute((const void*)fwd, hipFuncAttributeMaxDynamicSharedMemorySize, LDS_BYTES) != hipSuccess) { fprintf(stderr, "kernel_launch: hipFuncSetAttribute failed\n"); grid = -1; return; }
        if (hipOccupancyMaxActiveBlocksPerMultiprocessor(&per_cu, (const void*)fwd, NTHR, LDS_BYTES) != hipSuccess || per_cu < 1) { fprintf(stderr, "kernel_launch: occupancy query says %d\n", per_cu); }
        (void)hipGetLastError();
        grid = cus;
    }
    if (grid < 0) return;
    if (hipMemsetAsync((char*)d_ws + WS_CTL, 0, CTL_ZERO_BYTES, stream) != hipSuccess) return;
    Args a{};
    for (int i = 0; i < 24; ++i) a.in[i] = (const float*)d_in[i];
    a.out = (float*)d_out; a.ws = (unsigned char*)d_ws;
#if MK_N_LAUNCHES == 1
    a.ph_lo = 0; a.ph_hi = NPHASE;
    hipLaunchKernelGGL(fwd, dim3(grid), dim3(NTHR), LDS_BYTES, stream, a);
#else
    for (int p = 0; p < NPHASE; ++p) { a.ph_lo = p; a.ph_hi = p + 1; hipLaunchKernelGGL(fwd, dim3(grid), dim3(NTHR), LDS_BYTES, stream, a); }
#endif
}
```

```cpp
#include <hip/hip_runtime.h>
#include <cstdio>
#include <cstdint>

#ifndef MK_N_LAUNCHES
#define MK_N_LAUNCHES 1
#endif

namespace pg8 {
#define PG8_LAS __attribute__((address_space(3)))
typedef unsigned short bf16_t;
typedef short bf16x8 __attribute__((ext_vector_type(8)));
typedef float f32x4 __attribute__((ext_vector_type(4)));
typedef unsigned u32x4 __attribute__((ext_vector_type(4)));
typedef unsigned u32x2 __attribute__((ext_vector_type(2)));
constexpr int BM = 256, BK = 64, HALF = 128, HTB = HALF * BK * 2  , STAGE_BYTES = 8 * HTB, NXCD = 8, WGM = 8;

__host__ __device__ __forceinline__ int lds_byte(int r, int c) { const int st = (r >> 4) * 2 + (c >> 5), rr = r & 15, cc = c & 31, ob = rr * 64 + cc * 2; return st * 1024 + (ob ^ (((ob >> 9) & 1) << 5)); }
__host__ __device__ __forceinline__ void stage_rc(int b, int& R, int& C) { const int st = b / 1024, sb = b % 1024, swz = sb ^ (((sb >> 9) & 1) << 5); R = (st >> 1) * 16 + swz / 64; C = (st & 1) * 32 + (swz % 64) / 2; }
__host__ __device__ __forceinline__ int perm32(int rho) { const int n = rho >> 4, i = rho & 15; return 8 * (i >> 2) + 4 * n + (i & 3); }

struct Unit { int pm, pn, arow, brow, r0, nv, e, lb; };
struct Gemm { const bf16_t* A; const bf16_t* Bt; int M, N, K; };

struct StaticOrder {
    int nM, nN, nwg, G, c;
    __host__ __device__ void init(int M, int N, int G_, int c_) { nM = M / BM; nN = N / BM; nwg = nM * nN; G = G_; c = c_; }
    __host__ __device__ bool next(int i, Unit& u) const {
        const long L = (long)i * G + c; if (L >= nwg) return false;
        int wgid = (int)L; { const int q = nwg / NXCD, r = nwg % NXCD, xcd = wgid % NXCD, off = wgid / NXCD; wgid = (xcd < r ? xcd * (q + 1) : r * (q + 1) + (xcd - r) * q) + off; }
        const int nig = WGM * nN, gid = wgid / nig, fm = gid * WGM, gsz = (nM - fm) < WGM ? (nM - fm) : WGM;
        u.pm = fm + ((wgid % nig) % gsz); u.pn = (wgid % nig) / gsz; u.arow = u.pm * BM; u.brow = u.pn * BM; u.r0 = u.arow; u.nv = BM; u.e = 0; u.lb = 0; return true;
    }
    __device__ __forceinline__ int row_of(const Unit&, int) const { return 0; }
};

__device__ __forceinline__ unsigned cvt_pk_bf16(float lo, float hi) { unsigned r; asm volatile("v_cvt_pk_bf16_f32 %0, %1, %2" : "=v"(r) : "v"(lo), "v"(hi)); return r; }

template <class Epi, class Sched, bool ALIGN_EPI, bool GATHER>
__device__ __forceinline__ void gemm_phase(PG8_LAS unsigned char* lds, const Gemm g, const Sched& S, const Epi& E) {
    static_assert(Epi::PERM, "epilogues use the PERM column layout");
    const int tid = threadIdx.x, wid = __builtin_amdgcn_readfirstlane(tid >> 6), lane = tid & 63, wr = wid >> 2, wc = wid & 3, fr = lane & 15, fq = lane >> 4;
    const int K = g.K, nt = K / BK;
    unsigned voffA[2], voffB[2]; int stR[2], stC[2];
#pragma unroll
    for (int i = 0; i < 2; ++i) { int R, C; stage_rc(tid * 16 + i * 8192, R, C); const int Rb = (R & ~31) + perm32(R & 31); stR[i] = R; stC[i] = C;
        voffA[i] = (unsigned)(R * K + C) * 2u; voffB[i] = (unsigned)(Rb * K + C) * 2u; }
    const size_t kstep = (size_t)(BK * 2);
    const size_t hstep = (size_t)HALF * K * 2;
    const size_t rstep = (size_t)K * 2;
    const unsigned ldsw = (unsigned)wid * 1024u;
    const int aoff = lds_byte(wr * 64 + fr, fq * 8), boff = lds_byte(wc * 32 + fr, fq * 8);
#define PG8_SA(b, h) (((b) * 2 + (h)) * HTB)
#define PG8_SB(b, h) ((4 + (b) * 2 + (h)) * HTB)
#define PG8_STAGE(bufoff, gbase, voff) do { _Pragma("unroll") for (int _i = 0; _i < 2; ++_i) \
        __builtin_amdgcn_global_load_lds((const unsigned*)((const char*)(gbase) + (voff)[_i]), (PG8_LAS unsigned*)(lds + (bufoff) + ldsw + _i * 8192), 16, 0, 0); } while (0)
#define PG8_STAGE_A(b, h, P, V) do { if constexpr (GATHER) { PG8_STAGE(PG8_SA(b, h), P, V[h]); } else { PG8_STAGE(PG8_SA(b, h), (P) + (h) * hstep, voffA); } } while (0)
#define PG8_LDA(dst, b, h) do { _Pragma("unroll") for (int m = 0; m < 4; ++m) _Pragma("unroll") for (int k = 0; k < 2; ++k) dst[m][k] = *(const PG8_LAS bf16x8*)(lds + PG8_SA(b, h) + aoff + m * 2048 + k * 1024); } while (0)
#define PG8_LDB(dst, b, h) do { _Pragma("unroll") for (int n = 0; n < 2; ++n) _Pragma("unroll") for (int k = 0; k < 2; ++k) dst[n][k] = *(const PG8_LAS bf16x8*)(lds + PG8_SB(b, h) + boff + n * 2048 + k * 1024); } while (0)
#define PG8_MMA(ai, bj, At, Bt) do { __builtin_amdgcn_s_setprio(1); _Pragma("unroll") for (int m = 0; m < 4; ++m) _Pragma("unroll") for (int n = 0; n < 2; ++n) _Pragma("unroll") for (int k = 0; k < 2; ++k) \
        acc[ai][bj][m][n] = __builtin_amdgcn_mfma_f32_16x16x32_bf16(Bt[n][k], At[m][k], acc[ai][bj][m][n], 0, 0, 0); __builtin_amdgcn_s_setprio(0); } while (0)
#define PG8_WAIT_V(n) asm volatile("s_waitcnt vmcnt(" #n ")" ::: "memory")
#define PG8_WAIT_L(n) asm volatile("s_waitcnt lgkmcnt(" #n ")" ::: "memory")
#define PG8_BAR __builtin_amdgcn_s_barrier()
#define PG8_SCHED __builtin_amdgcn_sched_barrier(0)
#define PG8_GOFF(V, u) do { if constexpr (GATHER) { _Pragma("unroll") for (int _h = 0; _h < 2; ++_h) _Pragma("unroll") for (int _i = 0; _i < 2; ++_i) \
        V[_h][_i] = (unsigned)(S.row_of(u, _h * HALF + stR[_i]) * K + stC[_i]) * 2u; } } while (0)
    Unit cur, nxt; int ui = 0;
    if (!S.next(0, cur)) return;
    f32x4 acc[2][2][4][2];
#pragma unroll
    for (int a = 0; a < 2; ++a)
#pragma unroll
        for (int b = 0; b < 2; ++b)
#pragma unroll
            for (int m = 0; m < 4; ++m)
#pragma unroll
                for (int n = 0; n < 2; ++n) acc[a][b][m][n] = (f32x4){0.f, 0.f, 0.f, 0.f};
    bf16x8 At[4][2], B0[2][2], B1[2][2];
    unsigned vcur[2][2] = {{0u, 0u}, {0u, 0u}}, vnxt[2][2] = {{0u, 0u}, {0u, 0u}}, v2[2][2] = {{0u, 0u}, {0u, 0u}};
    PG8_GOFF(vcur, cur);
    const char* cA = GATHER ? (const char*)g.A : (const char*)g.A + (size_t)cur.arow * rstep; const char* cB = (const char*)g.Bt + (size_t)cur.brow * rstep;
    PG8_STAGE(PG8_SB(0, 0), cB, voffB); PG8_STAGE(PG8_SB(0, 1), cB + hstep, voffB); PG8_STAGE_A(0, 0, cA, vcur); PG8_STAGE_A(0, 1, cA, vcur);
    if (wr == 1) PG8_BAR;
    PG8_WAIT_V(2); PG8_BAR;
    PG8_STAGE(PG8_SB(1, 0), cB + kstep, voffB); PG8_STAGE_A(1, 0, cA + kstep, vcur); PG8_STAGE(PG8_SB(1, 1), cB + hstep + kstep, voffB);
    PG8_WAIT_V(6); PG8_BAR;
    for (;;) {
        const bool has_next = S.next(ui + 1, nxt);
        if constexpr (GATHER) { if (has_next) { PG8_GOFF(vnxt, nxt); } else {
#pragma unroll
            for (int h = 0; h < 2; ++h)
#pragma unroll
                for (int i = 0; i < 2; ++i) vnxt[h][i] = vcur[h][i]; } }
        const char* nA = GATHER ? cA : (has_next ? (const char*)g.A + (size_t)nxt.arow * rstep : cA); const char* nB = has_next ? (const char*)g.Bt + (size_t)nxt.brow * rstep : cB;
        for (int t = 0; t < nt; t += 2) {
            const bool last = (t == nt - 2);
            const char* a1 = cA + (size_t)(t + 1) * kstep;
            const char* a2 = last ? nA : cA + (size_t)(t + 2) * kstep; const char* b2 = last ? nB : cB + (size_t)(t + 2) * kstep;
            const char* a3 = a2 + kstep; const char* b3 = b2 + kstep;
            if constexpr (GATHER) {
#pragma unroll
                for (int h = 0; h < 2; ++h)
#pragma unroll
                    for (int i = 0; i < 2; ++i) v2[h][i] = last ? vnxt[h][i] : vcur[h][i]; }
            PG8_LDB(B0, 0, 0); PG8_LDB(B1, 0, 1); PG8_SCHED; PG8_LDA(At, 0, 0); PG8_STAGE_A(1, 1, a1, vcur);
            PG8_WAIT_V(8); PG8_WAIT_L(0); PG8_BAR; PG8_MMA(0, 0, At, B0); PG8_MMA(0, 1, At, B1); PG8_BAR; PG8_SCHED;
            PG8_LDA(At, 0, 1); PG8_STAGE(PG8_SB(0, 0), b2, voffB); PG8_STAGE(PG8_SB(0, 1), b2 + hstep, voffB); PG8_STAGE_A(0, 0, a2, v2);
            PG8_WAIT_V(8); PG8_WAIT_L(0); PG8_BAR; PG8_MMA(1, 0, At, B0); PG8_MMA(1, 1, At, B1); PG8_BAR; PG8_SCHED;
            PG8_LDB(B0, 1, 0); PG8_LDB(B1, 1, 1); PG8_SCHED; PG8_LDA(At, 1, 0); PG8_STAGE_A(0, 1, a2, v2);
            PG8_WAIT_V(8); PG8_WAIT_L(0); PG8_BAR; PG8_MMA(0, 0, At, B0); PG8_MMA(0, 1, At, B1); PG8_BAR; PG8_SCHED;
            PG8_LDA(At, 1, 1); PG8_STAGE(PG8_SB(1, 0), b3, voffB); PG8_STAGE(PG8_SB(1, 1), b3 + hstep, voffB); PG8_STAGE_A(1, 0, a3, v2);
            PG8_WAIT_V(8); PG8_WAIT_L(0); PG8_BAR; PG8_MMA(1, 0, At, B0); PG8_MMA(1, 1, At, B1); PG8_BAR; PG8_SCHED;
        }
        if constexpr (ALIGN_EPI) { if (wr == 0) PG8_BAR; }
        E(acc, cur, wr, wc, fr, fq);
        if (!has_next) break;
#pragma unroll
        for (int a = 0; a < 2; ++a)
#pragma unroll
            for (int b = 0; b < 2; ++b)
#pragma unroll
                for (int m = 0; m < 4; ++m)
#pragma unroll
                    for (int n = 0; n < 2; ++n) acc[a][b][m][n] = (f32x4){0.f, 0.f, 0.f, 0.f};
        cur = nxt; cA = nA; cB = nB; ++ui;
        if constexpr (GATHER) {
#pragma unroll
            for (int h = 0; h < 2; ++h)
#pragma unroll
                for (int i = 0; i < 2; ++i) vcur[h][i] = vnxt[h][i]; }
        if constexpr (ALIGN_EPI) { if (wr == 1) PG8_BAR; }
    }
    PG8_WAIT_V(0);
    if constexpr (!ALIGN_EPI) { if (wr == 0) PG8_BAR; }
    PG8_BAR;
#undef PG8_SA
#undef PG8_SB
#undef PG8_STAGE
#undef PG8_STAGE_A
#undef PG8_LDA
#undef PG8_LDB
#undef PG8_MMA
#undef PG8_WAIT_V
#undef PG8_WAIT_L
#undef PG8_BAR
#undef PG8_SCHED
#undef PG8_GOFF
}
}

constexpr int NWAVES = 8, NTHR = 512;
constexpr int T = 8192, D = 2048, NPROJ = 11264, WIN_PITCH = 11280, NH = 8, NE = 64, NEX = 65, FF = 512, TOPK = 8, NCHUNK = 128;
constexpr float ALPHA = 1.18920711500272106672f, LN_EPS = 1e-5f, NORM_EPS = 1e-6f, LAMBDA_INIT = 0.2f, ROUTED_SCALE = 2.5f;
constexpr int NPHASE = 12;

constexpr size_t MiB = 1u << 20;
constexpr size_t WS_CTL = 0, CTL_ZERO_BYTES = 1 * MiB;
constexpr size_t WS_WA = 2 * MiB, WS_WB = 6 * MiB, WS_WO = 10 * MiB, WS_WGU = 18 * MiB, WS_WD = 278 * MiB;
constexpr size_t WS_X1F = 408 * MiB, WS_X1B = 472 * MiB, WS_YA = 504 * MiB, WS_YB = 520 * MiB;
constexpr size_t WS_TOKL = 536 * MiB, WS_WGTL = 539 * MiB, WS_INFO = 542 * MiB, WS_GL = 542 * MiB + 512 * 1024, WS_GAB = 543 * MiB;
constexpr size_t WS_WIN = 544 * MiB, WS_XB = 588 * MiB, WS_P = 620 * MiB;
constexpr size_t WS_U = 796 * MiB, WS_W = 828 * MiB, WS_QD = 860 * MiB, WS_KD = 892 * MiB, WS_AQK = 924 * MiB, WS_SST = 940 * MiB, WS_END = 1004 * MiB;
constexpr size_t WS_TMP = 796 * MiB, WS_MRG = 860 * MiB, WS_Y1 = 892 * MiB;
constexpr size_t WS_HB = 544 * MiB, WS_YAS = 620 * MiB;
constexpr size_t PBUF = (size_t)T * 1024;
constexpr int CW_BAR = 4096;
constexpr int CW_CNT = 32768;

constexpr int RING_BYTES = 131072;
constexpr int LDS_TAB = RING_BYTES;
constexpr int MISC_OFF = RING_BYTES + 16384 - 256;
constexpr int LDS_BYTES = RING_BYTES + 16384;

#define GAS __attribute__((address_space(1)))
#define LAS __attribute__((address_space(3)))
typedef unsigned short bf16;
typedef unsigned v4u __attribute__((ext_vector_type(4)));
typedef unsigned v2u __attribute__((ext_vector_type(2)));
typedef float f32x4 __attribute__((ext_vector_type(4)));
typedef float f32x2 __attribute__((ext_vector_type(2)));
typedef short bf16x8 __attribute__((ext_vector_type(8)));
typedef GAS unsigned gu32;
#define RLX_AGENT __ATOMIC_RELAXED, __HIP_MEMORY_SCOPE_AGENT
#define LDS_WAIT() asm volatile("s_waitcnt lgkmcnt(0)" ::: "memory")
#define VM_WAIT() asm volatile("s_waitcnt vmcnt(0)" ::: "memory")
__device__ __forceinline__ unsigned f2bf(float f) { unsigned u = __builtin_bit_cast(unsigned, f); return (u + 0x7fffu + ((u >> 16) & 1u)) >> 16; }
__device__ __forceinline__ unsigned pk2(float lo, float hi) { return f2bf(lo) | (f2bf(hi) << 16); }
__device__ __forceinline__ float bflo(unsigned w) { return __builtin_bit_cast(float, w << 16); }
__device__ __forceinline__ float bfhi(unsigned w) { return __builtin_bit_cast(float, w & 0xffff0000u); }
__device__ __forceinline__ float bf2f(bf16 b) { return __builtin_bit_cast(float, (unsigned)b << 16); }
__device__ __forceinline__ float sigmoidf_(float x) { return 1.f / (1.f + __expf(-x)); }
__device__ __forceinline__ float siluf_(float x) { return x / (1.f + __expf(-x)); }

#define XB_TMO      128
#define XB_XCNT(j)  (256  + 64 * (j))
#define XB_XSUB(j)  (1280 + 64 * (j))
#define XB_XGEN(j)  (2304 + 64 * (j))
#define XB_TOP      3328
#define XB_TOPGEN   3392
#define XCD_BAR_WORDS 3456
#define XB_SPIN_CAP (1u << 22)

__device__ __forceinline__ unsigned xb_ld(unsigned* p)              { return __hip_atomic_load(p, __ATOMIC_RELAXED, __HIP_MEMORY_SCOPE_AGENT); }
__device__ __forceinline__ unsigned xb_add(unsigned* p, unsigned v) { return __hip_atomic_fetch_add(p, v, __ATOMIC_RELAXED, __HIP_MEMORY_SCOPE_AGENT); }
__device__ __forceinline__ unsigned xb_xcc_id() { return (unsigned)__builtin_amdgcn_s_getreg((3 << 11) | 20) & 0xFu; }
#define XB_SPIN(cond, bar) do { unsigned _sp = 0; while (cond) { __builtin_amdgcn_s_sleep(1); \
    if ((++_sp & 255u) == 0u) { if (xb_ld(&(bar)[XB_TMO])) break; if (_sp > XB_SPIN_CAP) { atomicAdd(&(bar)[XB_TMO], 1u); break; } } } } while (0)

struct XcdBarrier {
    unsigned* bar; unsigned x;
    volatile LAS unsigned* st;
};
__device__ __forceinline__ XcdBarrier xcd_barrier_post(unsigned* bar, volatile LAS unsigned* st) {
    XcdBarrier b; b.bar = bar; b.x = xb_xcc_id(); b.st = st;
    if (threadIdx.x == 0) (void)xb_add(&bar[XB_XCNT(b.x)], 1u);
    return b;
}
__device__ __forceinline__ void xcd_barrier_complete(unsigned* bar, unsigned x, unsigned& nloc, unsigned& nx) {
    const unsigned G = gridDim.x * gridDim.y * gridDim.z;
    unsigned sum, cnt, mine, sp = 0u;
    for (;;) {
        sum = 0u; cnt = 0u; mine = 0u;
#pragma unroll
        for (unsigned j = 0; j < 16; ++j) { const unsigned c = xb_ld(&bar[XB_XCNT(j)]); sum += c; cnt += (c > 0u) ? 1u : 0u; mine = (j == x) ? c : mine; }
        if (sum == G) break;
        __builtin_amdgcn_s_sleep(1);
        if ((++sp & 255u) == 0u) { if (xb_ld(&bar[XB_TMO])) break; if (sp > XB_SPIN_CAP) { atomicAdd(&bar[XB_TMO], 1u); break; } }
    }
    nloc = mine > 0u ? mine : 1u; nx = cnt > 0u ? cnt : 1u;
}
__device__ __forceinline__ void xcd_barrier(const XcdBarrier& b) {
    asm volatile("s_waitcnt vmcnt(0)" ::: "memory");
    __syncthreads();
    if (threadIdx.x == 0) {
        unsigned* bar = b.bar;
        __builtin_amdgcn_s_waitcnt(0);
        unsigned nloc = b.st[0], nx = b.st[1];
        if (nloc == 0u) { xcd_barrier_complete(bar, b.x, nloc, nx); b.st[0] = nloc; b.st[1] = nx; }
        const unsigned old = xb_add(&bar[XB_XSUB(b.x)], 1u);
        const unsigned gen = old / nloc;
        if (old + 1u == (gen + 1u) * nloc) {
            __builtin_amdgcn_fence(__ATOMIC_RELEASE, "agent");
            asm volatile("s_waitcnt vmcnt(0)" ::: "memory");
            const unsigned og = xb_add(&bar[XB_TOP], 1u);
            const unsigned tg = og / nx;
            if (og + 1u == (tg + 1u) * nx) xb_add(&bar[XB_TOPGEN], 1u);
            else XB_SPIN(xb_ld(&bar[XB_TOPGEN]) == tg, bar);
            __builtin_amdgcn_fence(__ATOMIC_ACQUIRE, "agent");
            xb_add(&bar[XB_XGEN(b.x)], 1u);
            asm volatile("s_waitcnt vmcnt(0)" ::: "memory");
        } else {
            XB_SPIN(xb_ld(&bar[XB_XGEN(b.x)]) == gen, bar);
            __builtin_amdgcn_fence(__ATOMIC_ACQUIRE, "agent");
            asm volatile("s_waitcnt vmcnt(0)" ::: "memory");
        }
    }
    __syncthreads();
}

struct Frame {
    LAS unsigned char* lds;
    gu32* ctl;
    int tid, lane, wave;
    int vcu, G;
    const float* in[24]; float* out; unsigned char* ws;
};
__device__ __forceinline__ float wave_sum(float v) {
#pragma unroll
    for (int o = 1; o < 64; o <<= 1) v += __shfl_xor(v, o);
    return v;
}
__device__ __forceinline__ float wave_max(float v) {
#pragma unroll
    for (int o = 1; o < 64; o <<= 1) v = fmaxf(v, __shfl_xor(v, o));
    return v;
}

__device__ __forceinline__ void p0_transpose_item(const float* W, int pitch, int sn0, bf16* WT, int dpitch, int dr0, int k0, LAS float* scr, int lane) {
#pragma unroll 8
    for (int i = 0; i < 32; ++i) { const int kk = 2 * i + (lane >> 5); scr[kk * 33 + (lane & 31)] = W[(size_t)(k0 + kk) * pitch + sn0 + (lane & 31)]; }
    LDS_WAIT(); asm volatile("" ::: "memory");
    const int c = lane & 7;
#pragma unroll
    for (int j = 0; j < 4; ++j) { const int n = (lane >> 3) + 8 * j; const LAS float* s = scr + (8 * c) * 33 + n;
        v4u o; o.x = pk2(s[0 * 33], s[1 * 33]); o.y = pk2(s[2 * 33], s[3 * 33]); o.z = pk2(s[4 * 33], s[5 * 33]); o.w = pk2(s[6 * 33], s[7 * 33]);
        *(GAS v4u*)(WT + (size_t)(dr0 + n) * dpitch + k0 + 8 * c) = o; }
    LDS_WAIT(); asm volatile("" ::: "memory");
}
__device__ __forceinline__ void p0_prologue(Frame& F) {
    unsigned char* ws = F.ws;
    {
        LAS float* w16 = (LAS float*)F.lds;
        for (int idx = F.tid; idx < 2048 * 4; idx += NTHR) { const int k = idx >> 2, q = idx & 3;
            const f32x4 v = *(const GAS f32x4*)(F.in[1] + (size_t)k * WIN_PITCH + 7168 + 4 * q); *(LAS f32x4*)(w16 + k * 16 + 4 * q) = v; }
        __syncthreads();
        float* gab = (float*)(ws + WS_GAB);
        for (int tok = F.vcu * NWAVES + F.wave; tok < T; tok += F.G * NWAVES) {
            float acc[16];
#pragma unroll
            for (int e = 0; e < 16; ++e) acc[e] = 0.f;
            const float* xr = F.in[0] + (size_t)tok * D;
#pragma unroll 2
            for (int j = 0; j < 32; ++j) { const int k = j * 64 + F.lane; const float xv = xr[k];
#pragma unroll
                for (int q = 0; q < 4; ++q) { const f32x4 w = *(const LAS f32x4*)(w16 + k * 16 + 4 * q);
                    acc[4 * q + 0] += xv * w.x; acc[4 * q + 1] += xv * w.y; acc[4 * q + 2] += xv * w.z; acc[4 * q + 3] += xv * w.w; } }
#pragma unroll
            for (int e = 0; e < 16; ++e) acc[e] = wave_sum(acc[e]);
            if (F.lane == 0) {
#pragma unroll
                for (int q = 0; q < 4; ++q) *(GAS f32x4*)(gab + (size_t)tok * 16 + 4 * q) = (f32x4){acc[4 * q], acc[4 * q + 1], acc[4 * q + 2], acc[4 * q + 3]}; }
        }
        __syncthreads();
    }
    LAS float* scr = (LAS float*)(F.lds + F.wave * 16384);
    const int gw = F.vcu * NWAVES + F.wave, NGW = F.G * NWAVES;
    constexpr int I_IN = 32 * 352, I_A = 16 * 64, I_O = 32 * 64, I_GU = NEX * 2 * 512, I_D = NEX * 512;
    constexpr int NITEMS = I_IN + 2 * I_A + I_O + I_GU + I_D;
    for (int it = gw; it < NITEMS; it += NGW) {
        int r = it;
        if (r < I_IN) { const int kb = r / 352, nb = r % 352, n0 = 32 * nb; p0_transpose_item(F.in[1], WIN_PITCH, n0 + (n0 >= 7168 ? 16 : 0), (bf16*)(ws + WS_WIN), D, n0, 64 * kb, scr, F.lane); continue; } r -= I_IN;
        if (r < I_A) { const int kb = r / 64, nb = r % 64; p0_transpose_item(F.in[9], D, 32 * nb, (bf16*)(ws + WS_WA), 1024, 32 * nb, 64 * kb, scr, F.lane); continue; } r -= I_A;
        if (r < I_A) { const int kb = r / 64, nb = r % 64; p0_transpose_item(F.in[10], D, 32 * nb, (bf16*)(ws + WS_WB), 1024, 32 * nb, 64 * kb, scr, F.lane); continue; } r -= I_A;
        if (r < I_O) { const int kb = r / 64, nb = r % 64; p0_transpose_item(F.in[11], D, 32 * nb, (bf16*)(ws + WS_WO), D, 32 * nb, 64 * kb, scr, F.lane); continue; } r -= I_O;
        if (r < I_GU) { const int e = r / 1024, which = (r >> 9) & 1, q = r & 511, kb = q / 16, nb = q % 16;
            const float* src = e < NE ? (which ? F.in[17] : F.in[16]) + (size_t)e * D * FF : (which ? F.in[20] : F.in[19]);
            p0_transpose_item(src, FF, 32 * nb, (bf16*)(ws + WS_WGU) + (size_t)e * 1024 * D, D, 256 * (nb >> 2) + 32 * (nb & 3) + 128 * which, 64 * kb, scr, F.lane); continue; } r -= I_GU;
        { const int e = r / 512, q = r & 511, kb = q / 64, nb = q % 64;
            const float* src = e < NE ? F.in[18] + (size_t)e * FF * D : F.in[21];
            p0_transpose_item(src, D, 32 * nb, (bf16*)(ws + WS_WD) + (size_t)e * D * FF, FF, 32 * nb, 64 * kb, scr, F.lane); }
    }
    { const GAS f32x4* x4 = (const GAS f32x4*)F.in[0]; GAS v4u* o = (GAS v4u*)(ws + WS_XB);
      for (size_t i = (size_t)F.vcu * NTHR + F.tid; i < (size_t)T * D / 8; i += (size_t)F.G * NTHR) { const f32x4 a = x4[2 * i], b = x4[2 * i + 1];
          v4u w; w.x = pk2(a.x, a.y); w.y = pk2(a.z, a.w); w.z = pk2(b.x, b.y); w.w = pk2(b.z, b.w); o[i] = w; } }
}

using pg8::Unit;
struct EpiProj {
    static constexpr bool PERM = true;
    bf16* P;
    __device__ __forceinline__ void operator()(const f32x4 (&acc)[2][2][4][2], const Unit& u, int wr, int wc, int fr, int fq) const {
        const int buf = u.pn >> 2, colt = (u.pn & 3) * 256; bf16* base = P + (size_t)buf * PBUF;
        const int row0 = u.r0 + wr * 64 + fr, col0 = colt + wc * 32 + 8 * fq; const bool sg = buf >= 7;
#pragma unroll
        for (int ai = 0; ai < 2; ++ai)
#pragma unroll
            for (int m = 0; m < 4; ++m) { bf16* rowp = base + (size_t)(row0 + ai * 128 + m * 16) * 1024 + col0;
#pragma unroll
                for (int bj = 0; bj < 2; ++bj) { f32x4 v0 = acc[ai][bj][m][0], v1 = acc[ai][bj][m][1];
                    if (sg) { v0 = (f32x4){sigmoidf_(v0.x), sigmoidf_(v0.y), sigmoidf_(v0.z), sigmoidf_(v0.w)}; v1 = (f32x4){sigmoidf_(v1.x), sigmoidf_(v1.y), sigmoidf_(v1.z), sigmoidf_(v1.w)}; }
                    v4u w; w.x = pk2(v0.x, v0.y); w.y = pk2(v0.z, v0.w); w.z = pk2(v1.x, v1.y); w.w = pk2(v1.z, v1.w);
                    *(GAS v4u*)(rowp + bj * 128) = w; } }
    }
};
template <int STEP> struct EpiBranch {
    static constexpr bool PERM = true;
    const bf16* SG; float* tmp; bf16* mrg;
    __device__ __forceinline__ void operator()(const f32x4 (&acc)[2][2][4][2], const Unit& u, int wr, int wc, int fr, int fq) const {
        const int row0 = u.r0 + wr * 64 + fr, colu = u.pn * 256 + wc * 32 + 8 * fq;
#pragma unroll
        for (int ai = 0; ai < 2; ++ai)
#pragma unroll
            for (int m = 0; m < 4; ++m) { const int row = row0 + ai * 128 + m * 16;
#pragma unroll
                for (int bj = 0; bj < 2; ++bj) { const int col = colu + bj * 128;
                    const v4u g = *(const GAS v4u*)(SG + (size_t)(col >> 10) * PBUF + (size_t)row * 1024 + (col & 1023));
                    f32x4 v0 = acc[ai][bj][m][0], v1 = acc[ai][bj][m][1];
                    v0 = v0 * (f32x4){bflo(g.x), bfhi(g.x), bflo(g.y), bfhi(g.y)}; v1 = v1 * (f32x4){bflo(g.z), bfhi(g.z), bflo(g.w), bfhi(g.w)};
                    float* tp = tmp + (size_t)row * D + col;
                    if (STEP == 0) { *(GAS f32x4*)tp = v0; *(GAS f32x4*)(tp + 4) = v1; }
                    else { v0 = v0 + *(const GAS f32x4*)tp; v1 = v1 + *(const GAS f32x4*)(tp + 4);
                        v4u w; w.x = pk2(v0.x, v0.y); w.y = pk2(v0.z, v0.w); w.z = pk2(v1.x, v1.y); w.w = pk2(v1.z, v1.w);
                        *(GAS v4u*)(mrg + (size_t)row * D + col) = w; } } }
    }
};
struct EpiOut {
    static constexpr bool PERM = true;
    const float* x; float* y1;
    __device__ __forceinline__ void operator()(const f32x4 (&acc)[2][2][4][2], const Unit& u, int wr, int wc, int fr, int fq) const {
        const int row0 = u.r0 + wr * 64 + fr, colu = u.pn * 256 + wc * 32 + 8 * fq;
#pragma unroll
        for (int ai = 0; ai < 2; ++ai)
#pragma unroll
            for (int m = 0; m < 4; ++m) { const size_t ro = (size_t)(row0 + ai * 128 + m * 16) * D;
#pragma unroll
                for (int bj = 0; bj < 2; ++bj) { const size_t o = ro + colu + bj * 128;
                    const f32x4 x0 = *(const GAS f32x4*)(x + o), x1 = *(const GAS f32x4*)(x + o + 4);
                    *(GAS f32x4*)(y1 + o) = x0 * ALPHA + acc[ai][bj][m][0]; *(GAS f32x4*)(y1 + o + 4) = x1 * ALPHA + acc[ai][bj][m][1]; } }
    }
};
struct EpiGU {
    static constexpr bool PERM = true;
    bf16* HB;
    __device__ __forceinline__ void operator()(const f32x4 (&acc)[2][2][4][2], const Unit& u, int wr, int wc, int fr, int fq) const {
        const int col = u.pn * 128 + wc * 32 + 8 * fq;
#pragma unroll
        for (int ai = 0; ai < 2; ++ai)
#pragma unroll
            for (int m = 0; m < 4; ++m) { const int r = ai * 128 + wr * 64 + m * 16 + fr;
                if (r < u.nv) { const f32x4 g0 = acc[ai][0][m][0], g1 = acc[ai][0][m][1], u0 = acc[ai][1][m][0], u1 = acc[ai][1][m][1];
                    v4u w; w.x = pk2(siluf_(g0.x) * u0.x, siluf_(g0.y) * u0.y); w.y = pk2(siluf_(g0.z) * u0.z, siluf_(g0.w) * u0.w);
                    w.z = pk2(siluf_(g1.x) * u1.x, siluf_(g1.y) * u1.y); w.w = pk2(siluf_(g1.z) * u1.z, siluf_(g1.w) * u1.w);
                    *(GAS v4u*)(HB + (size_t)(u.r0 + r) * FF + col) = w; } }
    }
};
struct EpiDown {
    static constexpr bool PERM = true;
    bf16* YAS; const float* wgtl;
    __device__ __forceinline__ void operator()(const f32x4 (&acc)[2][2][4][2], const Unit& u, int wr, int wc, int fr, int fq) const {
        const int colu = u.pn * 256 + wc * 32 + 8 * fq;
#pragma unroll
        for (int ai = 0; ai < 2; ++ai)
#pragma unroll
            for (int m = 0; m < 4; ++m) { const int r = ai * 128 + wr * 64 + m * 16 + fr;
                if (r < u.nv) { const float wg = wgtl[u.lb + r];
#pragma unroll
                    for (int bj = 0; bj < 2; ++bj) { const f32x4 v0 = acc[ai][bj][m][0] * wg, v1 = acc[ai][bj][m][1] * wg;
                        v4u w; w.x = pk2(v0.x, v0.y); w.y = pk2(v0.z, v0.w); w.z = pk2(v1.x, v1.y); w.w = pk2(v1.z, v1.w);
                        *(GAS v4u*)(YAS + (size_t)(u.r0 + r) * D + colu + bj * 128) = w; } } }
    }
};
struct MoeOrder {
    const LAS int* tpref; const LAS int* rbase; const LAS int* cnts; const int* tokl; int NT, G, c, brows;
    __device__ __forceinline__ bool next(int i, Unit& u) const {
        const int L = i * G + c; if (L >= tpref[NEX] * NT) return false;
        const int tg = L / NT, nt = L % NT; int e = 0;
        while (tpref[e + 1] <= tg) ++e;
        const int mt = tg - tpref[e];
        u.e = e; u.pm = mt; u.pn = nt; u.lb = e * T + mt * 256; u.nv = min(256, cnts[e] - mt * 256); u.r0 = rbase[e] + mt * 256; u.arow = u.r0; u.brow = e * brows + nt * 256; return true;
    }
    __device__ __forceinline__ int row_of(const Unit& u, int r) const { return r < u.nv ? tokl[u.lb + r] : 0; }
};
__device__ __forceinline__ void moe_tables(Frame& F) {
    LAS int* tpref = (LAS int*)(F.lds + LDS_TAB); LAS int* rbase = tpref + 72; LAS int* cnts = rbase + 72;
    __syncthreads();
    if (F.wave == 0) {
        const int c = (int)__hip_atomic_load(F.ctl + CW_CNT + 64 * F.lane, RLX_AGENT);
        int tl = (c + 255) >> 8, tp = tl, rb = c;
#pragma unroll
        for (int o = 1; o < 64; o <<= 1) { const int a = __shfl_up(tp, o), b = __shfl_up(rb, o); if (F.lane >= o) { tp += a; rb += b; } }
        tpref[F.lane] = tp - tl; rbase[F.lane] = rb - c; cnts[F.lane] = c;
        if (F.lane == 63) { tpref[64] = tp; rbase[64] = rb; cnts[64] = T; tpref[65] = tp + T / 256; rbase[65] = rb + T; }
    }
    __syncthreads();
}

__device__ __forceinline__ int t5_bucket(int rel) {
    const int n = rel < 0 ? -rel : rel; int b;
    if (n < 8) b = n; else if (n < 12) b = 8; else if (n < 16) b = 9; else if (n < 23) b = 10; else if (n < 32) b = 11; else if (n < 46) b = 12; else if (n < 64) b = 13; else if (n < 91) b = 14; else b = 15;
    return b + (rel > 0 ? 16 : 0);
}
typedef short s16x4 __attribute__((ext_vector_type(4)));
__device__ __forceinline__ void attn_v1(Frame& F) {
    LAS bf16* Kl = (LAS bf16*)F.lds;
    LAS bf16* Vt = Kl + 64 * 136;
    LAS float* Ox = (LAS float*)(F.lds + 65536);
    LAS float* relb = (LAS float*)(F.lds + LDS_TAB);
    const bf16* Pq = (const bf16*)(F.ws + WS_P); const bf16* Pk = Pq + PBUF; const bf16* Pv = Pq + 2 * PBUF;
    bf16* ya = (bf16*)(F.ws + WS_YA);
    const int tid = F.tid, lane = F.lane, l15 = lane & 15, g = lane >> 4, qs = F.wave & 3, map = F.wave >> 2;
    float lam;
    { const float* dl = F.in[6]; float s01 = 0.f, s23 = 0.f;
      for (int d = 0; d < 64; ++d) { s01 += dl[d] * dl[64 + d]; s23 += dl[128 + d] * dl[192 + d]; }
      lam = expf(s01) - expf(s23) + LAMBDA_INIT; }
    for (int L = blockIdx.x; L < NH * NCHUNK; L += F.G) {
        const int h = L & 7, c = NCHUNK - 1 - (L >> 3);
        __syncthreads();
        if (tid < 256) relb[tid] = F.in[8][t5_bucket(tid - 191) * 8 + h];
        const int qrow = 16 * qs + l15;
        bf16x8 qf[2];
#pragma unroll
        for (int s = 0; s < 2; ++s) qf[s] = *(const GAS bf16x8*)(Pq + (size_t)(c * 64 + qrow) * 1024 + h * 128 + map * 64 + 32 * s + 8 * g);
        float mrun = -INFINITY, lrun = 0.f; f32x4 o[8];
#pragma unroll
        for (int rb = 0; rb < 8; ++rb) o[rb] = (f32x4){0.f, 0.f, 0.f, 0.f};
        for (int j = 0; j <= c; ++j) {
            __syncthreads();
            { const int r = tid >> 3, cs = (tid & 7) * 16; const size_t go = (size_t)(j * 64 + r) * 1024 + h * 128 + cs;
              const v4u a0 = *(const GAS v4u*)(Pk + go), a1 = *(const GAS v4u*)(Pk + go + 8), b0 = *(const GAS v4u*)(Pv + go), b1 = *(const GAS v4u*)(Pv + go + 8);
              *(LAS v4u*)(Kl + r * 136 + cs) = a0; *(LAS v4u*)(Kl + r * 136 + cs + 8) = a1;
              const unsigned bw[8] = {b0.x, b0.y, b0.z, b0.w, b1.x, b1.y, b1.z, b1.w};
#pragma unroll
              for (int i = 0; i < 8; ++i) { Vt[(cs + 2 * i) * 72 + r] = (bf16)(bw[i] & 0xffffu); Vt[(cs + 2 * i + 1) * 72 + r] = (bf16)(bw[i] >> 16); } }
            __syncthreads();
            f32x4 st[4];
#pragma unroll
            for (int t = 0; t < 4; ++t) { st[t] = (f32x4){0.f, 0.f, 0.f, 0.f};
#pragma unroll
                for (int s = 0; s < 2; ++s) { const bf16x8 kf = *(const LAS bf16x8*)(Kl + (16 * t + l15) * 136 + map * 64 + 32 * s + 8 * g);
                    st[t] = __builtin_amdgcn_mfma_f32_16x16x32_bf16(kf, qf[s], st[t], 0, 0, 0); } }
            float mt = -INFINITY;
            if (j >= c - 2) {
#pragma unroll
                for (int t = 0; t < 4; ++t)
#pragma unroll
                    for (int r = 0; r < 4; ++r) { st[t][r] = st[t][r] * 0.125f + relb[(j - c) * 64 + 16 * t + 4 * g + r - qrow + 191]; mt = fmaxf(mt, st[t][r]); }
            } else { const float bfar = relb[0];
#pragma unroll
                for (int t = 0; t < 4; ++t)
#pragma unroll
                    for (int r = 0; r < 4; ++r) { st[t][r] = st[t][r] * 0.125f + bfar; mt = fmaxf(mt, st[t][r]); } }
            mt = fmaxf(mt, __shfl_xor(mt, 16)); mt = fmaxf(mt, __shfl_xor(mt, 32));
            const float mn = fmaxf(mrun, mt), corr = __expf(mrun - mn);
            lrun *= corr; mrun = mn;
#pragma unroll
            for (int rb = 0; rb < 8; ++rb) o[rb] = o[rb] * corr;
            float ps = 0.f;
#pragma unroll
            for (int t = 0; t < 4; ++t)
#pragma unroll
                for (int r = 0; r < 4; ++r) { st[t][r] = __expf(st[t][r] - mn); ps += st[t][r]; }
            lrun += ps;
            bf16x8 pf[2];
#pragma unroll
            for (int s = 0; s < 2; ++s) { const v4u w = (v4u){pk2(st[2 * s][0], st[2 * s][1]), pk2(st[2 * s][2], st[2 * s][3]), pk2(st[2 * s + 1][0], st[2 * s + 1][1]), pk2(st[2 * s + 1][2], st[2 * s + 1][3])};
                pf[s] = __builtin_bit_cast(bf16x8, w); }
#pragma unroll
            for (int rb = 0; rb < 8; ++rb)
#pragma unroll
                for (int s = 0; s < 2; ++s) { const LAS bf16* vp = Vt + (16 * rb + l15) * 72 + 32 * s + 4 * g;
                    const v2u lo = *(const LAS v2u*)vp, hi = *(const LAS v2u*)(vp + 16);
                    const bf16x8 vf = __builtin_bit_cast(bf16x8, (v4u){lo.x, lo.y, hi.x, hi.y});
                    o[rb] = __builtin_amdgcn_mfma_f32_16x16x32_bf16(vf, pf[s], o[rb], 0, 0, 0); }
        }
        lrun += __shfl_xor(lrun, 16); lrun += __shfl_xor(lrun, 32);
        __syncthreads();
        { const float inv = 1.f / lrun; LAS float* od = Ox + (map * 64 + qrow) * 128;
#pragma unroll
          for (int rb = 0; rb < 8; ++rb) *(LAS f32x4*)(od + 16 * rb + 4 * g) = o[rb] * inv; }
        __syncthreads();
        { const int qq = tid >> 3, seg = (tid & 7) * 16; float a[16], ss = 0.f;
#pragma unroll
          for (int i = 0; i < 16; ++i) { a[i] = Ox[qq * 128 + seg + i] - lam * Ox[(64 + qq) * 128 + seg + i]; ss += a[i] * a[i]; }
          ss += __shfl_xor(ss, 1); ss += __shfl_xor(ss, 2); ss += __shfl_xor(ss, 4);
          const float r = rsqrtf(ss * (1.f / 128.f) + NORM_EPS) * (1.f - LAMBDA_INIT);
          unsigned w[8];
#pragma unroll
          for (int i = 0; i < 8; ++i) w[i] = pk2(a[2 * i] * r * F.in[7][seg + 2 * i], a[2 * i + 1] * r * F.in[7][seg + 2 * i + 1]);
          GAS v4u* op = (GAS v4u*)(ya + (size_t)(c * 64 + qq) * 1024 + h * 128 + seg);
          op[0] = (v4u){w[0], w[1], w[2], w[3]}; op[1] = (v4u){w[4], w[5], w[6], w[7]}; }
    }
}

__device__ __forceinline__ void gdn_prep_v1(Frame& F) {
    LAS float* Ks = (LAS float*)F.lds;
    LAS float* Qs = Ks + 64 * 129;
    LAS float* Vs = Qs + 64 * 129;
    LAS float* As = Vs + 64 * 128;
    LAS float* Tm = As + 64 * 68;
    LAS float* gcs = Tm + 64 * 68;
    LAS float* bts = gcs + 64;
    LAS float* egs = bts + 64;
    const bf16* P3 = (const bf16*)(F.ws + WS_P) + 3 * PBUF;
    const float* gab = (const float*)(F.ws + WS_GAB);
    float* Ug = (float*)(F.ws + WS_U); float* Wg = (float*)(F.ws + WS_W); float* QDg = (float*)(F.ws + WS_QD); float* KDg = (float*)(F.ws + WS_KD);
    float* AQg = (float*)(F.ws + WS_AQK); float* GLg = (float*)(F.ws + WS_GL);
    const int tid = F.tid, lane = F.lane;
    for (int L = blockIdx.x; L < NH * NCHUNK; L += F.G) {
        const int n = L >> 3, h = L & 7, t0 = n * 64;
        __syncthreads();
        for (int idx = tid; idx < 64 * 384; idx += NTHR) { const int t = idx / 384, ch = idx % 384, which = ch >> 7, i = ch & 127, cg = which * 1024 + h * 128 + i;
            const bf16* src = P3 + (size_t)which * PBUF + h * 128 + i; float a = 0.f;
#pragma unroll
            for (int j = 0; j < 4; ++j) { const int tt = t0 + t - 3 + j; if (tt >= 0) a += bf2f(src[(size_t)tt * 1024]) * F.in[2][j * 3072 + cg]; }
            a = siluf_(a);
            if (which == 0) Qs[t * 129 + i] = a; else if (which == 1) Ks[t * 129 + i] = a; else Vs[t * 128 + i] = a; }
        __syncthreads();
        for (int t = F.wave * 8; t < F.wave * 8 + 8; ++t) {
            const float q0 = Qs[t * 129 + lane], q1 = Qs[t * 129 + 64 + lane], k0 = Ks[t * 129 + lane], k1 = Ks[t * 129 + 64 + lane];
            const float rq = rsqrtf(wave_sum(q0 * q0 + q1 * q1) + NORM_EPS) * 0.08838834764831845f, rk = rsqrtf(wave_sum(k0 * k0 + k1 * k1) + NORM_EPS);
            Qs[t * 129 + lane] = q0 * rq; Qs[t * 129 + 64 + lane] = q1 * rq; Ks[t * 129 + lane] = k0 * rk; Ks[t * 129 + 64 + lane] = k1 * rk; }
        if (F.wave == 0) { const int tok = t0 + lane; const float ga = gab[(size_t)tok * 16 + h] + F.in[4][h], gb = gab[(size_t)tok * 16 + 8 + h];
            const float sp = fmaxf(ga, 0.f) + log1pf(expf(-fabsf(ga))); float g = -expf(F.in[3][h]) * sp;
#pragma unroll
            for (int o = 1; o < 64; o <<= 1) { const float v = __shfl_up(g, o); if (lane >= o) g += v; }
            gcs[lane] = g; bts[lane] = 1.f / (1.f + expf(-gb)); egs[lane] = expf(g); }
        __syncthreads();
        for (int idx = tid; idx < 4096; idx += NTHR) { const int c = idx >> 6, s = idx & 63; float kk = 0.f, qk = 0.f;
            if (s <= c) { for (int i = 0; i < 128; ++i) { const float ks = Ks[s * 129 + i]; kk += Ks[c * 129 + i] * ks; qk += Qs[c * 129 + i] * ks; }
                const float dec = expf(gcs[c] - gcs[s]); kk *= dec * bts[c]; qk *= dec; }
            As[c * 68 + s] = (s < c) ? kk : 0.f; AQg[(size_t)L * 4096 + idx] = (s <= c) ? qk : 0.f; }
        __syncthreads();
        if (F.wave == 0) {
            for (int i = 0; i < 64; ++i) { float a = (i == lane) ? 1.f : 0.f;
#pragma unroll 4
                for (int j = 0; j < i; ++j) a -= As[i * 68 + j] * Tm[j * 68 + lane];
                Tm[i * 68 + lane] = a; }
        }
        __syncthreads();
        for (int idx = tid; idx < 64 * 256; idx += NTHR) { const int c = idx >> 8, col = idx & 255; float a = 0.f;
            if (col < 128) { for (int s = 0; s <= c; ++s) a += Tm[c * 68 + s] * bts[s] * Vs[s * 128 + col]; Ug[((size_t)h * T + t0 + c) * 128 + col] = a; }
            else { const int i = col - 128; for (int s = 0; s <= c; ++s) a += Tm[c * 68 + s] * bts[s] * egs[s] * Ks[s * 129 + i]; Wg[((size_t)h * T + t0 + c) * 128 + i] = a; } }
        const float glast = gcs[63];
        for (int idx = tid; idx < 64 * 128; idx += NTHR) { const int t = idx >> 7, i = idx & 127; const size_t o = ((size_t)h * T + t0 + t) * 128 + i;
            QDg[o] = Qs[t * 129 + i] * egs[t]; KDg[o] = Ks[t * 129 + i] * expf(glast - gcs[t]); }
        if (tid == 0) GLg[L] = expf(glast);
    }
}
__device__ __forceinline__ void gdn_scan_v1(Frame& F) {
    if (blockIdx.x >= 64) return;
    LAS float* Ssh = (LAS float*)F.lds;
    LAS float* Wsh = Ssh + 2048;
    LAS float* KDs = Wsh + 64 * 129;
    LAS float* Ush = KDs + 64 * 129;
    LAS float* VNs = Ush + 1024;
    const float* Ug = (const float*)(F.ws + WS_U); const float* Wg = (const float*)(F.ws + WS_W); const float* KDg = (const float*)(F.ws + WS_KD);
    const float* GLg = (const float*)(F.ws + WS_GL); float* SST = (float*)(F.ws + WS_SST);
    const int tid = F.tid, h = blockIdx.x >> 3, cb = blockIdx.x & 7;
    for (int idx = tid; idx < 2048; idx += NTHR) Ssh[idx] = 0.f;
    for (int n = 0; n < NCHUNK; ++n) {
        __syncthreads();
        const size_t base = ((size_t)h * T + n * 64) * 128;
        for (int idx = tid; idx < 64 * 128; idx += NTHR) { const int c = idx >> 7, i = idx & 127; Wsh[c * 129 + i] = Wg[base + idx]; KDs[c * 129 + i] = KDg[base + idx]; }
        for (int idx = tid; idx < 1024; idx += NTHR) { const int c = idx >> 4, j = idx & 15; Ush[idx] = Ug[base + c * 128 + cb * 16 + j]; }
        for (int idx = tid; idx < 2048; idx += NTHR) { const int i = idx >> 4, j = idx & 15; SST[(((size_t)h * NCHUNK + n) * 128 + i) * 128 + cb * 16 + j] = Ssh[idx]; }
        const float gl = GLg[n * 8 + h];
        __syncthreads();
        { const int c = tid >> 3, jp = (tid & 7) * 2; float a0 = 0.f, a1 = 0.f;
          for (int i = 0; i < 128; ++i) { const float w = Wsh[c * 129 + i]; a0 += w * Ssh[i * 16 + jp]; a1 += w * Ssh[i * 16 + jp + 1]; }
          VNs[c * 16 + jp] = Ush[c * 16 + jp] - a0; VNs[c * 16 + jp + 1] = Ush[c * 16 + jp + 1] - a1; }
        __syncthreads();
        { const int i = tid >> 2, jq = (tid & 3) * 4; float a[4];
#pragma unroll
          for (int x = 0; x < 4; ++x) a[x] = gl * Ssh[i * 16 + jq + x];
          for (int c = 0; c < 64; ++c) { const float kd = KDs[c * 129 + i];
#pragma unroll
              for (int x = 0; x < 4; ++x) a[x] += kd * VNs[c * 16 + jq + x]; }
#pragma unroll
          for (int x = 0; x < 4; ++x) Ssh[i * 16 + jq + x] = a[x]; }
    }
}
__device__ __forceinline__ void gdn_out_v1(Frame& F) {
    LAS float* Sh = (LAS float*)F.lds;
    LAS float* Wsh = Sh + 8192;
    LAS float* QDs = Wsh + 64 * 129;
    LAS float* VNh = QDs + 64 * 129;
    LAS float* AQ = VNh + 4096;
    const float* Ug = (const float*)(F.ws + WS_U); const float* Wg = (const float*)(F.ws + WS_W); const float* QDg = (const float*)(F.ws + WS_QD);
    const float* AQg = (const float*)(F.ws + WS_AQK); const float* SST = (const float*)(F.ws + WS_SST);
    const bf16* Pz = (const bf16*)(F.ws + WS_P) + 6 * PBUF; bf16* yb = (bf16*)(F.ws + WS_YB);
    const int tid = F.tid, c = tid >> 3, jg = tid & 7;
    for (int L = blockIdx.x; L < NH * NCHUNK; L += F.G) {
        const int n = L >> 3, h = L & 7, t0 = n * 64;
        const size_t base = ((size_t)h * T + t0) * 128;
        __syncthreads();
        for (int idx = tid; idx < 64 * 128; idx += NTHR) { const int cc = idx >> 7, i = idx & 127; Wsh[cc * 129 + i] = Wg[base + idx]; QDs[cc * 129 + i] = QDg[base + idx]; }
        for (int idx = tid; idx < 4096; idx += NTHR) AQ[(idx >> 6) * 68 + (idx & 63)] = AQg[(size_t)L * 4096 + idx];
        float oo[2][8];
#pragma unroll
        for (int half = 0; half < 2; ++half) {
            __syncthreads();
            for (int idx = tid; idx < 128 * 64; idx += NTHR) { const int i = idx >> 6, j = idx & 63; Sh[idx] = SST[(((size_t)h * NCHUNK + n) * 128 + i) * 128 + half * 64 + j]; }
            __syncthreads();
            float t1[8], qs[8];
#pragma unroll
            for (int x = 0; x < 8; ++x) { t1[x] = 0.f; qs[x] = 0.f; }
            for (int i = 0; i < 128; ++i) { const float w = Wsh[c * 129 + i], qd = QDs[c * 129 + i]; const LAS float* sr = Sh + i * 64 + jg * 8;
#pragma unroll
                for (int x = 0; x < 8; ++x) { t1[x] += w * sr[x]; qs[x] += qd * sr[x]; } }
#pragma unroll
            for (int x = 0; x < 8; ++x) VNh[c * 64 + jg * 8 + x] = Ug[base + (size_t)c * 128 + half * 64 + jg * 8 + x] - t1[x];
            __syncthreads();
            for (int s = 0; s <= c; ++s) { const float a = AQ[c * 68 + s]; const LAS float* vr = VNh + s * 64 + jg * 8;
#pragma unroll
                for (int x = 0; x < 8; ++x) qs[x] += a * vr[x]; }
#pragma unroll
            for (int x = 0; x < 8; ++x) oo[half][x] = qs[x];
        }
        float ss = 0.f;
#pragma unroll
        for (int half = 0; half < 2; ++half)
#pragma unroll
            for (int x = 0; x < 8; ++x) ss += oo[half][x] * oo[half][x];
        ss += __shfl_xor(ss, 1); ss += __shfl_xor(ss, 2); ss += __shfl_xor(ss, 4);
        const float r = rsqrtf(ss * (1.f / 128.f) + NORM_EPS);
#pragma unroll
        for (int half = 0; half < 2; ++half) { const int col = half * 64 + jg * 8; const size_t o = (size_t)(t0 + c) * 1024 + h * 128 + col;
            const v4u z = *(const GAS v4u*)(Pz + o); const float zz[8] = {bflo(z.x), bfhi(z.x), bflo(z.y), bfhi(z.y), bflo(z.z), bfhi(z.z), bflo(z.w), bfhi(z.w)};
            unsigned w[4];
#pragma unroll
            for (int x = 0; x < 4; ++x) w[x] = pk2(oo[half][2 * x] * r * F.in[5][col + 2 * x] * siluf_(zz[2 * x]), oo[half][2 * x + 1] * r * F.in[5][col + 2 * x + 1] * siluf_(zz[2 * x + 1]));
            *(GAS v4u*)(yb + o) = (v4u){w[0], w[1], w[2], w[3]}; }
    }
}

__device__ __forceinline__ void ln_router(Frame& F) {
    LAS float* X1s = (LAS float*)F.lds;
    LAS float* LG = (LAS float*)(F.lds + LDS_TAB);
    LAS int* hist = (LAS int*)(LG + 1024);
    LAS int* gbs = hist + 64;
    const float* y1 = (const float*)(F.ws + WS_Y1); float* x1f = (float*)(F.ws + WS_X1F); bf16* x1b = (bf16*)(F.ws + WS_X1B);
    int* tokl = (int*)(F.ws + WS_TOKL); float* wgtl = (float*)(F.ws + WS_WGTL); unsigned* info = (unsigned*)(F.ws + WS_INFO);
    const float* g1 = F.in[12]; const float* b1 = F.in[13]; const float* wr = F.in[14]; const float* rb = F.in[15];
    const int tid = F.tid, lane = F.lane;
    for (int blk = blockIdx.x; blk < T / 16; blk += F.G) {
        const int tb = blk * 16;
        __syncthreads();
        if (tid < 64) hist[tid] = 0;
#pragma unroll 1
        for (int tt = 0; tt < 2; ++tt) { const int tl = F.wave * 2 + tt, tok = tb + tl;
            const GAS f32x4* yr = (const GAS f32x4*)(y1 + (size_t)tok * D) + lane; f32x4 v[8]; float s = 0.f;
#pragma unroll
            for (int j = 0; j < 8; ++j) { v[j] = yr[64 * j]; s += (v[j].x + v[j].y) + (v[j].z + v[j].w); }
            const float mean = wave_sum(s) * (1.f / D); float s2 = 0.f;
#pragma unroll
            for (int j = 0; j < 8; ++j) { v[j] = v[j] - mean; s2 += (v[j].x * v[j].x + v[j].y * v[j].y) + (v[j].z * v[j].z + v[j].w * v[j].w); }
            const float rstd = rsqrtf(wave_sum(s2) * (1.f / D) + LN_EPS);
#pragma unroll
            for (int j = 0; j < 8; ++j) { const int col = j * 256 + lane * 4; const f32x4 gg = *(const GAS f32x4*)(g1 + col), bb = *(const GAS f32x4*)(b1 + col);
                const f32x4 xo = v[j] * rstd * gg + bb;
                *(GAS f32x4*)(x1f + (size_t)tok * D + col) = xo; *(GAS v2u*)(x1b + (size_t)tok * D + col) = (v2u){pk2(xo.x, xo.y), pk2(xo.z, xo.w)};
                *(LAS f32x4*)(X1s + tl * 2048 + col) = xo; }
            if (lane == 0) { tokl[NE * T + tok] = tok; wgtl[NE * T + tok] = 1.f; } }
        __syncthreads();
        { const int tl = tid >> 5, e0 = (tid & 31) * 2; const LAS float* xr = X1s + tl * 2048; float a0 = 0.f, a1 = 0.f;
#pragma unroll 4
          for (int d = 0; d < D; ++d) { const f32x2 w = *(const GAS f32x2*)(wr + (size_t)d * NE + e0); const float xv = xr[d]; a0 += xv * w.x; a1 += xv * w.y; }
          LG[tl * 64 + e0] = a0; LG[tl * 64 + e0 + 1] = a1; }
        __syncthreads();
        bool sel[2]; int loc[2]; float wsl[2]; unsigned long long msk[2];
#pragma unroll
        for (int tt = 0; tt < 2; ++tt) { const int tl = F.wave * 2 + tt;
            const float score = 1.f / (1.f + expf(-LG[tl * 64 + lane])), ch = score + rb[lane];
            int rk = 0;
#pragma unroll
            for (int x = 1; x < 8; ++x) { const float cj = __shfl_xor(ch, x); rk += (cj > ch || (cj == ch && (lane ^ x) < lane)) ? 1 : 0; }
            float gs = rk < 2 ? ch : 0.f; gs += __shfl_xor(gs, 1); gs += __shfl_xor(gs, 2); gs += __shfl_xor(gs, 4);
            const int g = lane >> 3; int grk = 0;
#pragma unroll
            for (int x = 1; x < 8; ++x) { const float gj = __shfl_xor(gs, 8 * x); grk += (gj > gs || (gj == gs && (g ^ x) < g)) ? 1 : 0; }
            const float mk = grk < 4 ? ch : -INFINITY; int erk = 0;
#pragma unroll
            for (int j = 0; j < 64; ++j) { const float mj = __builtin_bit_cast(float, __builtin_amdgcn_readlane(__builtin_bit_cast(int, mk), j)); erk += (mj > mk || (mj == mk && j < lane)) ? 1 : 0; }
            sel[tt] = (grk < 4) && (erk < TOPK);
            const float ssum = wave_sum(sel[tt] ? score : 0.f); wsl[tt] = score / ssum * ROUTED_SCALE;
            msk[tt] = __ballot(sel[tt]);
            loc[tt] = sel[tt] ? atomicAdd((int*)&hist[lane], 1) : 0; }
        __syncthreads();
        if (tid < 64) { const int hc = hist[tid]; gbs[tid] = hc ? (int)__hip_atomic_fetch_add(F.ctl + CW_CNT + 64 * tid, (unsigned)hc, RLX_AGENT) : 0; }
        __syncthreads();
#pragma unroll
        for (int tt = 0; tt < 2; ++tt) if (sel[tt]) { const int tok = tb + F.wave * 2 + tt, slot = gbs[lane] + loc[tt];
            tokl[lane * T + slot] = tok; wgtl[lane * T + slot] = wsl[tt];
            const int k = __popcll(msk[tt] & ((1ull << lane) - 1ull)); info[tok * 8 + k] = ((unsigned)lane << 16) | (unsigned)slot; }
    }
}
__device__ __forceinline__ void final_ln(Frame& F) {
    moe_tables(F);
    const LAS int* rbase = (const LAS int*)(F.lds + LDS_TAB) + 72;
    const float* x1f = (const float*)(F.ws + WS_X1F); const bf16* yas = (const bf16*)(F.ws + WS_YAS); const unsigned* info = (const unsigned*)(F.ws + WS_INFO);
    const float* g2 = F.in[22]; const float* b2 = F.in[23];
    const int lane = F.lane;
    for (int tok = F.vcu * NWAVES + F.wave; tok < T; tok += F.G * NWAVES) {
        f32x4 v[8];
        const GAS f32x4* xr = (const GAS f32x4*)(x1f + (size_t)tok * D) + lane;
#pragma unroll
        for (int j = 0; j < 8; ++j) v[j] = xr[64 * j] * ALPHA;
        for (int k = 0; k < 9; ++k) { int row;
            if (k < 8) { const unsigned w = info[tok * 8 + k]; row = rbase[w >> 16] + (int)(w & 0xffffu); } else row = NE * T * 0 + 65536 + tok;
            const GAS v2u* yr = (const GAS v2u*)(yas + (size_t)row * D) + lane;
#pragma unroll
            for (int j = 0; j < 8; ++j) { const v2u w = yr[64 * j]; v[j] = v[j] + (f32x4){bflo(w.x), bfhi(w.x), bflo(w.y), bfhi(w.y)}; } }
        float s = 0.f;
#pragma unroll
        for (int j = 0; j < 8; ++j) s += (v[j].x + v[j].y) + (v[j].z + v[j].w);
        const float mean = wave_sum(s) * (1.f / D); float s2 = 0.f;
#pragma unroll
        for (int j = 0; j < 8; ++j) { v[j] = v[j] - mean; s2 += (v[j].x * v[j].x + v[j].y * v[j].y) + (v[j].z * v[j].z + v[j].w * v[j].w); }
        const float rstd = rsqrtf(wave_sum(s2) * (1.f / D) + LN_EPS);
#pragma unroll
        for (int j = 0; j < 8; ++j) { const int col = j * 256 + lane * 4; const f32x4 gg = *(const GAS f32x4*)(g2 + col), bb = *(const GAS f32x4*)(b2 + col);
            *(GAS f32x4*)(F.out + (size_t)tok * D + col) = v[j] * rstd * gg + bb; }
    }
}

struct Args { const float* in[24]; float* out; unsigned char* ws; int ph_lo, ph_hi; };
__global__ void __launch_bounds__(NTHR, 2) fwd(Args args) {
    extern __shared__ __attribute__((aligned(16))) unsigned char lds[];
    Frame F;
    F.lds = (LAS unsigned char*)lds;
    F.tid = threadIdx.x; F.lane = F.tid & 63; F.wave = __builtin_amdgcn_readfirstlane(F.tid >> 6);
    F.G = gridDim.x; { const int bx = blockIdx.x; F.vcu = (F.G % 8 == 0) ? (bx % 8) * (F.G / 8) + bx / 8 : bx; }
    F.ws = args.ws; F.ctl = (gu32*)(args.ws + WS_CTL); F.out = args.out;
#pragma unroll
    for (int i = 0; i < 24; ++i) F.in[i] = args.in[i];
    volatile LAS unsigned* MISC = (volatile LAS unsigned*)(F.lds + MISC_OFF);
    if (F.tid < 64) MISC[F.tid] = 0u;
    __syncthreads();
    const int lo = args.ph_lo, hi = args.ph_hi;
    const bool multi = (hi - lo) > 1;
    XcdBarrier bar; bar.bar = (unsigned*)(F.ctl + CW_BAR); bar.x = 0; bar.st = nullptr;
    if (multi) bar = xcd_barrier_post((unsigned*)(F.ctl + CW_BAR), MISC + 8);
#ifndef ONLY_PHASE
#define ONLY_PHASE -1
#endif
#define IN(k) ((ONLY_PHASE < 0 || ONLY_PHASE == (k)) && lo <= (k) && (k) < hi)
#define SEAM(k) do { if (IN(k) && IN((k) + 1)) xcd_barrier(bar); } while (0)
    unsigned char* ws = args.ws;
    if (IN(0)) { p0_prologue(F); SEAM(0); }
    if (IN(1)) {
        pg8::Gemm g{(const bf16*)(ws + WS_XB), (const bf16*)(ws + WS_WIN), T, NPROJ, D}; pg8::StaticOrder S; S.init(T, NPROJ, F.G, (int)blockIdx.x);
        EpiProj E{(bf16*)(ws + WS_P)};
        pg8::gemm_phase<EpiProj, pg8::StaticOrder, true, false>(F.lds, g, S, E);
        SEAM(1);
    }
    if (IN(2)) { attn_v1(F); SEAM(2); }
    if (IN(3)) { gdn_prep_v1(F); SEAM(3); }
    if (IN(4)) { gdn_scan_v1(F); SEAM(4); }
    if (IN(5)) { gdn_out_v1(F); SEAM(5); }
    if (IN(6)) {
        { pg8::Gemm g{(const bf16*)(ws + WS_YA), (const bf16*)(ws + WS_WA), T, D, 1024}; pg8::StaticOrder S; S.init(T, D, F.G, (int)blockIdx.x);
          EpiBranch<0> E{(const bf16*)(ws + WS_P) + 7 * PBUF, (float*)(ws + WS_TMP), (bf16*)(ws + WS_MRG)};
          pg8::gemm_phase<EpiBranch<0>, pg8::StaticOrder, true, false>(F.lds, g, S, E); }
        VM_WAIT(); __syncthreads();
        { pg8::Gemm g{(const bf16*)(ws + WS_YB), (const bf16*)(ws + WS_WB), T, D, 1024}; pg8::StaticOrder S; S.init(T, D, F.G, (int)blockIdx.x);
          EpiBranch<1> E{(const bf16*)(ws + WS_P) + 9 * PBUF, (float*)(ws + WS_TMP), (bf16*)(ws + WS_MRG)};
          pg8::gemm_phase<EpiBranch<1>, pg8::StaticOrder, true, false>(F.lds, g, S, E); }
        SEAM(6);
    }
    if (IN(7)) {
        pg8::Gemm g{(const bf16*)(ws + WS_MRG), (const bf16*)(ws + WS_WO), T, D, D}; pg8::StaticOrder S; S.init(T, D, F.G, (int)blockIdx.x);
        EpiOut E{F.in[0], (float*)(ws + WS_Y1)};
        pg8::gemm_phase<EpiOut, pg8::StaticOrder, true, false>(F.lds, g, S, E);
        SEAM(7);
    }
    if (IN(8)) { ln_router(F); SEAM(8); }
    if (IN(9)) {
        moe_tables(F);
        const LAS int* tp = (const LAS int*)(F.lds + LDS_TAB);
        MoeOrder S{tp, tp + 72, tp + 144, (const int*)(ws + WS_TOKL), 4, F.G, (int)blockIdx.x, 1024};
        pg8::Gemm g{(const bf16*)(ws + WS_X1B), (const bf16*)(ws + WS_WGU), T, 1024, D};
        EpiGU E{(bf16*)(ws + WS_HB)};
        pg8::gemm_phase<EpiGU, MoeOrder, true, true>(F.lds, g, S, E);
        SEAM(9);
    }
    if (IN(10)) {
        moe_tables(F);
        const LAS int* tp = (const LAS int*)(F.lds + LDS_TAB);
        MoeOrder S{tp, tp + 72, tp + 144, (const int*)(ws + WS_TOKL), 8, F.G, (int)blockIdx.x, D};
        pg8::Gemm g{(const bf16*)(ws + WS_HB), (const bf16*)(ws + WS_WD), T, D, FF};
        EpiDown E{(bf16*)(ws + WS_YAS), (const float*)(ws + WS_WGTL)};
        pg8::gemm_phase<EpiDown, MoeOrder, true, false>(F.lds, g, S, E);
        SEAM(10);
    }
    if (IN(11)) { final_ln(F); }
#undef IN
#undef SEAM
}

extern "C" void kernel_launch(void* const* d_in, const int* in_sizes, int n_in, void* d_out, int out_size, void* d_ws, size_t ws_size, hipStream_t stream) {
    static int grid = 0;
    if (grid == 0) {
        if (n_in != 24 || in_sizes[0] != T * D || out_size != T * D || ws_size < WS_END) { fprintf(stderr, "kernel_launch: unexpected shapes (n_in %d, ws %zu); nothing launched\n", n_in, ws_size); grid = -1; return; }
        int dev = 0, cus = 0, per_cu = 0;
        if (hipGetDevice(&dev) != hipSuccess || hipDeviceGetAttribute(&cus, hipDeviceAttributeMultiprocessorCount, dev) != hipSuccess) { grid = -1; return; }
        if (hipFuncSetAttribute((const void*)fwd, hipFuncAttributeMaxDynamicSharedMemorySize, LDS_BYTES) != hipSuccess) { fprintf(stderr, "kernel_launch: hipFuncSetAttribute failed\n"); grid = -1; return; }
        if (hipOccupancyMaxActiveBlocksPerMultiprocessor(&per_cu, (const void*)fwd, NTHR, LDS_BYTES) != hipSuccess || per_cu < 1) { fprintf(stderr, "kernel_launch: occupancy query says %d\n", per_cu); }
        (void)hipGetLastError();
        grid = cus;
    }
    if (grid < 0) return;
    if (hipMemsetAsync((char*)d_ws + WS_CTL, 0, CTL_ZERO_BYTES, stream) != hipSuccess) return;
    Args a{};
    for (int i = 0; i < 24; ++i) a.in[i] = (const float*)d_in[i];
    a.out = (float*)d_out; a.ws = (unsigned char*)d_ws;
#if MK_N_LAUNCHES == 1
    a.ph_lo = 0; a.ph_hi = NPHASE;
    hipLaunchKernelGGL(fwd, dim3(grid), dim3(NTHR), LDS_BYTES, stream, a);
#else
    for (int p = 0; p < NPHASE; ++p) { a.ph_lo = p; a.ph_hi = p + 1; hipLaunchKernelGGL(fwd, dim3(grid), dim3(NTHR), LDS_BYTES, stream, a); }
#endif
}
```

```cpp
#include <hip/hip_runtime.h>
#include <cstdio>
#include <cstdint>

#ifndef MK_N_LAUNCHES
#define MK_N_LAUNCHES 1
#endif

namespace pg8 {
#define PG8_LAS __attribute__((address_space(3)))
typedef unsigned short bf16_t;
typedef short bf16x8 __attribute__((ext_vector_type(8)));
typedef float f32x4 __attribute__((ext_vector_type(4)));
typedef unsigned u32x4 __attribute__((ext_vector_type(4)));
typedef unsigned u32x2 __attribute__((ext_vector_type(2)));
constexpr int BM = 256, BK = 64, HALF = 128, HTB = HALF * BK * 2  , STAGE_BYTES = 8 * HTB, NXCD = 8, WGM = 8;

__host__ __device__ __forceinline__ int lds_byte(int r, int c) { const int st = (r >> 4) * 2 + (c >> 5), rr = r & 15, cc = c & 31, ob = rr * 64 + cc * 2; return st * 1024 + (ob ^ (((ob >> 9) & 1) << 5)); }
__host__ __device__ __forceinline__ void stage_rc(int b, int& R, int& C) { const int st = b / 1024, sb = b % 1024, swz = sb ^ (((sb >> 9) & 1) << 5); R = (st >> 1) * 16 + swz / 64; C = (st & 1) * 32 + (swz % 64) / 2; }
__host__ __device__ __forceinline__ int perm32(int rho) { const int n = rho >> 4, i = rho & 15; return 8 * (i >> 2) + 4 * n + (i & 3); }

struct Unit { int pm, pn, arow, brow, r0, nv, e, lb; };
struct Gemm { const bf16_t* A; const bf16_t* Bt; int M, N, K; };

struct StaticOrder {
    int nM, nN, nwg, G, c;
    __host__ __device__ void init(int M, int N, int G_, int c_) { nM = M / BM; nN = N / BM; nwg = nM * nN; G = G_; c = c_; }
    __host__ __device__ bool next(int i, Unit& u) const {
        const long L = (long)i * G + c; if (L >= nwg) return false;
        int wgid = (int)L; { const int q = nwg / NXCD, r = nwg % NXCD, xcd = wgid % NXCD, off = wgid / NXCD; wgid = (xcd < r ? xcd * (q + 1) : r * (q + 1) + (xcd - r) * q) + off; }
        const int nig = WGM * nN, gid = wgid / nig, fm = gid * WGM, gsz = (nM - fm) < WGM ? (nM - fm) : WGM;
        u.pm = fm + ((wgid % nig) % gsz); u.pn = (wgid % nig) / gsz; u.arow = u.pm * BM; u.brow = u.pn * BM; u.r0 = u.arow; u.nv = BM; u.e = 0; u.lb = 0; return true;
    }
    __device__ __forceinline__ int row_of(const Unit&, int) const { return 0; }
};

__device__ __forceinline__ unsigned cvt_pk_bf16(float lo, float hi) { unsigned r; asm volatile("v_cvt_pk_bf16_f32 %0, %1, %2" : "=v"(r) : "v"(lo), "v"(hi)); return r; }

template <class Epi, class Sched, bool ALIGN_EPI, bool GATHER>
__device__ __forceinline__ void gemm_phase(PG8_LAS unsigned char* lds, const Gemm g, const Sched& S, const Epi& E) {
    static_assert(Epi::PERM, "epilogues use the PERM column layout");
    const int tid = threadIdx.x, wid = __builtin_amdgcn_readfirstlane(tid >> 6), lane = tid & 63, wr = wid >> 2, wc = wid & 3, fr = lane & 15, fq = lane >> 4;
    const int K = g.K, nt = K / BK;
    unsigned voffA[2], voffB[2]; int stR[2], stC[2];
#pragma unroll
    for (int i = 0; i < 2; ++i) { int R, C; stage_rc(tid * 16 + i * 8192, R, C); const int Rb = (R & ~31) + perm32(R & 31); stR[i] = R; stC[i] = C;
        voffA[i] = (unsigned)(R * K + C) * 2u; voffB[i] = (unsigned)(Rb * K + C) * 2u; }
    const size_t kstep = (size_t)(BK * 2);
    const size_t hstep = (size_t)HALF * K * 2;
    const size_t rstep = (size_t)K * 2;
    const unsigned ldsw = (unsigned)wid * 1024u;
    const int aoff = lds_byte(wr * 64 + fr, fq * 8), boff = lds_byte(wc * 32 + fr, fq * 8);
#define PG8_SA(b, h) (((b) * 2 + (h)) * HTB)
#define PG8_SB(b, h) ((4 + (b) * 2 + (h)) * HTB)
#define PG8_STAGE(bufoff, gbase, voff) do { _Pragma("unroll") for (int _i = 0; _i < 2; ++_i) \
        __builtin_amdgcn_global_load_lds((const unsigned*)((const char*)(gbase) + (voff)[_i]), (PG8_LAS unsigned*)(lds + (bufoff) + ldsw + _i * 8192), 16, 0, 0); } while (0)
#define PG8_STAGE_A(b, h, P, V) do { if constexpr (GATHER) { PG8_STAGE(PG8_SA(b, h), P, V[h]); } else { PG8_STAGE(PG8_SA(b, h), (P) + (h) * hstep, voffA); } } while (0)
#define PG8_LDA(dst, b, h) do { _Pragma("unroll") for (int m = 0; m < 4; ++m) _Pragma("unroll") for (int k = 0; k < 2; ++k) dst[m][k] = *(const PG8_LAS bf16x8*)(lds + PG8_SA(b, h) + aoff + m * 2048 + k * 1024); } while (0)
#define PG8_LDB(dst, b, h) do { _Pragma("unroll") for (int n = 0; n < 2; ++n) _Pragma("unroll") for (int k = 0; k < 2; ++k) dst[n][k] = *(const PG8_LAS bf16x8*)(lds + PG8_SB(b, h) + boff + n * 2048 + k * 1024); } while (0)
#define PG8_MMA(ai, bj, At, Bt) do { __builtin_amdgcn_s_setprio(1); _Pragma("unroll") for (int m = 0; m < 4; ++m) _Pragma("unroll") for (int n = 0; n < 2; ++n) _Pragma("unroll") for (int k = 0; k < 2; ++k) \
        acc[ai][bj][m][n] = __builtin_amdgcn_mfma_f32_16x16x32_bf16(Bt[n][k], At[m][k], acc[ai][bj][m][n], 0, 0, 0); __builtin_amdgcn_s_setprio(0); } while (0)
#define PG8_WAIT_V(n) asm volatile("s_waitcnt vmcnt(" #n ")" ::: "memory")
#define PG8_WAIT_L(n) asm volatile("s_waitcnt lgkmcnt(" #n ")" ::: "memory")
#define PG8_BAR __builtin_amdgcn_s_barrier()
#define PG8_SCHED __builtin_amdgcn_sched_barrier(0)
#define PG8_GOFF(V, u) do { if constexpr (GATHER) { _Pragma("unroll") for (int _h = 0; _h < 2; ++_h) _Pragma("unroll") for (int _i = 0; _i < 2; ++_i) \
        V[_h][_i] = (unsigned)(S.row_of(u, _h * HALF + stR[_i]) * K + stC[_i]) * 2u; } } while (0)
    Unit cur, nxt; int ui = 0;
    if (!S.next(0, cur)) return;
    f32x4 acc[2][2][4][2];
#pragma unroll
    for (int a = 0; a < 2; ++a)
#pragma unroll
        for (int b = 0; b < 2; ++b)
#pragma unroll
            for (int m = 0; m < 4; ++m)
#pragma unroll
                for (int n = 0; n < 2; ++n) acc[a][b][m][n] = (f32x4){0.f, 0.f, 0.f, 0.f};
    bf16x8 At[4][2], B0[2][2], B1[2][2];
    unsigned vcur[2][2] = {{0u, 0u}, {0u, 0u}}, vnxt[2][2] = {{0u, 0u}, {0u, 0u}}, v2[2][2] = {{0u, 0u}, {0u, 0u}};
    PG8_GOFF(vcur, cur);
    const char* cA = GATHER ? (const char*)g.A : (const char*)g.A + (size_t)cur.arow * rstep; const char* cB = (const char*)g.Bt + (size_t)cur.brow * rstep;
    PG8_STAGE(PG8_SB(0, 0), cB, voffB); PG8_STAGE(PG8_SB(0, 1), cB + hstep, voffB); PG8_STAGE_A(0, 0, cA, vcur); PG8_STAGE_A(0, 1, cA, vcur);
    if (wr == 1) PG8_BAR;
    PG8_WAIT_V(2); PG8_BAR;
    PG8_STAGE(PG8_SB(1, 0), cB + kstep, voffB); PG8_STAGE_A(1, 0, cA + kstep, vcur); PG8_STAGE(PG8_SB(1, 1), cB + hstep + kstep, voffB);
    PG8_WAIT_V(6); PG8_BAR;
    for (;;) {
        const bool has_next = S.next(ui + 1, nxt);
        if constexpr (GATHER) { if (has_next) { PG8_GOFF(vnxt, nxt); } else {
#pragma unroll
            for (int h = 0; h < 2; ++h)
#pragma unroll
                for (int i = 0; i < 2; ++i) vnxt[h][i] = vcur[h][i]; } }
        const char* nA = GATHER ? cA : (has_next ? (const char*)g.A + (size_t)nxt.arow * rstep : cA); const char* nB = has_next ? (const char*)g.Bt + (size_t)nxt.brow * rstep : cB;
        for (int t = 0; t < nt; t += 2) {
            const bool last = (t == nt - 2);
            const char* a1 = cA + (size_t)(t + 1) * kstep;
            const char* a2 = last ? nA : cA + (size_t)(t + 2) * kstep; const char* b2 = last ? nB : cB + (size_t)(t + 2) * kstep;
            const char* a3 = a2 + kstep; const char* b3 = b2 + kstep;
            if constexpr (GATHER) {
#pragma unroll
                for (int h = 0; h < 2; ++h)
#pragma unroll
                    for (int i = 0; i < 2; ++i) v2[h][i] = last ? vnxt[h][i] : vcur[h][i]; }
            PG8_LDB(B0, 0, 0); PG8_LDB(B1, 0, 1); PG8_SCHED; PG8_LDA(At, 0, 0); PG8_STAGE_A(1, 1, a1, vcur);
            PG8_WAIT_V(8); PG8_WAIT_L(0); PG8_BAR; PG8_MMA(0, 0, At, B0); PG8_MMA(0, 1, At, B1); PG8_BAR; PG8_SCHED;
            PG8_LDA(At, 0, 1); PG8_STAGE(PG8_SB(0, 0), b2, voffB); PG8_STAGE(PG8_SB(0, 1), b2 + hstep, voffB); PG8_STAGE_A(0, 0, a2, v2);
            PG8_WAIT_V(8); PG8_WAIT_L(0); PG8_BAR; PG8_MMA(1, 0, At, B0); PG8_MMA(1, 1, At, B1); PG8_BAR; PG8_SCHED;
            PG8_LDB(B0, 1, 0); PG8_LDB(B1, 1, 1); PG8_SCHED; PG8_LDA(At, 1, 0); PG8_STAGE_A(0, 1, a2, v2);
            PG8_WAIT_V(8); PG8_WAIT_L(0); PG8_BAR; PG8_MMA(0, 0, At, B0); PG8_MMA(0, 1, At, B1); PG8_BAR; PG8_SCHED;
            PG8_LDA(At, 1, 1); PG8_STAGE(PG8_SB(1, 0), b3, voffB); PG8_STAGE(PG8_SB(1, 1), b3 + hstep, voffB); PG8_STAGE_A(1, 0, a3, v2);
            PG8_WAIT_V(8); PG8_WAIT_L(0); PG8_BAR; PG8_MMA(1, 0, At, B0); PG8_MMA(1, 1, At, B1); PG8_BAR; PG8_SCHED;
        }
        if constexpr (ALIGN_EPI) { if (wr == 0) PG8_BAR; }
        E(acc, cur, wr, wc, fr, fq);
        if (!has_next) break;
#pragma unroll
        for (int a = 0; a < 2; ++a)
#pragma unroll
            for (int b = 0; b < 2; ++b)
#pragma unroll
                for (int m = 0; m < 4; ++m)
#pragma unroll
                    for (int n = 0; n < 2; ++n) acc[a][b][m][n] = (f32x4){0.f, 0.f, 0.f, 0.f};
        cur = nxt; cA = nA; cB = nB; ++ui;
        if constexpr (GATHER) {
#pragma unroll
            for (int h = 0; h < 2; ++h)
#pragma unroll
                for (int i = 0; i < 2; ++i) vcur[h][i] = vnxt[h][i]; }
        if constexpr (ALIGN_EPI) { if (wr == 1) PG8_BAR; }
    }
    PG8_WAIT_V(0);
    if constexpr (!ALIGN_EPI) { if (wr == 0) PG8_BAR; }
    PG8_BAR;
#undef PG8_SA
#undef PG8_SB
#undef PG8_STAGE
#undef PG8_STAGE_A
#undef PG8_LDA
#undef PG8_LDB
#undef PG8_MMA
#undef PG8_WAIT_V
#undef PG8_WAIT_L
#undef PG8_BAR
#undef PG8_SCHED
#undef PG8_GOFF
}
}

constexpr int NWAVES = 8, NTHR = 512;
constexpr int T = 8192, D = 2048, NPROJ = 11264, WIN_PITCH = 11280, NH = 8, NE = 64, NEX = 65, FF = 512, TOPK = 8, NCHUNK = 128;
constexpr float ALPHA = 1.18920711500272106672f, LN_EPS = 1e-5f, NORM_EPS = 1e-6f, LAMBDA_INIT = 0.2f, ROUTED_SCALE = 2.5f;
constexpr int NPHASE = 12;

constexpr size_t MiB = 1u << 20;
constexpr size_t WS_CTL = 0, CTL_ZERO_BYTES = 1 * MiB;
constexpr size_t WS_WA = 2 * MiB, WS_WB = 6 * MiB, WS_WO = 10 * MiB, WS_WGU = 18 * MiB, WS_WD = 278 * MiB;
constexpr size_t WS_X1F = 408 * MiB, WS_X1B = 472 * MiB, WS_YA = 504 * MiB, WS_YB = 520 * MiB;
constexpr size_t WS_TOKL = 536 * MiB, WS_WGTL = 539 * MiB, WS_INFO = 542 * MiB, WS_GL = 542 * MiB + 512 * 1024, WS_GAB = 543 * MiB;
constexpr size_t WS_WIN = 544 * MiB, WS_XB = 588 * MiB, WS_P = 620 * MiB;
constexpr size_t WS_U = 796 * MiB, WS_W = 828 * MiB, WS_QD = 860 * MiB, WS_KD = 892 * MiB, WS_AQK = 924 * MiB, WS_SST = 940 * MiB, WS_END = 1004 * MiB;
constexpr size_t WS_PK = 796 * MiB, WS_UL = 860 * MiB, WS_OG = 892 * MiB;
constexpr int PK_BYTES = 65536, PK_WN = 0, PK_QD = 17408, PK_KDT = 34816, PK_AQ = 53248;
constexpr size_t WS_TMP = 796 * MiB, WS_MRG = 860 * MiB, WS_Y1 = 892 * MiB;
constexpr size_t WS_HB = 544 * MiB, WS_YAS = 620 * MiB;
constexpr size_t PBUF = (size_t)T * 1024;
constexpr int CW_BAR = 4096;
constexpr int CW_CNT = 32768;

constexpr int RING_BYTES = 131072;
constexpr int LDS_TAB = RING_BYTES;
constexpr int MISC_OFF = RING_BYTES + 16384 - 256;
constexpr int LDS_BYTES = RING_BYTES + 16384;

#define GAS __attribute__((address_space(1)))
#define LAS __attribute__((address_space(3)))
typedef unsigned short bf16;
typedef unsigned v4u __attribute__((ext_vector_type(4)));
typedef unsigned v2u __attribute__((ext_vector_type(2)));
typedef float f32x4 __attribute__((ext_vector_type(4)));
typedef float f32x2 __attribute__((ext_vector_type(2)));
typedef short bf16x8 __attribute__((ext_vector_type(8)));
typedef GAS unsigned gu32;
#define RLX_AGENT __ATOMIC_RELAXED, __HIP_MEMORY_SCOPE_AGENT
#define LDS_WAIT() asm volatile("s_waitcnt lgkmcnt(0)" ::: "memory")
#define VM_WAIT() asm volatile("s_waitcnt vmcnt(0)" ::: "memory")
__device__ __forceinline__ unsigned f2bf(float f) { unsigned u = __builtin_bit_cast(unsigned, f); return (u + 0x7fffu + ((u >> 16) & 1u)) >> 16; }
__device__ __forceinline__ unsigned pk2(float lo, float hi) { return f2bf(lo) | (f2bf(hi) << 16); }
__device__ __forceinline__ float bflo(unsigned w) { return __builtin_bit_cast(float, w << 16); }
__device__ __forceinline__ float bfhi(unsigned w) { return __builtin_bit_cast(float, w & 0xffff0000u); }
__device__ __forceinline__ float bf2f(bf16 b) { return __builtin_bit_cast(float, (unsigned)b << 16); }
__device__ __forceinline__ float sigmoidf_(float x) { return 1.f / (1.f + __expf(-x)); }
__device__ __forceinline__ float siluf_(float x) { return x / (1.f + __expf(-x)); }

#define XB_TMO      128
#define XB_XCNT(j)  (256  + 64 * (j))
#define XB_XSUB(j)  (1280 + 64 * (j))
#define XB_XGEN(j)  (2304 + 64 * (j))
#define XB_TOP      3328
#define XB_TOPGEN   3392
#define XCD_BAR_WORDS 3456
#define XB_SPIN_CAP (1u << 22)

__device__ __forceinline__ unsigned xb_ld(unsigned* p)              { return __hip_atomic_load(p, __ATOMIC_RELAXED, __HIP_MEMORY_SCOPE_AGENT); }
__device__ __forceinline__ unsigned xb_add(unsigned* p, unsigned v) { return __hip_atomic_fetch_add(p, v, __ATOMIC_RELAXED, __HIP_MEMORY_SCOPE_AGENT); }
__device__ __forceinline__ unsigned xb_xcc_id() { return (unsigned)__builtin_amdgcn_s_getreg((3 << 11) | 20) & 0xFu; }
#define XB_SPIN(cond, bar) do { unsigned _sp = 0; while (cond) { __builtin_amdgcn_s_sleep(1); \
    if ((++_sp & 255u) == 0u) { if (xb_ld(&(bar)[XB_TMO])) break; if (_sp > XB_SPIN_CAP) { atomicAdd(&(bar)[XB_TMO], 1u); break; } } } } while (0)

struct XcdBarrier {
    unsigned* bar; unsigned x;
    volatile LAS unsigned* st;
};
__device__ __forceinline__ XcdBarrier xcd_barrier_post(unsigned* bar, volatile LAS unsigned* st) {
    XcdBarrier b; b.bar = bar; b.x = xb_xcc_id(); b.st = st;
    if (threadIdx.x == 0) (void)xb_add(&bar[XB_XCNT(b.x)], 1u);
    return b;
}
__device__ __forceinline__ void xcd_barrier_complete(unsigned* bar, unsigned x, unsigned& nloc, unsigned& nx) {
    const unsigned G = gridDim.x * gridDim.y * gridDim.z;
    unsigned sum, cnt, mine, sp = 0u;
    for (;;) {
        sum = 0u; cnt = 0u; mine = 0u;
#pragma unroll
        for (unsigned j = 0; j < 16; ++j) { const unsigned c = xb_ld(&bar[XB_XCNT(j)]); sum += c; cnt += (c > 0u) ? 1u : 0u; mine = (j == x) ? c : mine; }
        if (sum == G) break;
        __builtin_amdgcn_s_sleep(1);
        if ((++sp & 255u) == 0u) { if (xb_ld(&bar[XB_TMO])) break; if (sp > XB_SPIN_CAP) { atomicAdd(&bar[XB_TMO], 1u); break; } }
    }
    nloc = mine > 0u ? mine : 1u; nx = cnt > 0u ? cnt : 1u;
}
__device__ __forceinline__ void xcd_barrier(const XcdBarrier& b) {
    asm volatile("s_waitcnt vmcnt(0)" ::: "memory");
    __syncthreads();
    if (threadIdx.x == 0) {
        unsigned* bar = b.bar;
        __builtin_amdgcn_s_waitcnt(0);
        unsigned nloc = b.st[0], nx = b.st[1];
        if (nloc == 0u) { xcd_barrier_complete(bar, b.x, nloc, nx); b.st[0] = nloc; b.st[1] = nx; }
        const unsigned old = xb_add(&bar[XB_XSUB(b.x)], 1u);
        const unsigned gen = old / nloc;
        if (old + 1u == (gen + 1u) * nloc) {
            __builtin_amdgcn_fence(__ATOMIC_RELEASE, "agent");
            asm volatile("s_waitcnt vmcnt(0)" ::: "memory");
            const unsigned og = xb_add(&bar[XB_TOP], 1u);
            const unsigned tg = og / nx;
            if (og + 1u == (tg + 1u) * nx) xb_add(&bar[XB_TOPGEN], 1u);
            else XB_SPIN(xb_ld(&bar[XB_TOPGEN]) == tg, bar);
            __builtin_amdgcn_fence(__ATOMIC_ACQUIRE, "agent");
            xb_add(&bar[XB_XGEN(b.x)], 1u);
            asm volatile("s_waitcnt vmcnt(0)" ::: "memory");
        } else {
            XB_SPIN(xb_ld(&bar[XB_XGEN(b.x)]) == gen, bar);
            __builtin_amdgcn_fence(__ATOMIC_ACQUIRE, "agent");
            asm volatile("s_waitcnt vmcnt(0)" ::: "memory");
        }
    }
    __syncthreads();
}

struct Frame {
    LAS unsigned char* lds;
    gu32* ctl;
    int tid, lane, wave;
    int vcu, G;
    const float* in[24]; float* out; unsigned char* ws;
};
__device__ __forceinline__ float wave_sum(float v) {
#pragma unroll
    for (int o = 1; o < 64; o <<= 1) v += __shfl_xor(v, o);
    return v;
}
__device__ __forceinline__ float wave_max(float v) {
#pragma unroll
    for (int o = 1; o < 64; o <<= 1) v = fmaxf(v, __shfl_xor(v, o));
    return v;
}

__device__ __forceinline__ void p0_transpose_item(const float* W, int pitch, int sn0, bf16* WT, int dpitch, int dr0, int k0, LAS float* scr, int lane) {
#pragma unroll 8
    for (int i = 0; i < 32; ++i) { const int kk = 2 * i + (lane >> 5); scr[kk * 33 + (lane & 31)] = W[(size_t)(k0 + kk) * pitch + sn0 + (lane & 31)]; }
    LDS_WAIT(); asm volatile("" ::: "memory");
    const int c = lane & 7;
#pragma unroll
    for (int j = 0; j < 4; ++j) { const int n = (lane >> 3) + 8 * j; const LAS float* s = scr + (8 * c) * 33 + n;
        v4u o; o.x = pk2(s[0 * 33], s[1 * 33]); o.y = pk2(s[2 * 33], s[3 * 33]); o.z = pk2(s[4 * 33], s[5 * 33]); o.w = pk2(s[6 * 33], s[7 * 33]);
        *(GAS v4u*)(WT + (size_t)(dr0 + n) * dpitch + k0 + 8 * c) = o; }
    LDS_WAIT(); asm volatile("" ::: "memory");
}
__device__ __forceinline__ void p0_prologue(Frame& F) {
    unsigned char* ws = F.ws;
    {
        LAS float* w16 = (LAS float*)F.lds;
        for (int idx = F.tid; idx < 2048 * 4; idx += NTHR) { const int k = idx >> 2, q = idx & 3;
            const f32x4 v = *(const GAS f32x4*)(F.in[1] + (size_t)k * WIN_PITCH + 7168 + 4 * q); *(LAS f32x4*)(w16 + k * 16 + 4 * q) = v; }
        __syncthreads();
        float* gab = (float*)(ws + WS_GAB);
        for (int tok = F.vcu * NWAVES + F.wave; tok < T; tok += F.G * NWAVES) {
            float acc[16];
#pragma unroll
            for (int e = 0; e < 16; ++e) acc[e] = 0.f;
            const float* xr = F.in[0] + (size_t)tok * D;
#pragma unroll 2
            for (int j = 0; j < 32; ++j) { const int k = j * 64 + F.lane; const float xv = xr[k];
#pragma unroll
                for (int q = 0; q < 4; ++q) { const f32x4 w = *(const LAS f32x4*)(w16 + k * 16 + 4 * q);
                    acc[4 * q + 0] += xv * w.x; acc[4 * q + 1] += xv * w.y; acc[4 * q + 2] += xv * w.z; acc[4 * q + 3] += xv * w.w; } }
#pragma unroll
            for (int e = 0; e < 16; ++e) acc[e] = wave_sum(acc[e]);
            if (F.lane == 0) {
#pragma unroll
                for (int q = 0; q < 4; ++q) *(GAS f32x4*)(gab + (size_t)tok * 16 + 4 * q) = (f32x4){acc[4 * q], acc[4 * q + 1], acc[4 * q + 2], acc[4 * q + 3]}; }
        }
        __syncthreads();
    }
    LAS float* scr = (LAS float*)(F.lds + F.wave * 16384);
    const int gw = F.vcu * NWAVES + F.wave, NGW = F.G * NWAVES;
    constexpr int I_IN = 32 * 352, I_A = 16 * 64, I_O = 32 * 64, I_GU = NEX * 2 * 512, I_D = NEX * 512;
    constexpr int NITEMS = I_IN + 2 * I_A + I_O + I_GU + I_D;
    for (int it = gw; it < NITEMS; it += NGW) {
        int r = it;
        if (r < I_IN) { const int kb = r / 352, nb = r % 352, n0 = 32 * nb; p0_transpose_item(F.in[1], WIN_PITCH, n0 + (n0 >= 7168 ? 16 : 0), (bf16*)(ws + WS_WIN), D, n0, 64 * kb, scr, F.lane); continue; } r -= I_IN;
        if (r < I_A) { const int kb = r / 64, nb = r % 64; p0_transpose_item(F.in[9], D, 32 * nb, (bf16*)(ws + WS_WA), 1024, 32 * nb, 64 * kb, scr, F.lane); continue; } r -= I_A;
        if (r < I_A) { const int kb = r / 64, nb = r % 64; p0_transpose_item(F.in[10], D, 32 * nb, (bf16*)(ws + WS_WB), 1024, 32 * nb, 64 * kb, scr, F.lane); continue; } r -= I_A;
        if (r < I_O) { const int kb = r / 64, nb = r % 64; p0_transpose_item(F.in[11], D, 32 * nb, (bf16*)(ws + WS_WO), D, 32 * nb, 64 * kb, scr, F.lane); continue; } r -= I_O;
        if (r < I_GU) { const int e = r / 1024, which = (r >> 9) & 1, q = r & 511, kb = q / 16, nb = q % 16;
            const float* src = e < NE ? (which ? F.in[17] : F.in[16]) + (size_t)e * D * FF : (which ? F.in[20] : F.in[19]);
            p0_transpose_item(src, FF, 32 * nb, (bf16*)(ws + WS_WGU) + (size_t)e * 1024 * D, D, 256 * (nb >> 2) + 32 * (nb & 3) + 128 * which, 64 * kb, scr, F.lane); continue; } r -= I_GU;
        { const int e = r / 512, q = r & 511, kb = q / 64, nb = q % 64;
            const float* src = e < NE ? F.in[18] + (size_t)e * FF * D : F.in[21];
            p0_transpose_item(src, D, 32 * nb, (bf16*)(ws + WS_WD) + (size_t)e * D * FF, FF, 32 * nb, 64 * kb, scr, F.lane); }
    }
    { const GAS f32x4* x4 = (const GAS f32x4*)F.in[0]; GAS v4u* o = (GAS v4u*)(ws + WS_XB);
      for (size_t i = (size_t)F.vcu * NTHR + F.tid; i < (size_t)T * D / 8; i += (size_t)F.G * NTHR) { const f32x4 a = x4[2 * i], b = x4[2 * i + 1];
          v4u w; w.x = pk2(a.x, a.y); w.y = pk2(a.z, a.w); w.z = pk2(b.x, b.y); w.w = pk2(b.z, b.w); o[i] = w; } }
}

using pg8::Unit;
struct EpiProj {
    static constexpr bool PERM = true;
    bf16* P;
    __device__ __forceinline__ void operator()(const f32x4 (&acc)[2][2][4][2], const Unit& u, int wr, int wc, int fr, int fq) const {
        const int buf = u.pn >> 2, colt = (u.pn & 3) * 256; bf16* base = P + (size_t)buf * PBUF;
        const int row0 = u.r0 + wr * 64 + fr, col0 = colt + wc * 32 + 8 * fq; const bool sg = buf >= 7;
#pragma unroll
        for (int ai = 0; ai < 2; ++ai)
#pragma unroll
            for (int m = 0; m < 4; ++m) { bf16* rowp = base + (size_t)(row0 + ai * 128 + m * 16) * 1024 + col0;
#pragma unroll
                for (int bj = 0; bj < 2; ++bj) { f32x4 v0 = acc[ai][bj][m][0], v1 = acc[ai][bj][m][1];
                    if (sg) { v0 = (f32x4){sigmoidf_(v0.x), sigmoidf_(v0.y), sigmoidf_(v0.z), sigmoidf_(v0.w)}; v1 = (f32x4){sigmoidf_(v1.x), sigmoidf_(v1.y), sigmoidf_(v1.z), sigmoidf_(v1.w)}; }
                    v4u w; w.x = pk2(v0.x, v0.y); w.y = pk2(v0.z, v0.w); w.z = pk2(v1.x, v1.y); w.w = pk2(v1.z, v1.w);
                    *(GAS v4u*)(rowp + bj * 128) = w; } }
    }
};
template <int STEP> struct EpiBranch {
    static constexpr bool PERM = true;
    const bf16* SG; float* tmp; bf16* mrg;
    __device__ __forceinline__ void operator()(const f32x4 (&acc)[2][2][4][2], const Unit& u, int wr, int wc, int fr, int fq) const {
        const int row0 = u.r0 + wr * 64 + fr, colu = u.pn * 256 + wc * 32 + 8 * fq;
#pragma unroll
        for (int ai = 0; ai < 2; ++ai)
#pragma unroll
            for (int m = 0; m < 4; ++m) { const int row = row0 + ai * 128 + m * 16;
#pragma unroll
                for (int bj = 0; bj < 2; ++bj) { const int col = colu + bj * 128;
                    const v4u g = *(const GAS v4u*)(SG + (size_t)(col >> 10) * PBUF + (size_t)row * 1024 + (col & 1023));
                    f32x4 v0 = acc[ai][bj][m][0], v1 = acc[ai][bj][m][1];
                    v0 = v0 * (f32x4){bflo(g.x), bfhi(g.x), bflo(g.y), bfhi(g.y)}; v1 = v1 * (f32x4){bflo(g.z), bfhi(g.z), bflo(g.w), bfhi(g.w)};
                    float* tp = tmp + (size_t)row * D + col;
                    if (STEP == 0) { *(GAS f32x4*)tp = v0; *(GAS f32x4*)(tp + 4) = v1; }
                    else { v0 = v0 + *(const GAS f32x4*)tp; v1 = v1 + *(const GAS f32x4*)(tp + 4);
                        v4u w; w.x = pk2(v0.x, v0.y); w.y = pk2(v0.z, v0.w); w.z = pk2(v1.x, v1.y); w.w = pk2(v1.z, v1.w);
                        *(GAS v4u*)(mrg + (size_t)row * D + col) = w; } } }
    }
};
struct EpiOut {
    static constexpr bool PERM = true;
    const float* x; float* y1;
    __device__ __forceinline__ void operator()(const f32x4 (&acc)[2][2][4][2], const Unit& u, int wr, int wc, int fr, int fq) const {
        const int row0 = u.r0 + wr * 64 + fr, colu = u.pn * 256 + wc * 32 + 8 * fq;
#pragma unroll
        for (int ai = 0; ai < 2; ++ai)
#pragma unroll
            for (int m = 0; m < 4; ++m) { const size_t ro = (size_t)(row0 + ai * 128 + m * 16) * D;
#pragma unroll
                for (int bj = 0; bj < 2; ++bj) { const size_t o = ro + colu + bj * 128;
                    const f32x4 x0 = *(const GAS f32x4*)(x + o), x1 = *(const GAS f32x4*)(x + o + 4);
                    *(GAS f32x4*)(y1 + o) = x0 * ALPHA + acc[ai][bj][m][0]; *(GAS f32x4*)(y1 + o + 4) = x1 * ALPHA + acc[ai][bj][m][1]; } }
    }
};
struct EpiGU {
    static constexpr bool PERM = true;
    bf16* HB;
    __device__ __forceinline__ void operator()(const f32x4 (&acc)[2][2][4][2], const Unit& u, int wr, int wc, int fr, int fq) const {
        const int col = u.pn * 128 + wc * 32 + 8 * fq;
#pragma unroll
        for (int ai = 0; ai < 2; ++ai)
#pragma unroll
            for (int m = 0; m < 4; ++m) { const int r = ai * 128 + wr * 64 + m * 16 + fr;
                if (r < u.nv) { const f32x4 g0 = acc[ai][0][m][0], g1 = acc[ai][0][m][1], u0 = acc[ai][1][m][0], u1 = acc[ai][1][m][1];
                    v4u w; w.x = pk2(siluf_(g0.x) * u0.x, siluf_(g0.y) * u0.y); w.y = pk2(siluf_(g0.z) * u0.z, siluf_(g0.w) * u0.w);
                    w.z = pk2(siluf_(g1.x) * u1.x, siluf_(g1.y) * u1.y); w.w = pk2(siluf_(g1.z) * u1.z, siluf_(g1.w) * u1.w);
                    *(GAS v4u*)(HB + (size_t)(u.r0 + r) * FF + col) = w; } }
    }
};
struct EpiDown {
    static constexpr bool PERM = true;
    bf16* YAS; const float* wgtl;
    __device__ __forceinline__ void operator()(const f32x4 (&acc)[2][2][4][2], const Unit& u, int wr, int wc, int fr, int fq) const {
        const int colu = u.pn * 256 + wc * 32 + 8 * fq;
#pragma unroll
        for (int ai = 0; ai < 2; ++ai)
#pragma unroll
            for (int m = 0; m < 4; ++m) { const int r = ai * 128 + wr * 64 + m * 16 + fr;
                if (r < u.nv) { const float wg = wgtl[u.lb + r];
#pragma unroll
                    for (int bj = 0; bj < 2; ++bj) { const f32x4 v0 = acc[ai][bj][m][0] * wg, v1 = acc[ai][bj][m][1] * wg;
                        v4u w; w.x = pk2(v0.x, v0.y); w.y = pk2(v0.z, v0.w); w.z = pk2(v1.x, v1.y); w.w = pk2(v1.z, v1.w);
                        *(GAS v4u*)(YAS + (size_t)(u.r0 + r) * D + colu + bj * 128) = w; } } }
    }
};
struct MoeOrder {
    const LAS int* tpref; const LAS int* rbase; const LAS int* cnts; const int* tokl; int NT, G, c, brows;
    __device__ __forceinline__ bool next(int i, Unit& u) const {
        const int L = i * G + c; if (L >= tpref[NEX] * NT) return false;
        const int tg = L / NT, nt = L % NT; int e = 0;
        while (tpref[e + 1] <= tg) ++e;
        const int mt = tg - tpref[e];
        u.e = e; u.pm = mt; u.pn = nt; u.lb = e * T + mt * 256; u.nv = min(256, cnts[e] - mt * 256); u.r0 = rbase[e] + mt * 256; u.arow = u.r0; u.brow = e * brows + nt * 256; return true;
    }
    __device__ __forceinline__ int row_of(const Unit& u, int r) const { return r < u.nv ? tokl[u.lb + r] : 0; }
};
__device__ __forceinline__ void moe_tables(Frame& F) {
    LAS int* tpref = (LAS int*)(F.lds + LDS_TAB); LAS int* rbase = tpref + 72; LAS int* cnts = rbase + 72;
    __syncthreads();
    if (F.wave == 0) {
        const int c = (int)__hip_atomic_load(F.ctl + CW_CNT + 64 * F.lane, RLX_AGENT);
        int tl = (c + 255) >> 8, tp = tl, rb = c;
#pragma unroll
        for (int o = 1; o < 64; o <<= 1) { const int a = __shfl_up(tp, o), b = __shfl_up(rb, o); if (F.lane >= o) { tp += a; rb += b; } }
        tpref[F.lane] = tp - tl; rbase[F.lane] = rb - c; cnts[F.lane] = c;
        if (F.lane == 63) { tpref[64] = tp; rbase[64] = rb; cnts[64] = T; tpref[65] = tp + T / 256; rbase[65] = rb + T; }
    }
    __syncthreads();
}

__device__ __forceinline__ int t5_bucket(int rel) {
    const int n = rel < 0 ? -rel : rel; int b;
    if (n < 8) b = n; else if (n < 12) b = 8; else if (n < 16) b = 9; else if (n < 23) b = 10; else if (n < 32) b = 11; else if (n < 46) b = 12; else if (n < 64) b = 13; else if (n < 91) b = 14; else b = 15;
    return b + (rel > 0 ? 16 : 0);
}
typedef short s16x4 __attribute__((ext_vector_type(4)));
__device__ __forceinline__ void attn_v1(Frame& F) {
    LAS bf16* Kl = (LAS bf16*)F.lds;
    LAS bf16* Vt = Kl + 64 * 136;
    LAS float* Ox = (LAS float*)(F.lds + 65536);
    LAS float* relb = (LAS float*)(F.lds + LDS_TAB);
    const bf16* Pq = (const bf16*)(F.ws + WS_P); const bf16* Pk = Pq + PBUF; const bf16* Pv = Pq + 2 * PBUF;
    bf16* ya = (bf16*)(F.ws + WS_YA);
    const int tid = F.tid, lane = F.lane, l15 = lane & 15, g = lane >> 4, qs = F.wave & 3, map = F.wave >> 2;
    float lam;
    { const float* dl = F.in[6]; float s01 = 0.f, s23 = 0.f;
      for (int d = 0; d < 64; ++d) { s01 += dl[d] * dl[64 + d]; s23 += dl[128 + d] * dl[192 + d]; }
      lam = expf(s01) - expf(s23) + LAMBDA_INIT; }
    for (int L = blockIdx.x; L < NH * NCHUNK; L += F.G) {
        const int h = L & 7, c = NCHUNK - 1 - (L >> 3);
        __syncthreads();
        if (tid < 256) relb[tid] = F.in[8][t5_bucket(tid - 191) * 8 + h];
        const int qrow = 16 * qs + l15;
        bf16x8 qf[2];
#pragma unroll
        for (int s = 0; s < 2; ++s) qf[s] = *(const GAS bf16x8*)(Pq + (size_t)(c * 64 + qrow) * 1024 + h * 128 + map * 64 + 32 * s + 8 * g);
        float mrun = -INFINITY, lrun = 0.f; f32x4 o[8];
#pragma unroll
        for (int rb = 0; rb < 8; ++rb) o[rb] = (f32x4){0.f, 0.f, 0.f, 0.f};
        for (int j = 0; j <= c; ++j) {
            __syncthreads();
            { const int r = tid >> 3, cs = (tid & 7) * 16; const size_t go = (size_t)(j * 64 + r) * 1024 + h * 128 + cs;
              const v4u a0 = *(const GAS v4u*)(Pk + go), a1 = *(const GAS v4u*)(Pk + go + 8), b0 = *(const GAS v4u*)(Pv + go), b1 = *(const GAS v4u*)(Pv + go + 8);
              *(LAS v4u*)(Kl + r * 136 + cs) = a0; *(LAS v4u*)(Kl + r * 136 + cs + 8) = a1;
              const unsigned bw[8] = {b0.x, b0.y, b0.z, b0.w, b1.x, b1.y, b1.z, b1.w};
#pragma unroll
              for (int i = 0; i < 8; ++i) { Vt[(cs + 2 * i) * 72 + r] = (bf16)(bw[i] & 0xffffu); Vt[(cs + 2 * i + 1) * 72 + r] = (bf16)(bw[i] >> 16); } }
            __syncthreads();
            f32x4 st[4];
#pragma unroll
            for (int t = 0; t < 4; ++t) { st[t] = (f32x4){0.f, 0.f, 0.f, 0.f};
#pragma unroll
                for (int s = 0; s < 2; ++s) { const bf16x8 kf = *(const LAS bf16x8*)(Kl + (16 * t + l15) * 136 + map * 64 + 32 * s + 8 * g);
                    st[t] = __builtin_amdgcn_mfma_f32_16x16x32_bf16(kf, qf[s], st[t], 0, 0, 0); } }
            float mt = -INFINITY;
            if (j >= c - 2) {
#pragma unroll
                for (int t = 0; t < 4; ++t)
#pragma unroll
                    for (int r = 0; r < 4; ++r) { st[t][r] = st[t][r] * 0.125f + relb[(j - c) * 64 + 16 * t + 4 * g + r - qrow + 191]; mt = fmaxf(mt, st[t][r]); }
            } else { const float bfar = relb[0];
#pragma unroll
                for (int t = 0; t < 4; ++t)
#pragma unroll
                    for (int r = 0; r < 4; ++r) { st[t][r] = st[t][r] * 0.125f + bfar; mt = fmaxf(mt, st[t][r]); } }
            mt = fmaxf(mt, __shfl_xor(mt, 16)); mt = fmaxf(mt, __shfl_xor(mt, 32));
            const float mn = fmaxf(mrun, mt), corr = __expf(mrun - mn);
            lrun *= corr; mrun = mn;
#pragma unroll
            for (int rb = 0; rb < 8; ++rb) o[rb] = o[rb] * corr;
            float ps = 0.f;
#pragma unroll
            for (int t = 0; t < 4; ++t)
#pragma unroll
                for (int r = 0; r < 4; ++r) { st[t][r] = __expf(st[t][r] - mn); ps += st[t][r]; }
            lrun += ps;
            bf16x8 pf[2];
#pragma unroll
            for (int s = 0; s < 2; ++s) { const v4u w = (v4u){pk2(st[2 * s][0], st[2 * s][1]), pk2(st[2 * s][2], st[2 * s][3]), pk2(st[2 * s + 1][0], st[2 * s + 1][1]), pk2(st[2 * s + 1][2], st[2 * s + 1][3])};
                pf[s] = __builtin_bit_cast(bf16x8, w); }
#pragma unroll
            for (int rb = 0; rb < 8; ++rb)
#pragma unroll
                for (int s = 0; s < 2; ++s) { const LAS bf16* vp = Vt + (16 * rb + l15) * 72 + 32 * s + 4 * g;
                    const v2u lo = *(const LAS v2u*)vp, hi = *(const LAS v2u*)(vp + 16);
                    const bf16x8 vf = __builtin_bit_cast(bf16x8, (v4u){lo.x, lo.y, hi.x, hi.y});
                    o[rb] = __builtin_amdgcn_mfma_f32_16x16x32_bf16(vf, pf[s], o[rb], 0, 0, 0); }
        }
        lrun += __shfl_xor(lrun, 16); lrun += __shfl_xor(lrun, 32);
        __syncthreads();
        { const float inv = 1.f / lrun; LAS float* od = Ox + (map * 64 + qrow) * 128;
#pragma unroll
          for (int rb = 0; rb < 8; ++rb) *(LAS f32x4*)(od + 16 * rb + 4 * g) = o[rb] * inv; }
        __syncthreads();
        { const int qq = tid >> 3, seg = (tid & 7) * 16; float a[16], ss = 0.f;
#pragma unroll
          for (int i = 0; i < 16; ++i) { a[i] = Ox[qq * 128 + seg + i] - lam * Ox[(64 + qq) * 128 + seg + i]; ss += a[i] * a[i]; }
          ss += __shfl_xor(ss, 1); ss += __shfl_xor(ss, 2); ss += __shfl_xor(ss, 4);
          const float r = rsqrtf(ss * (1.f / 128.f) + NORM_EPS) * (1.f - LAMBDA_INIT);
          unsigned w[8];
#pragma unroll
          for (int i = 0; i < 8; ++i) w[i] = pk2(a[2 * i] * r * F.in[7][seg + 2 * i], a[2 * i + 1] * r * F.in[7][seg + 2 * i + 1]);
          GAS v4u* op = (GAS v4u*)(ya + (size_t)(c * 64 + qq) * 1024 + h * 128 + seg);
          op[0] = (v4u){w[0], w[1], w[2], w[3]}; op[1] = (v4u){w[4], w[5], w[6], w[7]}; }
    }
}

__device__ __forceinline__ int swap23(int x) { return (x & ~12) | ((x & 4) << 1) | ((x & 8) >> 1); }
__device__ __forceinline__ void gdn_prep_v1(Frame& F) {
    LAS float* Ks = (LAS float*)F.lds;
    LAS float* Qs = Ks + 64 * 129;
    LAS float* Vs = Qs + 64 * 129;
    LAS float* As = Vs + 64 * 128;
    LAS float* Tm = As + 64 * 68;
    LAS float* gcs = Tm + 64 * 68;
    LAS float* bts = gcs + 64;
    LAS float* egs = bts + 64;
    const bf16* P3 = (const bf16*)(F.ws + WS_P) + 3 * PBUF;
    const float* gab = (const float*)(F.ws + WS_GAB);
    float* GLg = (float*)(F.ws + WS_GL);
    const int tid = F.tid, lane = F.lane;
    for (int L = blockIdx.x; L < NH * NCHUNK; L += F.G) {
        const int n = L >> 3, h = L & 7, t0 = n * 64;
        __syncthreads();
        for (int idx = tid; idx < 64 * 384; idx += NTHR) { const int t = idx / 384, ch = idx % 384, which = ch >> 7, i = ch & 127, cg = which * 1024 + h * 128 + i;
            const bf16* src = P3 + (size_t)which * PBUF + h * 128 + i; float a = 0.f;
#pragma unroll
            for (int j = 0; j < 4; ++j) { const int tt = t0 + t - 3 + j; if (tt >= 0) a += bf2f(src[(size_t)tt * 1024]) * F.in[2][j * 3072 + cg]; }
            a = siluf_(a);
            if (which == 0) Qs[t * 129 + i] = a; else if (which == 1) Ks[t * 129 + i] = a; else Vs[t * 128 + i] = a; }
        __syncthreads();
        for (int t = F.wave * 8; t < F.wave * 8 + 8; ++t) {
            const float q0 = Qs[t * 129 + lane], q1 = Qs[t * 129 + 64 + lane], k0 = Ks[t * 129 + lane], k1 = Ks[t * 129 + 64 + lane];
            const float rq = rsqrtf(wave_sum(q0 * q0 + q1 * q1) + NORM_EPS) * 0.08838834764831845f, rk = rsqrtf(wave_sum(k0 * k0 + k1 * k1) + NORM_EPS);
            Qs[t * 129 + lane] = q0 * rq; Qs[t * 129 + 64 + lane] = q1 * rq; Ks[t * 129 + lane] = k0 * rk; Ks[t * 129 + 64 + lane] = k1 * rk; }
        if (F.wave == 0) { const int tok = t0 + lane; const float ga = gab[(size_t)tok * 16 + h] + F.in[4][h], gb = gab[(size_t)tok * 16 + 8 + h];
            const float sp = fmaxf(ga, 0.f) + log1pf(expf(-fabsf(ga))); float g = -expf(F.in[3][h]) * sp;
#pragma unroll
            for (int o = 1; o < 64; o <<= 1) { const float v = __shfl_up(g, o); if (lane >= o) g += v; }
            gcs[lane] = g; bts[lane] = 1.f / (1.f + expf(-gb)); egs[lane] = expf(g); }
        __syncthreads();
        for (int idx = tid; idx < 4096; idx += NTHR) { const int c = idx >> 6, s = idx & 63; float kk = 0.f, qk = 0.f;
            if (s <= c) { for (int i = 0; i < 128; ++i) { const float ks = Ks[s * 129 + i]; kk += Ks[c * 129 + i] * ks; qk += Qs[c * 129 + i] * ks; }
                const float dec = expf(gcs[c] - gcs[s]); kk *= dec * bts[c]; qk *= dec; }
            As[c * 68 + s] = (s < c) ? kk : 0.f; ((bf16*)(F.ws + WS_PK + (size_t)(h * NCHUNK + n) * PK_BYTES + PK_AQ))[c * 72 + swap23(s)] = (bf16)f2bf((s <= c) ? qk : 0.f); }
        __syncthreads();
        if (F.wave == 0) {
            for (int i = 0; i < 64; ++i) { float a = (i == lane) ? 1.f : 0.f;
#pragma unroll 4
                for (int j = 0; j < i; ++j) a -= As[i * 68 + j] * Tm[j * 68 + lane];
                Tm[i * 68 + lane] = a; }
        }
        __syncthreads();
        unsigned char* pk = F.ws + WS_PK + (size_t)(h * NCHUNK + n) * PK_BYTES; float* ul = (float*)(F.ws + WS_UL) + (size_t)(h * NCHUNK + n) * 4 * 64 * 32;
        for (int idx = tid; idx < 64 * 256; idx += NTHR) { const int c = idx >> 8, col = idx & 255; float a = 0.f;
            if (col < 128) { for (int s = 0; s <= c; ++s) a += Tm[c * 68 + s] * bts[s] * Vs[s * 128 + col];
                const int cp = c & 31; ul[(((col >> 5) * 64) + (col & 31) + 32 * ((cp >> 2) & 1)) * 32 + (c >> 5) * 16 + (cp & 3) + 4 * (cp >> 3)] = a; }
            else { const int i = col - 128; for (int s = 0; s <= c; ++s) a += Tm[c * 68 + s] * bts[s] * egs[s] * Ks[s * 129 + i];
                ((bf16*)(pk + PK_WN))[c * 136 + swap23(i)] = (bf16)f2bf(-a); } }
        const float glast = gcs[63];
        for (int idx = tid; idx < 64 * 128; idx += NTHR) { const int t = idx >> 7, i = idx & 127;
            ((bf16*)(pk + PK_QD))[t * 136 + swap23(i)] = (bf16)f2bf(Qs[t * 129 + i] * egs[t]);
            ((bf16*)(pk + PK_KDT))[i * 72 + swap23(t)] = (bf16)f2bf(Ks[t * 129 + i] * expf(glast - gcs[t])); }
        if (tid == 0) GLg[L] = expf(glast);
    }
}
__device__ __forceinline__ void gdn_prep_v2(Frame& F) {
    typedef float f32x16_ __attribute__((ext_vector_type(16)));
    LAS bf16* Kb = (LAS bf16*)F.lds;
    LAS bf16* Qb = Kb + 64 * 136;
    LAS bf16* Vt = Qb + 64 * 136;
    LAS bf16* KBt = Vt + 128 * 72;
    LAS float* As = (LAS float*)(KBt + 128 * 72);
    LAS float* Tm = As + 64 * 68;
    LAS float* Tp = Tm + 64 * 68;
    LAS bf16* Tmb = (LAS bf16*)(Tp + 32 * 36);
    LAS float* gcs = (LAS float*)(Tmb + 64 * 72);
    LAS float* bts = gcs + 64;
    LAS float* egs = bts + 64;
    LAS float* eks = egs + 64;
    const bf16* P3 = (const bf16*)(F.ws + WS_P) + 3 * PBUF;
    const float* gab = (const float*)(F.ws + WS_GAB);
    float* GLg = (float*)(F.ws + WS_GL);
    for (int L = blockIdx.x; L < NH * NCHUNK; L += F.G) {
        int tid = F.tid; asm volatile("" : "+v"(tid));
        const int lane = tid & 63, i31 = lane & 31, hh = lane >> 5;
        const int n = L >> 3, h = L & 7, t0 = n * 64;
        unsigned char* pk = F.ws + WS_PK + (size_t)(h * NCHUNK + n) * PK_BYTES; float* ul = (float*)(F.ws + WS_UL) + (size_t)(h * NCHUNK + n) * 4 * 64 * 32;
        __syncthreads();
        if (F.wave == 0) { const int tok = t0 + lane; const float ga = gab[(size_t)tok * 16 + h] + F.in[4][h], gb = gab[(size_t)tok * 16 + 8 + h];
            const float sp = fmaxf(ga, 0.f) + log1pf(expf(-fabsf(ga))); float g = -expf(F.in[3][h]) * sp;
#pragma unroll
            for (int o = 1; o < 64; o <<= 1) { const float v = __shfl_up(g, o); if (lane >= o) g += v; }
            const float glast = __shfl(g, 63);
            gcs[lane] = g; bts[lane] = 1.f / (1.f + expf(-gb)); egs[lane] = expf(g); eks[lane] = expf(glast - g);
            if (lane == 0) GLg[L] = expf(glast); }
        for (int idx = tid; idx < 64 * 68; idx += NTHR) Tm[idx] = 0.f;
        const int seg = tid & 63, trow = tid >> 6, which = seg >> 4, sc = (seg & 15) * 8;
        float ov[8][8];
        if (seg < 48) {
            const int cg = which * 1024 + h * 128 + sc; float cw[4][8];
#pragma unroll
            for (int j = 0; j < 4; ++j) { const f32x4 a = *(const GAS f32x4*)(F.in[2] + j * 3072 + cg), b = *(const GAS f32x4*)(F.in[2] + j * 3072 + cg + 4);
                cw[j][0] = a.x; cw[j][1] = a.y; cw[j][2] = a.z; cw[j][3] = a.w; cw[j][4] = b.x; cw[j][5] = b.y; cw[j][6] = b.z; cw[j][7] = b.w; }
            const bf16* src = P3 + (size_t)which * PBUF + h * 128 + sc; v4u xw[11];
#pragma unroll
            for (int m = 0; m < 11; ++m) { const int tt = t0 + 8 * trow - 3 + m; xw[m] = (v4u){0u, 0u, 0u, 0u}; if (tt >= 0) xw[m] = *(const GAS v4u*)(src + (size_t)tt * 1024); }
#pragma unroll
            for (int ti = 0; ti < 8; ++ti) {
#pragma unroll
                for (int c2 = 0; c2 < 4; ++c2) { float a0 = 0.f, a1 = 0.f;
#pragma unroll
                    for (int j = 0; j < 4; ++j) { const unsigned w = xw[ti + j][c2]; a0 += bflo(w) * cw[j][2 * c2]; a1 += bfhi(w) * cw[j][2 * c2 + 1]; }
                    ov[ti][2 * c2] = siluf_(a0); ov[ti][2 * c2 + 1] = siluf_(a1); } }
        } else {
#pragma unroll
            for (int ti = 0; ti < 8; ++ti)
#pragma unroll
                for (int ch = 0; ch < 8; ++ch) ov[ti][ch] = 0.f; }
#pragma unroll
        for (int ti = 0; ti < 8; ++ti) { float ss = 0.f;
#pragma unroll
            for (int ch = 0; ch < 8; ++ch) ss += ov[ti][ch] * ov[ti][ch];
            ss += __shfl_xor(ss, 1); ss += __shfl_xor(ss, 2); ss += __shfl_xor(ss, 4); ss += __shfl_xor(ss, 8);
            const float rn = which == 0 ? rsqrtf(ss + NORM_EPS) * 0.08838834764831845f : (which == 1 ? rsqrtf(ss + NORM_EPS) : 1.f);
#pragma unroll
            for (int ch = 0; ch < 8; ++ch) ov[ti][ch] *= rn; }
        __syncthreads();
        if (seg < 48) {
            const int a = (sc >> 3) & 1, g16 = sc & ~15;
            if (which == 0) {
#pragma unroll
                for (int ti = 0; ti < 8; ++ti) { const int t = 8 * trow + ti; const float e = egs[t];
                    *(LAS v4u*)(Qb + t * 136 + sc) = (v4u){pk2(ov[ti][0], ov[ti][1]), pk2(ov[ti][2], ov[ti][3]), pk2(ov[ti][4], ov[ti][5]), pk2(ov[ti][6], ov[ti][7])};
                    bf16* qd = (bf16*)(pk + PK_QD) + t * 136 + g16 + 4 * a;
                    *(GAS v2u*)qd = (v2u){pk2(ov[ti][0] * e, ov[ti][1] * e), pk2(ov[ti][2] * e, ov[ti][3] * e)};
                    *(GAS v2u*)(qd + 8) = (v2u){pk2(ov[ti][4] * e, ov[ti][5] * e), pk2(ov[ti][6] * e, ov[ti][7] * e)}; }
            } else if (which == 1) {
                float be[8], ek[8];
#pragma unroll
                for (int ti = 0; ti < 8; ++ti) { const int t = 8 * trow + ti; be[ti] = bts[t] * egs[t]; ek[ti] = eks[t];
                    *(LAS v4u*)(Kb + t * 136 + sc) = (v4u){pk2(ov[ti][0], ov[ti][1]), pk2(ov[ti][2], ov[ti][3]), pk2(ov[ti][4], ov[ti][5]), pk2(ov[ti][6], ov[ti][7])}; }
                const int ta = trow & 1, tg16 = (8 * trow) & ~15;
#pragma unroll
                for (int ch = 0; ch < 8; ++ch) {
                    *(LAS v4u*)(KBt + (sc + ch) * 72 + 8 * trow) = (v4u){pk2(ov[0][ch] * be[0], ov[1][ch] * be[1]), pk2(ov[2][ch] * be[2], ov[3][ch] * be[3]), pk2(ov[4][ch] * be[4], ov[5][ch] * be[5]), pk2(ov[6][ch] * be[6], ov[7][ch] * be[7])};
                    bf16* kd = (bf16*)(pk + PK_KDT) + (sc + ch) * 72 + tg16 + 4 * ta;
                    *(GAS v2u*)kd = (v2u){pk2(ov[0][ch] * ek[0], ov[1][ch] * ek[1]), pk2(ov[2][ch] * ek[2], ov[3][ch] * ek[3])};
                    *(GAS v2u*)(kd + 8) = (v2u){pk2(ov[4][ch] * ek[4], ov[5][ch] * ek[5]), pk2(ov[6][ch] * ek[6], ov[7][ch] * ek[7])}; }
            } else {
                float be[8];
#pragma unroll
                for (int ti = 0; ti < 8; ++ti) be[ti] = bts[8 * trow + ti];
#pragma unroll
                for (int ch = 0; ch < 8; ++ch)
                    *(LAS v4u*)(Vt + (sc + ch) * 72 + 8 * trow) = (v4u){pk2(ov[0][ch] * be[0], ov[1][ch] * be[1]), pk2(ov[2][ch] * be[2], ov[3][ch] * be[3]), pk2(ov[4][ch] * be[4], ov[5][ch] * be[5]), pk2(ov[6][ch] * be[6], ov[7][ch] * be[7])};
            }
        }
        __syncthreads();
        { const int kind = F.wave >> 2, mb = (F.wave >> 1) & 1, nb = F.wave & 1; const LAS bf16* Am = kind ? Qb : Kb; f32x16_ acc;
#pragma unroll
          for (int r = 0; r < 16; ++r) acc[r] = 0.f;
#pragma unroll
          for (int ks = 0; ks < 8; ++ks) { const bf16x8 a = *(const LAS bf16x8*)(Am + (32 * mb + i31) * 136 + 16 * ks + 8 * hh), b = *(const LAS bf16x8*)(Kb + (32 * nb + i31) * 136 + 16 * ks + 8 * hh);
              acc = __builtin_amdgcn_mfma_f32_32x32x16_bf16(a, b, acc, 0, 0, 0); }
          const int s = 32 * nb + i31; const float gs = gcs[s];
#pragma unroll
          for (int r = 0; r < 16; ++r) { const int c = 32 * mb + (r & 3) + 8 * (r >> 2) + 4 * hh; const float dec = expf(s <= c ? gcs[c] - gs : 0.f);
              if (kind == 0) As[c * 68 + s] = (s < c) ? bts[c] * acc[r] * dec : 0.f;
              else ((bf16*)(pk + PK_AQ))[c * 72 + swap23(s)] = (bf16)f2bf((s <= c) ? acc[r] * dec : 0.f); } }
        __syncthreads();
        if (F.wave < 4 && lane < 16) { const int b0 = 16 * F.wave; float tc[16];
#pragma unroll
            for (int i = 0; i < 16; ++i) { float a = (i == lane) ? 1.f : 0.f;
#pragma unroll
                for (int m = 0; m < i; ++m) a -= As[(b0 + i) * 68 + b0 + m] * tc[m];
                tc[i] = a; Tm[(b0 + i) * 68 + b0 + lane] = a; } }
        __syncthreads();
        { const int p = tid >> 8, o = tid & 255, r = o >> 4, cc = o & 15, rb = 16 + 32 * p, cbs = 32 * p; float a = 0.f;
#pragma unroll
          for (int m = 0; m < 16; ++m) a += As[(rb + r) * 68 + cbs + m] * Tm[(cbs + m) * 68 + cbs + cc];
          Tp[p * 256 + o] = a;
          __syncthreads();
          float b = 0.f;
#pragma unroll
          for (int m = 0; m < 16; ++m) b += Tm[(rb + r) * 68 + rb + m] * Tp[p * 256 + m * 16 + cc];
          __syncthreads();
          Tm[(rb + r) * 68 + cbs + cc] = -b; }
        __syncthreads();
        { float a[2];
#pragma unroll
          for (int q = 0; q < 2; ++q) { const int o = tid + 512 * q, r = o >> 5, cc = o & 31; a[q] = 0.f;
#pragma unroll 8
              for (int m = 0; m < 32; ++m) a[q] += As[(32 + r) * 68 + m] * Tm[m * 68 + cc]; }
          __syncthreads();
#pragma unroll
          for (int q = 0; q < 2; ++q) { const int o = tid + 512 * q; Tp[(o >> 5) * 36 + (o & 31)] = a[q]; }
          __syncthreads();
#pragma unroll
          for (int q = 0; q < 2; ++q) { const int o = tid + 512 * q, r = o >> 5, cc = o & 31; a[q] = 0.f;
#pragma unroll 8
              for (int m = 0; m < 32; ++m) a[q] += Tm[(32 + r) * 68 + 32 + m] * Tp[m * 36 + cc]; }
#pragma unroll
          for (int q = 0; q < 2; ++q) { const int o = tid + 512 * q; Tm[(32 + (o >> 5)) * 68 + (o & 31)] = -a[q]; } }
        __syncthreads();
        for (int idx = tid; idx < 64 * 32; idx += NTHR) { const int c = idx >> 5, s2 = (idx & 31) * 2; *(LAS unsigned*)(Tmb + c * 72 + s2) = pk2(Tm[c * 68 + s2], Tm[c * 68 + s2 + 1]); }
        __syncthreads();
        if (F.wave < 4) { const int cb = F.wave;
#pragma unroll
            for (int mb = 0; mb < 2; ++mb) { f32x16_ acc;
#pragma unroll
                for (int r = 0; r < 16; ++r) acc[r] = 0.f;
#pragma unroll
                for (int ks = 0; ks < 4; ++ks) { const bf16x8 a = *(const LAS bf16x8*)(Tmb + (32 * mb + i31) * 72 + 16 * ks + 8 * hh), b = *(const LAS bf16x8*)(Vt + (32 * cb + i31) * 72 + 16 * ks + 8 * hh);
                    acc = __builtin_amdgcn_mfma_f32_32x32x16_bf16(a, b, acc, 0, 0, 0); }
                float* up = ul + (cb * 64 + lane) * 32 + mb * 16;
#pragma unroll
                for (int q = 0; q < 4; ++q) *(GAS f32x4*)(up + 4 * q) = (f32x4){acc[4 * q], acc[4 * q + 1], acc[4 * q + 2], acc[4 * q + 3]}; }
        } else { const int db = F.wave - 4;
#pragma unroll
            for (int nb = 0; nb < 2; ++nb) { f32x16_ acc;
#pragma unroll
                for (int r = 0; r < 16; ++r) acc[r] = 0.f;
#pragma unroll
                for (int ks = 0; ks < 4; ++ks) { const bf16x8 a = *(const LAS bf16x8*)(KBt + (32 * db + i31) * 72 + 16 * ks + 8 * hh), b = *(const LAS bf16x8*)(Tmb + (32 * nb + i31) * 72 + 16 * ks + 8 * hh);
                    acc = __builtin_amdgcn_mfma_f32_32x32x16_bf16(a, b, acc, 0, 0, 0); }
                bf16* wp = (bf16*)(pk + PK_WN) + (32 * nb + i31) * 136 + 32 * db + 8 * hh;
#pragma unroll
                for (int q = 0; q < 4; ++q) *(GAS v2u*)(wp + 16 * (q >> 1) + 4 * (q & 1)) = (v2u){pk2(-acc[4 * q], -acc[4 * q + 1]), pk2(-acc[4 * q + 2], -acc[4 * q + 3])}; }
        }
    }
}
typedef float f32x16 __attribute__((ext_vector_type(16)));
__device__ __forceinline__ bf16x8 cvt8(const f32x16& x, int s) {
    v4u w;
    if (s == 0) { w.x = pk2(x[0], x[1]); w.y = pk2(x[2], x[3]); w.z = pk2(x[4], x[5]); w.w = pk2(x[6], x[7]); }
    else { w.x = pk2(x[8], x[9]); w.y = pk2(x[10], x[11]); w.z = pk2(x[12], x[13]); w.w = pk2(x[14], x[15]); }
    return __builtin_bit_cast(bf16x8, w);
}
__device__ __forceinline__ void gdn_scan_v2(Frame& F) {
    if (blockIdx.x >= 8) return;
    const int h = blockIdx.x, lane = F.lane;
    const unsigned char* PK = F.ws + WS_PK + (size_t)(h * NCHUNK) * PK_BYTES;
    if (F.wave >= 4) {
        const int lw = F.wave - 4;
#pragma unroll 1
        for (int n = -1; n < NCHUNK; ++n) {
            if (n + 1 < NCHUNK) { const unsigned char* src = PK + (size_t)(n + 1) * PK_BYTES + lw * 16384 + lane * 16; LAS unsigned char* dst = F.lds + ((n + 1) & 1) * PK_BYTES + lw * 16384;
#pragma unroll
                for (int p = 0; p < 16; ++p) __builtin_amdgcn_global_load_lds((const unsigned*)(src + p * 1024), (LAS unsigned*)(dst + p * 1024), 16, 0, 0); }
            asm volatile("s_waitcnt vmcnt(0)" ::: "memory"); __builtin_amdgcn_s_barrier(); asm volatile("" ::: "memory");
        }
    } else {
        const int cb = F.wave, i31 = lane & 31, hh = lane >> 5;
        const float* GLg = (const float*)(F.ws + WS_GL);
        const float* ul = (const float*)(F.ws + WS_UL) + ((size_t)(h * NCHUNK) * 4 + cb) * 64 * 32 + lane * 32;
        float* og = (float*)(F.ws + WS_OG) + h * 128 + cb * 32 + i31;
        f32x16 S[4], vn[2], O[2];
#pragma unroll
        for (int b = 0; b < 4; ++b)
#pragma unroll
            for (int r = 0; r < 16; ++r) S[b][r] = 0.f;
#pragma unroll
        for (int mb = 0; mb < 2; ++mb)
#pragma unroll
            for (int q = 0; q < 4; ++q) { const f32x4 v = *(const GAS f32x4*)(ul + mb * 16 + 4 * q); vn[mb][4 * q] = v.x; vn[mb][4 * q + 1] = v.y; vn[mb][4 * q + 2] = v.z; vn[mb][4 * q + 3] = v.w; }
        __builtin_amdgcn_s_barrier(); asm volatile("" ::: "memory");
#pragma unroll 1
        for (int n = 0; n < NCHUNK; ++n) {
            const LAS unsigned char* buf = F.lds + (n & 1) * PK_BYTES;
            bf16x8 sf[8];
#pragma unroll
            for (int b = 0; b < 4; ++b) { sf[2 * b] = cvt8(S[b], 0); sf[2 * b + 1] = cvt8(S[b], 1); }
#pragma unroll
            for (int mb = 0; mb < 2; ++mb) {
#pragma unroll
                for (int r = 0; r < 16; ++r) O[mb][r] = 0.f;
#pragma unroll
                for (int ks = 0; ks < 8; ++ks) { const bf16x8 a = *(const LAS bf16x8*)(buf + PK_WN + (32 * mb + i31) * 272 + (16 * ks + 8 * hh) * 2);
                    vn[mb] = __builtin_amdgcn_mfma_f32_32x32x16_bf16(a, sf[ks], vn[mb], 0, 0, 0); }
#pragma unroll
                for (int ks = 0; ks < 8; ++ks) { const bf16x8 a = *(const LAS bf16x8*)(buf + PK_QD + (32 * mb + i31) * 272 + (16 * ks + 8 * hh) * 2);
                    O[mb] = __builtin_amdgcn_mfma_f32_32x32x16_bf16(a, sf[ks], O[mb], 0, 0, 0); } }
            bf16x8 vf[4];
#pragma unroll
            for (int mb = 0; mb < 2; ++mb) { vf[2 * mb] = cvt8(vn[mb], 0); vf[2 * mb + 1] = cvt8(vn[mb], 1); }
            if (n + 1 < NCHUNK) { const float* un = ul + (size_t)(n + 1) * 4 * 64 * 32;
#pragma unroll
                for (int mb = 0; mb < 2; ++mb)
#pragma unroll
                    for (int q = 0; q < 4; ++q) { const f32x4 v = *(const GAS f32x4*)(un + mb * 16 + 4 * q); vn[mb][4 * q] = v.x; vn[mb][4 * q + 1] = v.y; vn[mb][4 * q + 2] = v.z; vn[mb][4 * q + 3] = v.w; } }
#pragma unroll
            for (int mb = 0; mb < 2; ++mb) {
#pragma unroll
                for (int ks = 0; ks < 4; ++ks) { const bf16x8 a = *(const LAS bf16x8*)(buf + PK_AQ + (32 * mb + i31) * 144 + (16 * ks + 8 * hh) * 2);
                    O[mb] = __builtin_amdgcn_mfma_f32_32x32x16_bf16(a, vf[ks], O[mb], 0, 0, 0); }
#pragma unroll
                for (int r = 0; r < 16; ++r) og[(size_t)(n * 64 + 32 * mb + (r & 3) + 8 * (r >> 2) + 4 * hh) * 1024] = O[mb][r]; }
            const float gl = GLg[n * 8 + h];
#pragma unroll
            for (int b = 0; b < 4; ++b) { S[b] = S[b] * gl;
#pragma unroll
                for (int ks = 0; ks < 4; ++ks) { const bf16x8 a = *(const LAS bf16x8*)(buf + PK_KDT + (32 * b + i31) * 144 + (16 * ks + 8 * hh) * 2);
                    S[b] = __builtin_amdgcn_mfma_f32_32x32x16_bf16(a, vf[ks], S[b], 0, 0, 0); } }
            asm volatile("s_waitcnt lgkmcnt(0)" ::: "memory"); __builtin_amdgcn_s_barrier(); asm volatile("" ::: "memory");
        }
    }
}
__device__ __forceinline__ void gdn_norm(Frame& F) {
    const float* og = (const float*)(F.ws + WS_OG); const bf16* Pz = (const bf16*)(F.ws + WS_P) + 6 * PBUF; bf16* yb = (bf16*)(F.ws + WS_YB);
    const int lane = F.lane, col = lane * 16;
    for (int tok = F.vcu * NWAVES + F.wave; tok < T; tok += F.G * NWAVES) {
        const size_t o = (size_t)tok * 1024 + col; float v[16], ss = 0.f;
#pragma unroll
        for (int q = 0; q < 4; ++q) { const f32x4 x = *(const GAS f32x4*)(og + o + 4 * q); v[4 * q] = x.x; v[4 * q + 1] = x.y; v[4 * q + 2] = x.z; v[4 * q + 3] = x.w; ss += (x.x * x.x + x.y * x.y) + (x.z * x.z + x.w * x.w); }
        ss += __shfl_xor(ss, 1); ss += __shfl_xor(ss, 2); ss += __shfl_xor(ss, 4);
        const float r = rsqrtf(ss * (1.f / 128.f) + NORM_EPS);
        const v4u z0 = *(const GAS v4u*)(Pz + o), z1 = *(const GAS v4u*)(Pz + o + 8);
        const float zz[16] = {bflo(z0.x), bfhi(z0.x), bflo(z0.y), bfhi(z0.y), bflo(z0.z), bfhi(z0.z), bflo(z0.w), bfhi(z0.w), bflo(z1.x), bfhi(z1.x), bflo(z1.y), bfhi(z1.y), bflo(z1.z), bfhi(z1.z), bflo(z1.w), bfhi(z1.w)};
        unsigned w[8];
#pragma unroll
        for (int x = 0; x < 8; ++x) { const int c0 = (col & 127) + 2 * x; w[x] = pk2(v[2 * x] * r * F.in[5][c0] * siluf_(zz[2 * x]), v[2 * x + 1] * r * F.in[5][c0 + 1] * siluf_(zz[2 * x + 1])); }
        *(GAS v4u*)(yb + o) = (v4u){w[0], w[1], w[2], w[3]}; *(GAS v4u*)(yb + o + 8) = (v4u){w[4], w[5], w[6], w[7]};
    }
}

__device__ __forceinline__ void ln_router(Frame& F) {
    constexpr int XS = 2052;
    LAS float* X1s = (LAS float*)F.lds;
    LAS float* LG = (LAS float*)(F.lds + 131584);
    LAS int* hist = (LAS int*)(LG + 1024);
    LAS int* gbs = hist + 64;
    const float* y1 = (const float*)(F.ws + WS_Y1); float* x1f = (float*)(F.ws + WS_X1F); bf16* x1b = (bf16*)(F.ws + WS_X1B);
    int* tokl = (int*)(F.ws + WS_TOKL); float* wgtl = (float*)(F.ws + WS_WGTL); unsigned* info = (unsigned*)(F.ws + WS_INFO);
    const float* g1 = F.in[12]; const float* b1 = F.in[13]; const float* wr = F.in[14]; const float* rb = F.in[15];
    const int tid = F.tid, lane = F.lane;
    for (int blk = blockIdx.x; blk < T / 16; blk += F.G) {
        const int tb = blk * 16;
        __syncthreads();
        if (tid < 64) hist[tid] = 0;
#pragma unroll 1
        for (int tt = 0; tt < 2; ++tt) { const int tl = F.wave * 2 + tt, tok = tb + tl;
            const GAS f32x4* yr = (const GAS f32x4*)(y1 + (size_t)tok * D) + lane; f32x4 v[8]; float s = 0.f;
#pragma unroll
            for (int j = 0; j < 8; ++j) { v[j] = yr[64 * j]; s += (v[j].x + v[j].y) + (v[j].z + v[j].w); }
            const float mean = wave_sum(s) * (1.f / D); float s2 = 0.f;
#pragma unroll
            for (int j = 0; j < 8; ++j) { v[j] = v[j] - mean; s2 += (v[j].x * v[j].x + v[j].y * v[j].y) + (v[j].z * v[j].z + v[j].w * v[j].w); }
            const float rstd = rsqrtf(wave_sum(s2) * (1.f / D) + LN_EPS);
#pragma unroll
            for (int j = 0; j < 8; ++j) { const int col = j * 256 + lane * 4; const f32x4 gg = *(const GAS f32x4*)(g1 + col), bb = *(const GAS f32x4*)(b1 + col);
                const f32x4 xo = v[j] * rstd * gg + bb;
                *(GAS f32x4*)(x1f + (size_t)tok * D + col) = xo; *(GAS v2u*)(x1b + (size_t)tok * D + col) = (v2u){pk2(xo.x, xo.y), pk2(xo.z, xo.w)};
                *(LAS f32x4*)(X1s + tl * XS + col) = xo; }
            if (lane == 0) { tokl[NE * T + tok] = tok; wgtl[NE * T + tok] = 1.f; } }
        __syncthreads();
        { const int eg = lane & 15, tg = lane >> 4; f32x4 acc[4];
#pragma unroll
          for (int ti = 0; ti < 4; ++ti) acc[ti] = (f32x4){0.f, 0.f, 0.f, 0.f};
          const float* wp = wr + (size_t)(256 * F.wave) * NE + 4 * eg; const LAS float* xp = X1s + (4 * tg) * XS + 256 * F.wave;
#pragma unroll 4
          for (int d0 = 0; d0 < 256; d0 += 4) { f32x4 xv[4], wv[4];
#pragma unroll
              for (int dd = 0; dd < 4; ++dd) wv[dd] = *(const GAS f32x4*)(wp + (size_t)(d0 + dd) * NE);
#pragma unroll
              for (int ti = 0; ti < 4; ++ti) xv[ti] = *(const LAS f32x4*)(xp + ti * XS + d0);
#pragma unroll
              for (int ti = 0; ti < 4; ++ti) { acc[ti] = acc[ti] + wv[0] * xv[ti].x; acc[ti] = acc[ti] + wv[1] * xv[ti].y; acc[ti] = acc[ti] + wv[2] * xv[ti].z; acc[ti] = acc[ti] + wv[3] * xv[ti].w; } }
          __syncthreads();
#pragma unroll
          for (int ti = 0; ti < 4; ++ti) *(LAS f32x4*)(X1s + ((F.wave * 16 + 4 * tg + ti) * 64 + 4 * eg)) = acc[ti];
          __syncthreads();
          { const int o = tid * 2; float a0 = 0.f, a1 = 0.f;
#pragma unroll
            for (int w = 0; w < 8; ++w) { const f32x2 p = *(const LAS f32x2*)(X1s + w * 1024 + o); a0 += p.x; a1 += p.y; }
            LG[o] = a0; LG[o + 1] = a1; } }
        __syncthreads();
        bool sel[2]; int loc[2]; float wsl[2]; unsigned long long msk[2];
#pragma unroll
        for (int tt = 0; tt < 2; ++tt) { const int tl = F.wave * 2 + tt;
            const float score = 1.f / (1.f + expf(-LG[tl * 64 + lane])), ch = score + rb[lane];
            int rk = 0;
#pragma unroll
            for (int x = 1; x < 8; ++x) { const float cj = __shfl_xor(ch, x); rk += (cj > ch || (cj == ch && (lane ^ x) < lane)) ? 1 : 0; }
            float gs = rk < 2 ? ch : 0.f; gs += __shfl_xor(gs, 1); gs += __shfl_xor(gs, 2); gs += __shfl_xor(gs, 4);
            const int g = lane >> 3; int grk = 0;
#pragma unroll
            for (int x = 1; x < 8; ++x) { const float gj = __shfl_xor(gs, 8 * x); grk += (gj > gs || (gj == gs && (g ^ x) < g)) ? 1 : 0; }
            const float mk = grk < 4 ? ch : -INFINITY; int erk = 0;
#pragma unroll
            for (int j = 0; j < 64; ++j) { const float mj = __builtin_bit_cast(float, __builtin_amdgcn_readlane(__builtin_bit_cast(int, mk), j)); erk += (mj > mk || (mj == mk && j < lane)) ? 1 : 0; }
            sel[tt] = (grk < 4) && (erk < TOPK);
            const float ssum = wave_sum(sel[tt] ? score : 0.f); wsl[tt] = score / ssum * ROUTED_SCALE;
            msk[tt] = __ballot(sel[tt]);
            loc[tt] = sel[tt] ? atomicAdd((int*)&hist[lane], 1) : 0; }
        __syncthreads();
        if (tid < 64) { const int hc = hist[tid]; gbs[tid] = hc ? (int)__hip_atomic_fetch_add(F.ctl + CW_CNT + 64 * tid, (unsigned)hc, RLX_AGENT) : 0; }
        __syncthreads();
#pragma unroll
        for (int tt = 0; tt < 2; ++tt) if (sel[tt]) { const int tok = tb + F.wave * 2 + tt, slot = gbs[lane] + loc[tt];
            tokl[lane * T + slot] = tok; wgtl[lane * T + slot] = wsl[tt];
            const int k = __popcll(msk[tt] & ((1ull << lane) - 1ull)); info[tok * 8 + k] = ((unsigned)lane << 16) | (unsigned)slot; }
    }
}
__device__ __forceinline__ void final_ln(Frame& F) {
    moe_tables(F);
    const LAS int* rbase = (const LAS int*)(F.lds + LDS_TAB) + 72;
    const float* x1f = (const float*)(F.ws + WS_X1F); const bf16* yas = (const bf16*)(F.ws + WS_YAS); const unsigned* info = (const unsigned*)(F.ws + WS_INFO);
    const float* g2 = F.in[22]; const float* b2 = F.in[23];
    const int lane = F.lane;
    for (int tok = F.vcu * NWAVES + F.wave; tok < T; tok += F.G * NWAVES) {
        f32x4 v[8];
        const GAS f32x4* xr = (const GAS f32x4*)(x1f + (size_t)tok * D) + lane;
#pragma unroll
        for (int j = 0; j < 8; ++j) v[j] = xr[64 * j] * ALPHA;
        for (int k = 0; k < 9; ++k) { int row;
            if (k < 8) { const unsigned w = info[tok * 8 + k]; row = rbase[w >> 16] + (int)(w & 0xffffu); } else row = NE * T * 0 + 65536 + tok;
            const GAS v2u* yr = (const GAS v2u*)(yas + (size_t)row * D) + lane;
#pragma unroll
            for (int j = 0; j < 8; ++j) { const v2u w = yr[64 * j]; v[j] = v[j] + (f32x4){bflo(w.x), bfhi(w.x), bflo(w.y), bfhi(w.y)}; } }
        float s = 0.f;
#pragma unroll
        for (int j = 0; j < 8; ++j) s += (v[j].x + v[j].y) + (v[j].z + v[j].w);
        const float mean = wave_sum(s) * (1.f / D); float s2 = 0.f;
#pragma unroll
        for (int j = 0; j < 8; ++j) { v[j] = v[j] - mean; s2 += (v[j].x * v[j].x + v[j].y * v[j].y) + (v[j].z * v[j].z + v[j].w * v[j].w); }
        const float rstd = rsqrtf(wave_sum(s2) * (1.f / D) + LN_EPS);
#pragma unroll
        for (int j = 0; j < 8; ++j) { const int col = j * 256 + lane * 4; const f32x4 gg = *(const GAS f32x4*)(g2 + col), bb = *(const GAS f32x4*)(b2 + col);
            *(GAS f32x4*)(F.out + (size_t)tok * D + col) = v[j] * rstd * gg + bb; }
    }
}

struct Args { const float* in[24]; float* out; unsigned char* ws; int ph_lo, ph_hi; };
__global__ void __launch_bounds__(NTHR, 2) fwd(Args args) {
    extern __shared__ __attribute__((aligned(16))) unsigned char lds[];
    Frame F;
    F.lds = (LAS unsigned char*)lds;
    F.tid = threadIdx.x; F.lane = F.tid & 63; F.wave = __builtin_amdgcn_readfirstlane(F.tid >> 6);
    F.G = gridDim.x; { const int bx = blockIdx.x; F.vcu = (F.G % 8 == 0) ? (bx % 8) * (F.G / 8) + bx / 8 : bx; }
    F.ws = args.ws; F.ctl = (gu32*)(args.ws + WS_CTL); F.out = args.out;
#pragma unroll
    for (int i = 0; i < 24; ++i) F.in[i] = args.in[i];
    volatile LAS unsigned* MISC = (volatile LAS unsigned*)(F.lds + MISC_OFF);
    if (F.tid < 64) MISC[F.tid] = 0u;
    __syncthreads();
    const int lo = args.ph_lo, hi = args.ph_hi;
    const bool multi = (hi - lo) > 1;
    XcdBarrier bar; bar.bar = (unsigned*)(F.ctl + CW_BAR); bar.x = 0; bar.st = nullptr;
    if (multi) bar = xcd_barrier_post((unsigned*)(F.ctl + CW_BAR), MISC + 8);
#ifndef ONLY_PHASE
#define ONLY_PHASE -1
#endif
#define IN(k) ((ONLY_PHASE < 0 || ONLY_PHASE == (k)) && lo <= (k) && (k) < hi)
#define SEAM(k) do { if (IN(k) && IN((k) + 1)) xcd_barrier(bar); } while (0)
    unsigned char* ws = args.ws;
#ifndef DUP_PHASE
#define DUP_PHASE -1
#endif
#define DUPBAR() do { VM_WAIT(); if (multi) xcd_barrier(bar); else __syncthreads(); } while (0)
    if (IN(0)) { p0_prologue(F); if (DUP_PHASE == 0) { __syncthreads(); p0_prologue(F); } SEAM(0); }
    if (IN(1)) {

        pg8::Gemm g{(const bf16*)(ws + WS_XB), (const bf16*)(ws + WS_WIN), T, NPROJ, D}; pg8::StaticOrder S; S.init(T, NPROJ, F.G, (int)blockIdx.x);
        EpiProj E{(bf16*)(ws + WS_P)};
        pg8::gemm_phase<EpiProj, pg8::StaticOrder, true, false>(F.lds, g, S, E);
        if (DUP_PHASE == 1) { VM_WAIT(); __syncthreads(); pg8::gemm_phase<EpiProj, pg8::StaticOrder, true, false>(F.lds, g, S, E); }
        SEAM(1);
    }
    if (IN(2)) { attn_v1(F); if (DUP_PHASE == 2) { DUPBAR(); attn_v1(F); } SEAM(2); }
    if (IN(3)) { gdn_prep_v2(F); if (DUP_PHASE == 3) { __syncthreads(); gdn_prep_v2(F); } SEAM(3); }
    if (IN(4)) { gdn_scan_v2(F); if (DUP_PHASE == 4) { __syncthreads(); gdn_scan_v2(F); } SEAM(4); }
    if (IN(5)) { gdn_norm(F); if (DUP_PHASE == 5) { __syncthreads(); gdn_norm(F); } SEAM(5); }
    if (IN(6)) {

        { pg8::Gemm g{(const bf16*)(ws + WS_YA), (const bf16*)(ws + WS_WA), T, D, 1024}; pg8::StaticOrder S; S.init(T, D, F.G, (int)blockIdx.x);
          EpiBranch<0> E{(const bf16*)(ws + WS_P) + 7 * PBUF, (float*)(ws + WS_TMP), (bf16*)(ws + WS_MRG)};
          pg8::gemm_phase<EpiBranch<0>, pg8::StaticOrder, true, false>(F.lds, g, S, E); }
        VM_WAIT(); __syncthreads();
        { pg8::Gemm g{(const bf16*)(ws + WS_YB), (const bf16*)(ws + WS_WB), T, D, 1024}; pg8::StaticOrder S; S.init(T, D, F.G, (int)blockIdx.x);
          EpiBranch<1> E{(const bf16*)(ws + WS_P) + 9 * PBUF, (float*)(ws + WS_TMP), (bf16*)(ws + WS_MRG)};
          pg8::gemm_phase<EpiBranch<1>, pg8::StaticOrder, true, false>(F.lds, g, S, E); }
        SEAM(6);
    }
    if (IN(7)) {

        pg8::Gemm g{(const bf16*)(ws + WS_MRG), (const bf16*)(ws + WS_WO), T, D, D}; pg8::StaticOrder S; S.init(T, D, F.G, (int)blockIdx.x);
        EpiOut E{F.in[0], (float*)(ws + WS_Y1)};
        pg8::gemm_phase<EpiOut, pg8::StaticOrder, true, false>(F.lds, g, S, E);
        if (DUP_PHASE == 7) { VM_WAIT(); __syncthreads(); pg8::gemm_phase<EpiOut, pg8::StaticOrder, true, false>(F.lds, g, S, E); }
        SEAM(7);
    }
    if (IN(8)) { ln_router(F); SEAM(8); }
    if (IN(9)) {

        moe_tables(F);
        const LAS int* tp = (const LAS int*)(F.lds + LDS_TAB);
        MoeOrder S{tp, tp + 72, tp + 144, (const int*)(ws + WS_TOKL), 4, F.G, (int)blockIdx.x, 1024};
        pg8::Gemm g{(const bf16*)(ws + WS_X1B), (const bf16*)(ws + WS_WGU), T, 1024, D};
        EpiGU E{(bf16*)(ws + WS_HB)};
        pg8::gemm_phase<EpiGU, MoeOrder, true, true>(F.lds, g, S, E);
        if (DUP_PHASE == 9) { VM_WAIT(); __syncthreads(); pg8::gemm_phase<EpiGU, MoeOrder, true, true>(F.lds, g, S, E); }
        SEAM(9);
    }
    if (IN(10)) {

        moe_tables(F);
        const LAS int* tp = (const LAS int*)(F.lds + LDS_TAB);
        MoeOrder S{tp, tp + 72, tp + 144, (const int*)(ws + WS_TOKL), 8, F.G, (int)blockIdx.x, D};
        pg8::Gemm g{(const bf16*)(ws + WS_HB), (const bf16*)(ws + WS_WD), T, D, FF};
        EpiDown E{(bf16*)(ws + WS_YAS), (const float*)(ws + WS_WGTL)};
        pg8::gemm_phase<EpiDown, MoeOrder, true, false>(F.lds, g, S, E);
        if (DUP_PHASE == 10) { VM_WAIT(); __syncthreads(); pg8::gemm_phase<EpiDown, MoeOrder, true, false>(F.lds, g, S, E); }
        SEAM(10);
    }
    if (IN(11)) { final_ln(F); if (DUP_PHASE == 11) { VM_WAIT(); __syncthreads(); final_ln(F); } }
#undef IN
#undef SEAM
}

extern "C" void kernel_launch(void* const* d_in, const int* in_sizes, int n_in, void* d_out, int out_size, void* d_ws, size_t ws_size, hipStream_t stream) {
    static int grid = 0;
    if (grid == 0) {
        if (n_in != 24 || in_sizes[0] != T * D || out_size != T * D || ws_size < WS_END) { fprintf(stderr, "kernel_launch: unexpected shapes (n_in %d, ws %zu); nothing launched\n", n_in, ws_size); grid = -1; return; }
        int dev = 0, cus = 0, per_cu = 0;
        if (hipGetDevice(&dev) != hipSuccess || hipDeviceGetAttribute(&cus, hipDeviceAttributeMultiprocessorCount, dev) != hipSuccess) { grid = -1; return; }
        if (hipFuncSetAttribute((const void*)fwd, hipFuncAttributeMaxDynamicSharedMemorySize, LDS_BYTES) != hipSuccess) { fprintf(stderr, "kernel_launch: hipFuncSetAttribute failed\n"); grid = -1; return; }
        if (hipOccupancyMaxActiveBlocksPerMultiprocessor(&per_cu, (const void*)fwd, NTHR, LDS_BYTES) != hipSuccess || per_cu < 1) { fprintf(stderr, "kernel_launch: occupancy query says %d\n", per_cu); }
        (void)hipGetLastError();
        grid = cus;
    }
    if (grid < 0) return;
    if (hipMemsetAsync((char*)d_ws + WS_CTL, 0, CTL_ZERO_BYTES, stream) != hipSuccess) return;
    Args a{};
    for (int i = 0; i < 24; ++i) a.in[i] = (const float*)d_in[i];
    a.out = (float*)d_out; a.ws = (unsigned char*)d_ws;
#if MK_N_LAUNCHES == 1
    a.ph_lo = 0; a.ph_hi = NPHASE;
    hipLaunchKernelGGL(fwd, dim3(grid), dim3(NTHR), LDS_BYTES, stream, a);
#else
    for (int p = 0; p < NPHASE; ++p) { a.ph_lo = p; a.ph_hi = p + 1; hipLaunchKernelGGL(fwd, dim3(grid), dim3(NTHR), LDS_BYTES, stream, a); }
#endif
}
```

```cpp
#include <hip/hip_runtime.h>
#include <cstdio>
#include <cstdint>

#ifndef MK_N_LAUNCHES
#define MK_N_LAUNCHES 1
#endif

namespace pg8 {
#define PG8_LAS __attribute__((address_space(3)))
typedef unsigned short bf16_t;
typedef short bf16x8 __attribute__((ext_vector_type(8)));
typedef float f32x4 __attribute__((ext_vector_type(4)));
typedef unsigned u32x4 __attribute__((ext_vector_type(4)));
typedef unsigned u32x2 __attribute__((ext_vector_type(2)));
constexpr int BM = 256, BK = 64, HALF = 128, HTB = HALF * BK * 2  , STAGE_BYTES = 8 * HTB, NXCD = 8, WGM = 8;

__host__ __device__ __forceinline__ int lds_byte(int r, int c) { const int st = (r >> 4) * 2 + (c >> 5), rr = r & 15, cc = c & 31, ob = rr * 64 + cc * 2; return st * 1024 + (ob ^ (((ob >> 9) & 1) << 5)); }
__host__ __device__ __forceinline__ void stage_rc(int b, int& R, int& C) { const int st = b / 1024, sb = b % 1024, swz = sb ^ (((sb >> 9) & 1) << 5); R = (st >> 1) * 16 + swz / 64; C = (st & 1) * 32 + (swz % 64) / 2; }
__host__ __device__ __forceinline__ int perm32(int rho) { const int n = rho >> 4, i = rho & 15; return 8 * (i >> 2) + 4 * n + (i & 3); }

struct Unit { int pm, pn, arow, brow, r0, nv, e, lb; };
struct Gemm { const bf16_t* A; const bf16_t* Bt; int M, N, K; };

struct StaticOrder {
    int nM, nN, nwg, G, c;
    __host__ __device__ void init(int M, int N, int G_, int c_) { nM = M / BM; nN = N / BM; nwg = nM * nN; G = G_; c = c_; }
    __host__ __device__ bool next(int i, Unit& u) const {
        const long L = (long)i * G + c; if (L >= nwg) return false;
        int wgid = (int)L; { const int q = nwg / NXCD, r = nwg % NXCD, xcd = wgid % NXCD, off = wgid / NXCD; wgid = (xcd < r ? xcd * (q + 1) : r * (q + 1) + (xcd - r) * q) + off; }
        const int nig = WGM * nN, gid = wgid / nig, fm = gid * WGM, gsz = (nM - fm) < WGM ? (nM - fm) : WGM;
        u.pm = fm + ((wgid % nig) % gsz); u.pn = (wgid % nig) / gsz; u.arow = u.pm * BM; u.brow = u.pn * BM; u.r0 = u.arow; u.nv = BM; u.e = 0; u.lb = 0; return true;
    }
    __device__ __forceinline__ int row_of(const Unit&, int) const { return 0; }
};

__device__ __forceinline__ unsigned cvt_pk_bf16(float lo, float hi) { unsigned r; asm volatile("v_cvt_pk_bf16_f32 %0, %1, %2" : "=v"(r) : "v"(lo), "v"(hi)); return r; }

template <class Epi, class Sched, bool ALIGN_EPI, bool GATHER>
__device__ __forceinline__ void gemm_phase(PG8_LAS unsigned char* lds, const Gemm g, const Sched& S, const Epi& E) {
    static_assert(Epi::PERM, "epilogues use the PERM column layout");
    const int tid = threadIdx.x, wid = __builtin_amdgcn_readfirstlane(tid >> 6), lane = tid & 63, wr = wid >> 2, wc = wid & 3, fr = lane & 15, fq = lane >> 4;
    const int K = g.K, nt = K / BK;
    unsigned voffA[2], voffB[2]; int stR[2], stC[2];
#pragma unroll
    for (int i = 0; i < 2; ++i) { int R, C; stage_rc(tid * 16 + i * 8192, R, C); const int Rb = (R & ~31) + perm32(R & 31); stR[i] = R; stC[i] = C;
        voffA[i] = (unsigned)(R * K + C) * 2u; voffB[i] = (unsigned)(Rb * K + C) * 2u; }
    const size_t kstep = (size_t)(BK * 2);
    const size_t hstep = (size_t)HALF * K * 2;
    const size_t rstep = (size_t)K * 2;
    const unsigned ldsw = (unsigned)wid * 1024u;
    const int aoff = lds_byte(wr * 64 + fr, fq * 8), boff = lds_byte(wc * 32 + fr, fq * 8);
#define PG8_SA(b, h) (((b) * 2 + (h)) * HTB)
#define PG8_SB(b, h) ((4 + (b) * 2 + (h)) * HTB)
#define PG8_STAGE(bufoff, gbase, voff) do { _Pragma("unroll") for (int _i = 0; _i < 2; ++_i) \
        __builtin_amdgcn_global_load_lds((const unsigned*)((const char*)(gbase) + (voff)[_i]), (PG8_LAS unsigned*)(lds + (bufoff) + ldsw + _i * 8192), 16, 0, 0); } while (0)
#define PG8_STAGE_A(b, h, P, V) do { if constexpr (GATHER) { PG8_STAGE(PG8_SA(b, h), P, V[h]); } else { PG8_STAGE(PG8_SA(b, h), (P) + (h) * hstep, voffA); } } while (0)
#define PG8_LDA(dst, b, h) do { _Pragma("unroll") for (int m = 0; m < 4; ++m) _Pragma("unroll") for (int k = 0; k < 2; ++k) dst[m][k] = *(const PG8_LAS bf16x8*)(lds + PG8_SA(b, h) + aoff + m * 2048 + k * 1024); } while (0)
#define PG8_LDB(dst, b, h) do { _Pragma("unroll") for (int n = 0; n < 2; ++n) _Pragma("unroll") for (int k = 0; k < 2; ++k) dst[n][k] = *(const PG8_LAS bf16x8*)(lds + PG8_SB(b, h) + boff + n * 2048 + k * 1024); } while (0)
#define PG8_MMA(ai, bj, At, Bt) do { __builtin_amdgcn_s_setprio(1); _Pragma("unroll") for (int m = 0; m < 4; ++m) _Pragma("unroll") for (int n = 0; n < 2; ++n) _Pragma("unroll") for (int k = 0; k < 2; ++k) \
        acc[ai][bj][m][n] = __builtin_amdgcn_mfma_f32_16x16x32_bf16(Bt[n][k], At[m][k], acc[ai][bj][m][n], 0, 0, 0); __builtin_amdgcn_s_setprio(0); } while (0)
#define PG8_WAIT_V(n) asm volatile("s_waitcnt vmcnt(" #n ")" ::: "memory")
#define PG8_WAIT_L(n) asm volatile("s_waitcnt lgkmcnt(" #n ")" ::: "memory")
#define PG8_BAR __builtin_amdgcn_s_barrier()
#define PG8_SCHED __builtin_amdgcn_sched_barrier(0)
#define PG8_GOFF(V, u) do { if constexpr (GATHER) { _Pragma("unroll") for (int _h = 0; _h < 2; ++_h) _Pragma("unroll") for (int _i = 0; _i < 2; ++_i) \
        V[_h][_i] = (unsigned)(S.row_of(u, _h * HALF + stR[_i]) * K + stC[_i]) * 2u; } } while (0)
    Unit cur, nxt; int ui = 0;
    if (!S.next(0, cur)) return;
    f32x4 acc[2][2][4][2];
#pragma unroll
    for (int a = 0; a < 2; ++a)
#pragma unroll
        for (int b = 0; b < 2; ++b)
#pragma unroll
            for (int m = 0; m < 4; ++m)
#pragma unroll
                for (int n = 0; n < 2; ++n) acc[a][b][m][n] = (f32x4){0.f, 0.f, 0.f, 0.f};
    bf16x8 At[4][2], B0[2][2], B1[2][2];
    unsigned vcur[2][2] = {{0u, 0u}, {0u, 0u}}, vnxt[2][2] = {{0u, 0u}, {0u, 0u}}, v2[2][2] = {{0u, 0u}, {0u, 0u}};
    PG8_GOFF(vcur, cur);
    const char* cA = GATHER ? (const char*)g.A : (const char*)g.A + (size_t)cur.arow * rstep; const char* cB = (const char*)g.Bt + (size_t)cur.brow * rstep;
    PG8_STAGE(PG8_SB(0, 0), cB, voffB); PG8_STAGE(PG8_SB(0, 1), cB + hstep, voffB); PG8_STAGE_A(0, 0, cA, vcur); PG8_STAGE_A(0, 1, cA, vcur);
    if (wr == 1) PG8_BAR;
    PG8_WAIT_V(2); PG8_BAR;
    PG8_STAGE(PG8_SB(1, 0), cB + kstep, voffB); PG8_STAGE_A(1, 0, cA + kstep, vcur); PG8_STAGE(PG8_SB(1, 1), cB + hstep + kstep, voffB);
    PG8_WAIT_V(6); PG8_BAR;
    for (;;) {
        const bool has_next = S.next(ui + 1, nxt);
        if constexpr (GATHER) { if (has_next) { PG8_GOFF(vnxt, nxt); } else {
#pragma unroll
            for (int h = 0; h < 2; ++h)
#pragma unroll
                for (int i = 0; i < 2; ++i) vnxt[h][i] = vcur[h][i]; } }
        const char* nA = GATHER ? cA : (has_next ? (const char*)g.A + (size_t)nxt.arow * rstep : cA); const char* nB = has_next ? (const char*)g.Bt + (size_t)nxt.brow * rstep : cB;
        for (int t = 0; t < nt; t += 2) {
            const bool last = (t == nt - 2);
            const char* a1 = cA + (size_t)(t + 1) * kstep;
            const char* a2 = last ? nA : cA + (size_t)(t + 2) * kstep; const char* b2 = last ? nB : cB + (size_t)(t + 2) * kstep;
            const char* a3 = a2 + kstep; const char* b3 = b2 + kstep;
            if constexpr (GATHER) {
#pragma unroll
                for (int h = 0; h < 2; ++h)
#pragma unroll
                    for (int i = 0; i < 2; ++i) v2[h][i] = last ? vnxt[h][i] : vcur[h][i]; }
            PG8_LDB(B0, 0, 0); PG8_LDB(B1, 0, 1); PG8_SCHED; PG8_LDA(At, 0, 0); PG8_STAGE_A(1, 1, a1, vcur);
            PG8_WAIT_V(8); PG8_WAIT_L(0); PG8_BAR; PG8_MMA(0, 0, At, B0); PG8_MMA(0, 1, At, B1); PG8_BAR; PG8_SCHED;
            PG8_LDA(At, 0, 1); PG8_STAGE(PG8_SB(0, 0), b2, voffB); PG8_STAGE(PG8_SB(0, 1), b2 + hstep, voffB); PG8_STAGE_A(0, 0, a2, v2);
            PG8_WAIT_V(8); PG8_WAIT_L(0); PG8_BAR; PG8_MMA(1, 0, At, B0); PG8_MMA(1, 1, At, B1); PG8_BAR; PG8_SCHED;
            PG8_LDB(B0, 1, 0); PG8_LDB(B1, 1, 1); PG8_SCHED; PG8_LDA(At, 1, 0); PG8_STAGE_A(0, 1, a2, v2);
            PG8_WAIT_V(8); PG8_WAIT_L(0); PG8_BAR; PG8_MMA(0, 0, At, B0); PG8_MMA(0, 1, At, B1); PG8_BAR; PG8_SCHED;
            PG8_LDA(At, 1, 1); PG8_STAGE(PG8_SB(1, 0), b3, voffB); PG8_STAGE(PG8_SB(1, 1), b3 + hstep, voffB); PG8_STAGE_A(1, 0, a3, v2);
            PG8_WAIT_V(8); PG8_WAIT_L(0); PG8_BAR; PG8_MMA(1, 0, At, B0); PG8_MMA(1, 1, At, B1); PG8_BAR; PG8_SCHED;
        }
        if constexpr (ALIGN_EPI) { if (wr == 0) PG8_BAR; }
        E(acc, cur, wr, wc, fr, fq);
        if (!has_next) break;
#pragma unroll
        for (int a = 0; a < 2; ++a)
#pragma unroll
            for (int b = 0; b < 2; ++b)
#pragma unroll
                for (int m = 0; m < 4; ++m)
#pragma unroll
                    for (int n = 0; n < 2; ++n) acc[a][b][m][n] = (f32x4){0.f, 0.f, 0.f, 0.f};
        cur = nxt; cA = nA; cB = nB; ++ui;
        if constexpr (GATHER) {
#pragma unroll
            for (int h = 0; h < 2; ++h)
#pragma unroll
                for (int i = 0; i < 2; ++i) vcur[h][i] = vnxt[h][i]; }
        if constexpr (ALIGN_EPI) { if (wr == 1) PG8_BAR; }
    }
    PG8_WAIT_V(0);
    if constexpr (!ALIGN_EPI) { if (wr == 0) PG8_BAR; }
    PG8_BAR;
#undef PG8_SA
#undef PG8_SB
#undef PG8_STAGE
#undef PG8_STAGE_A
#undef PG8_LDA
#undef PG8_LDB
#undef PG8_MMA
#undef PG8_WAIT_V
#undef PG8_WAIT_L
#undef PG8_BAR
#undef PG8_SCHED
#undef PG8_GOFF
}
}

constexpr int NWAVES = 8, NTHR = 512;
constexpr int T = 8192, D = 2048, NPROJ = 11264, WIN_PITCH = 11280, NH = 8, NE = 64, NEX = 65, FF = 512, TOPK = 8, NCHUNK = 128;
constexpr float ALPHA = 1.18920711500272106672f, LN_EPS = 1e-5f, NORM_EPS = 1e-6f, LAMBDA_INIT = 0.2f, ROUTED_SCALE = 2.5f;
constexpr int NPHASE = 12;

constexpr size_t MiB = 1u << 20;
constexpr size_t WS_CTL = 0, CTL_ZERO_BYTES = 1 * MiB;
constexpr size_t WS_WA = 2 * MiB, WS_WB = 6 * MiB, WS_WO = 10 * MiB, WS_WGU = 18 * MiB, WS_WD = 278 * MiB;
constexpr size_t WS_X1F = 408 * MiB, WS_X1B = 472 * MiB, WS_YA = 504 * MiB, WS_YB = 520 * MiB;
constexpr size_t WS_TOKL = 536 * MiB, WS_WGTL = 539 * MiB, WS_INFO = 542 * MiB, WS_GL = 542 * MiB + 512 * 1024, WS_GAB = 543 * MiB;
constexpr size_t WS_WIN = 544 * MiB, WS_XB = 588 * MiB, WS_P = 620 * MiB;
constexpr size_t WS_U = 796 * MiB, WS_W = 828 * MiB, WS_QD = 860 * MiB, WS_KD = 892 * MiB, WS_AQK = 924 * MiB, WS_SST = 940 * MiB, WS_END = 1004 * MiB;
constexpr size_t WS_PK = 796 * MiB, WS_UL = 860 * MiB, WS_OG = 892 * MiB;
constexpr int PK_BYTES = 65536, PK_WN = 0, PK_QD = 17408, PK_KDT = 34816, PK_AQ = 53248;
constexpr size_t WS_TMP = 796 * MiB, WS_MRG = 860 * MiB, WS_Y1 = 892 * MiB;
constexpr size_t WS_HB = 544 * MiB, WS_YAS = 620 * MiB;
constexpr size_t PBUF = (size_t)T * 1024;
constexpr int CW_BAR = 4096;
constexpr int CW_CNT = 32768;
constexpr int CW_AQ = 40960;

constexpr int RING_BYTES = 131072;
constexpr int LDS_TAB = RING_BYTES;
constexpr int MISC_OFF = RING_BYTES + 16384 - 256;
constexpr int LDS_BYTES = RING_BYTES + 16384;

#define GAS __attribute__((address_space(1)))
#define LAS __attribute__((address_space(3)))
typedef unsigned short bf16;
typedef unsigned v4u __attribute__((ext_vector_type(4)));
typedef unsigned v2u __attribute__((ext_vector_type(2)));
typedef float f32x4 __attribute__((ext_vector_type(4)));
typedef float f32x2 __attribute__((ext_vector_type(2)));
typedef short bf16x8 __attribute__((ext_vector_type(8)));
typedef GAS unsigned gu32;
#define RLX_AGENT __ATOMIC_RELAXED, __HIP_MEMORY_SCOPE_AGENT
#define LDS_WAIT() asm volatile("s_waitcnt lgkmcnt(0)" ::: "memory")
#define VM_WAIT() asm volatile("s_waitcnt vmcnt(0)" ::: "memory")
__device__ __forceinline__ unsigned f2bf(float f) { unsigned u = __builtin_bit_cast(unsigned, f); return (u + 0x7fffu + ((u >> 16) & 1u)) >> 16; }
__device__ __forceinline__ unsigned pk2(float lo, float hi) { return f2bf(lo) | (f2bf(hi) << 16); }
__device__ __forceinline__ float bflo(unsigned w) { return __builtin_bit_cast(float, w << 16); }
__device__ __forceinline__ float bfhi(unsigned w) { return __builtin_bit_cast(float, w & 0xffff0000u); }
__device__ __forceinline__ float bf2f(bf16 b) { return __builtin_bit_cast(float, (unsigned)b << 16); }
__device__ __forceinline__ float sigmoidf_(float x) { return 1.f / (1.f + __expf(-x)); }
__device__ __forceinline__ float siluf_(float x) { return x / (1.f + __expf(-x)); }

#define XB_TMO      128
#define XB_XCNT(j)  (256  + 64 * (j))
#define XB_XSUB(j)  (1280 + 64 * (j))
#define XB_XGEN(j)  (2304 + 64 * (j))
#define XB_TOP      3328
#define XB_TOPGEN   3392
#define XCD_BAR_WORDS 3456
#define XB_SPIN_CAP (1u << 22)

__device__ __forceinline__ unsigned xb_ld(unsigned* p)              { return __hip_atomic_load(p, __ATOMIC_RELAXED, __HIP_MEMORY_SCOPE_AGENT); }
__device__ __forceinline__ unsigned xb_add(unsigned* p, unsigned v) { return __hip_atomic_fetch_add(p, v, __ATOMIC_RELAXED, __HIP_MEMORY_SCOPE_AGENT); }
__device__ __forceinline__ unsigned xb_xcc_id() { return (unsigned)__builtin_amdgcn_s_getreg((3 << 11) | 20) & 0xFu; }
#define XB_SPIN(cond, bar) do { unsigned _sp = 0; while (cond) { __builtin_amdgcn_s_sleep(1); \
    if ((++_sp & 255u) == 0u) { if (xb_ld(&(bar)[XB_TMO])) break; if (_sp > XB_SPIN_CAP) { atomicAdd(&(bar)[XB_TMO], 1u); break; } } } } while (0)

struct XcdBarrier {
    unsigned* bar; unsigned x;
    volatile LAS unsigned* st;
};
__device__ __forceinline__ XcdBarrier xcd_barrier_post(unsigned* bar, volatile LAS unsigned* st) {
    XcdBarrier b; b.bar = bar; b.x = xb_xcc_id(); b.st = st;
    if (threadIdx.x == 0) (void)xb_add(&bar[XB_XCNT(b.x)], 1u);
    return b;
}
__device__ __forceinline__ void xcd_barrier_complete(unsigned* bar, unsigned x, unsigned& nloc, unsigned& nx) {
    const unsigned G = gridDim.x * gridDim.y * gridDim.z;
    unsigned sum, cnt, mine, sp = 0u;
    for (;;) {
        sum = 0u; cnt = 0u; mine = 0u;
#pragma unroll
        for (unsigned j = 0; j < 16; ++j) { const unsigned c = xb_ld(&bar[XB_XCNT(j)]); sum += c; cnt += (c > 0u) ? 1u : 0u; mine = (j == x) ? c : mine; }
        if (sum == G) break;
        __builtin_amdgcn_s_sleep(1);
        if ((++sp & 255u) == 0u) { if (xb_ld(&bar[XB_TMO])) break; if (sp > XB_SPIN_CAP) { atomicAdd(&bar[XB_TMO], 1u); break; } }
    }
    nloc = mine > 0u ? mine : 1u; nx = cnt > 0u ? cnt : 1u;
}
__device__ __forceinline__ void xcd_barrier(const XcdBarrier& b) {
    asm volatile("s_waitcnt vmcnt(0)" ::: "memory");
    __syncthreads();
    if (threadIdx.x == 0) {
        unsigned* bar = b.bar;
        __builtin_amdgcn_s_waitcnt(0);
        unsigned nloc = b.st[0], nx = b.st[1];
        if (nloc == 0u) { xcd_barrier_complete(bar, b.x, nloc, nx); b.st[0] = nloc; b.st[1] = nx; }
        const unsigned old = xb_add(&bar[XB_XSUB(b.x)], 1u);
        const unsigned gen = old / nloc;
        if (old + 1u == (gen + 1u) * nloc) {
            __builtin_amdgcn_fence(__ATOMIC_RELEASE, "agent");
            asm volatile("s_waitcnt vmcnt(0)" ::: "memory");
            const unsigned og = xb_add(&bar[XB_TOP], 1u);
            const unsigned tg = og / nx;
            if (og + 1u == (tg + 1u) * nx) xb_add(&bar[XB_TOPGEN], 1u);
            else XB_SPIN(xb_ld(&bar[XB_TOPGEN]) == tg, bar);
            __builtin_amdgcn_fence(__ATOMIC_ACQUIRE, "agent");
            xb_add(&bar[XB_XGEN(b.x)], 1u);
            asm volatile("s_waitcnt vmcnt(0)" ::: "memory");
        } else {
            XB_SPIN(xb_ld(&bar[XB_XGEN(b.x)]) == gen, bar);
            __builtin_amdgcn_fence(__ATOMIC_ACQUIRE, "agent");
            asm volatile("s_waitcnt vmcnt(0)" ::: "memory");
        }
    }
    __syncthreads();
}

struct Frame {
    LAS unsigned char* lds;
    gu32* ctl;
    int tid, lane, wave;
    int vcu, G;
    const float* in[24]; float* out; unsigned char* ws;
};
__device__ __forceinline__ float wave_sum(float v) {
#pragma unroll
    for (int o = 1; o < 64; o <<= 1) v += __shfl_xor(v, o);
    return v;
}
__device__ __forceinline__ float wave_max(float v) {
#pragma unroll
    for (int o = 1; o < 64; o <<= 1) v = fmaxf(v, __shfl_xor(v, o));
    return v;
}

__device__ __forceinline__ void p0_transpose_item(const float* W, int pitch, int sn0, bf16* WT, int dpitch, int dr0, int k0, LAS float* scr, int lane) {
#pragma unroll 8
    for (int i = 0; i < 32; ++i) { const int kk = 2 * i + (lane >> 5); scr[kk * 33 + (lane & 31)] = W[(size_t)(k0 + kk) * pitch + sn0 + (lane & 31)]; }
    LDS_WAIT(); asm volatile("" ::: "memory");
    const int c = lane & 7;
#pragma unroll
    for (int j = 0; j < 4; ++j) { const int n = (lane >> 3) + 8 * j; const LAS float* s = scr + (8 * c) * 33 + n;
        v4u o; o.x = pk2(s[0 * 33], s[1 * 33]); o.y = pk2(s[2 * 33], s[3 * 33]); o.z = pk2(s[4 * 33], s[5 * 33]); o.w = pk2(s[6 * 33], s[7 * 33]);
        *(GAS v4u*)(WT + (size_t)(dr0 + n) * dpitch + k0 + 8 * c) = o; }
    LDS_WAIT(); asm volatile("" ::: "memory");
}
__device__ __forceinline__ void p0_prologue(Frame& F) {
    unsigned char* ws = F.ws;
    {
        LAS float* w16 = (LAS float*)F.lds;
        for (int idx = F.tid; idx < 2048 * 4; idx += NTHR) { const int k = idx >> 2, q = idx & 3;
            const f32x4 v = *(const GAS f32x4*)(F.in[1] + (size_t)k * WIN_PITCH + 7168 + 4 * q); *(LAS f32x4*)(w16 + k * 16 + 4 * q) = v; }
        __syncthreads();
        float* gab = (float*)(ws + WS_GAB);
        for (int tok = F.vcu * NWAVES + F.wave; tok < T; tok += F.G * NWAVES) {
            float acc[16];
#pragma unroll
            for (int e = 0; e < 16; ++e) acc[e] = 0.f;
            const float* xr = F.in[0] + (size_t)tok * D;
#pragma unroll 2
            for (int j = 0; j < 32; ++j) { const int k = j * 64 + F.lane; const float xv = xr[k];
#pragma unroll
                for (int q = 0; q < 4; ++q) { const f32x4 w = *(const LAS f32x4*)(w16 + k * 16 + 4 * q);
                    acc[4 * q + 0] += xv * w.x; acc[4 * q + 1] += xv * w.y; acc[4 * q + 2] += xv * w.z; acc[4 * q + 3] += xv * w.w; } }
#pragma unroll
            for (int e = 0; e < 16; ++e) acc[e] = wave_sum(acc[e]);
            if (F.lane == 0) {
#pragma unroll
                for (int q = 0; q < 4; ++q) *(GAS f32x4*)(gab + (size_t)tok * 16 + 4 * q) = (f32x4){acc[4 * q], acc[4 * q + 1], acc[4 * q + 2], acc[4 * q + 3]}; }
        }
        __syncthreads();
    }
    LAS float* scr = (LAS float*)(F.lds + F.wave * 16384);
    const int gw = F.vcu * NWAVES + F.wave, NGW = F.G * NWAVES;
    constexpr int I_IN = 32 * 352, I_A = 16 * 64, I_O = 32 * 64, I_GU = NEX * 2 * 512, I_D = NEX * 512;
    constexpr int NITEMS = I_IN + 2 * I_A + I_O + I_GU + I_D;
    for (int it = gw; it < NITEMS; it += NGW) {
        int r = it;
        if (r < I_IN) { const int kb = r / 352, nb = r % 352, n0 = 32 * nb; p0_transpose_item(F.in[1], WIN_PITCH, n0 + (n0 >= 7168 ? 16 : 0), (bf16*)(ws + WS_WIN), D, n0, 64 * kb, scr, F.lane); continue; } r -= I_IN;
        if (r < I_A) { const int kb = r / 64, nb = r % 64; p0_transpose_item(F.in[9], D, 32 * nb, (bf16*)(ws + WS_WA), 1024, 32 * nb, 64 * kb, scr, F.lane); continue; } r -= I_A;
        if (r < I_A) { const int kb = r / 64, nb = r % 64; p0_transpose_item(F.in[10], D, 32 * nb, (bf16*)(ws + WS_WB), 1024, 32 * nb, 64 * kb, scr, F.lane); continue; } r -= I_A;
        if (r < I_O) { const int kb = r / 64, nb = r % 64; p0_transpose_item(F.in[11], D, 32 * nb, (bf16*)(ws + WS_WO), D, 32 * nb, 64 * kb, scr, F.lane); continue; } r -= I_O;
        if (r < I_GU) { const int e = r / 1024, which = (r >> 9) & 1, q = r & 511, kb = q / 16, nb = q % 16;
            const float* src = e < NE ? (which ? F.in[17] : F.in[16]) + (size_t)e * D * FF : (which ? F.in[20] : F.in[19]);
            p0_transpose_item(src, FF, 32 * nb, (bf16*)(ws + WS_WGU) + (size_t)e * 1024 * D, D, 256 * (nb >> 2) + 32 * (nb & 3) + 128 * which, 64 * kb, scr, F.lane); continue; } r -= I_GU;
        { const int e = r / 512, q = r & 511, kb = q / 64, nb = q % 64;
            const float* src = e < NE ? F.in[18] + (size_t)e * FF * D : F.in[21];
            p0_transpose_item(src, D, 32 * nb, (bf16*)(ws + WS_WD) + (size_t)e * D * FF, FF, 32 * nb, 64 * kb, scr, F.lane); }
    }
    { const GAS f32x4* x4 = (const GAS f32x4*)F.in[0]; GAS v4u* o = (GAS v4u*)(ws + WS_XB);
      for (size_t i = (size_t)F.vcu * NTHR + F.tid; i < (size_t)T * D / 8; i += (size_t)F.G * NTHR) { const f32x4 a = x4[2 * i], b = x4[2 * i + 1];
          v4u w; w.x = pk2(a.x, a.y); w.y = pk2(a.z, a.w); w.z = pk2(b.x, b.y); w.w = pk2(b.z, b.w); o[i] = w; } }
}

using pg8::Unit;
struct EpiProj {
    static constexpr bool PERM = true;
    bf16* P;
    __device__ __forceinline__ void operator()(const f32x4 (&acc)[2][2][4][2], const Unit& u, int wr, int wc, int fr, int fq) const {
        const int buf = u.pn >> 2, colt = (u.pn & 3) * 256; bf16* base = P + (size_t)buf * PBUF;
        const int row0 = u.r0 + wr * 64 + fr, col0 = colt + wc * 32 + 8 * fq; const bool sg = buf >= 7;
        if (buf == 2) {
            const int frp = (fr & ~12) | ((fr & 4) << 1) | ((fr & 8) >> 1);
#pragma unroll
            for (int ai = 0; ai < 2; ++ai)
#pragma unroll
                for (int m = 0; m < 4; ++m) { const int tokp = u.r0 + wr * 64 + ai * 128 + m * 16 + frp;
#pragma unroll
                    for (int bj = 0; bj < 2; ++bj)
#pragma unroll
                        for (int n = 0; n < 2; ++n)
#pragma unroll
                            for (int x = 0; x < 4; ++x) base[(size_t)(col0 + bj * 128 + 4 * n + x) * T + tokp] = (bf16)f2bf(acc[ai][bj][m][n][x]); }
            return; }
#pragma unroll
        for (int ai = 0; ai < 2; ++ai)
#pragma unroll
            for (int m = 0; m < 4; ++m) { bf16* rowp = base + (size_t)(row0 + ai * 128 + m * 16) * 1024 + col0;
#pragma unroll
                for (int bj = 0; bj < 2; ++bj) { f32x4 v0 = acc[ai][bj][m][0], v1 = acc[ai][bj][m][1];
                    if (sg) { v0 = (f32x4){sigmoidf_(v0.x), sigmoidf_(v0.y), sigmoidf_(v0.z), sigmoidf_(v0.w)}; v1 = (f32x4){sigmoidf_(v1.x), sigmoidf_(v1.y), sigmoidf_(v1.z), sigmoidf_(v1.w)}; }
                    v4u w; w.x = pk2(v0.x, v0.y); w.y = pk2(v0.z, v0.w); w.z = pk2(v1.x, v1.y); w.w = pk2(v1.z, v1.w);
                    *(GAS v4u*)(rowp + bj * 128) = w; } }
    }
};
template <int STEP> struct EpiBranch {
    static constexpr bool PERM = true;
    const bf16* SG; float* tmp; bf16* mrg;
    __device__ __forceinline__ void operator()(const f32x4 (&acc)[2][2][4][2], const Unit& u, int wr, int wc, int fr, int fq) const {
        const int row0 = u.r0 + wr * 64 + fr, colu = u.pn * 256 + wc * 32 + 8 * fq;
#pragma unroll
        for (int ai = 0; ai < 2; ++ai)
#pragma unroll
            for (int m = 0; m < 4; ++m) { const int row = row0 + ai * 128 + m * 16;
#pragma unroll
                for (int bj = 0; bj < 2; ++bj) { const int col = colu + bj * 128;
                    const v4u g = *(const GAS v4u*)(SG + (size_t)(col >> 10) * PBUF + (size_t)row * 1024 + (col & 1023));
                    f32x4 v0 = acc[ai][bj][m][0], v1 = acc[ai][bj][m][1];
                    v0 = v0 * (f32x4){bflo(g.x), bfhi(g.x), bflo(g.y), bfhi(g.y)}; v1 = v1 * (f32x4){bflo(g.z), bfhi(g.z), bflo(g.w), bfhi(g.w)};
                    float* tp = tmp + (size_t)row * D + col;
                    if (STEP == 0) { *(GAS f32x4*)tp = v0; *(GAS f32x4*)(tp + 4) = v1; }
                    else { v0 = v0 + *(const GAS f32x4*)tp; v1 = v1 + *(const GAS f32x4*)(tp + 4);
                        v4u w; w.x = pk2(v0.x, v0.y); w.y = pk2(v0.z, v0.w); w.z = pk2(v1.x, v1.y); w.w = pk2(v1.z, v1.w);
                        *(GAS v4u*)(mrg + (size_t)row * D + col) = w; } } }
    }
};
struct EpiOut {
    static constexpr bool PERM = true;
    const float* x; float* y1;
    __device__ __forceinline__ void operator()(const f32x4 (&acc)[2][2][4][2], const Unit& u, int wr, int wc, int fr, int fq) const {
        const int row0 = u.r0 + wr * 64 + fr, colu = u.pn * 256 + wc * 32 + 8 * fq;
#pragma unroll
        for (int ai = 0; ai < 2; ++ai)
#pragma unroll
            for (int m = 0; m < 4; ++m) { const size_t ro = (size_t)(row0 + ai * 128 + m * 16) * D;
#pragma unroll
                for (int bj = 0; bj < 2; ++bj) { const size_t o = ro + colu + bj * 128;
                    const f32x4 x0 = *(const GAS f32x4*)(x + o), x1 = *(const GAS f32x4*)(x + o + 4);
                    *(GAS f32x4*)(y1 + o) = x0 * ALPHA + acc[ai][bj][m][0]; *(GAS f32x4*)(y1 + o + 4) = x1 * ALPHA + acc[ai][bj][m][1]; } }
    }
};
struct EpiGU {
    static constexpr bool PERM = true;
    bf16* HB;
    __device__ __forceinline__ void operator()(const f32x4 (&acc)[2][2][4][2], const Unit& u, int wr, int wc, int fr, int fq) const {
        const int col = u.pn * 128 + wc * 32 + 8 * fq;
#pragma unroll
        for (int ai = 0; ai < 2; ++ai)
#pragma unroll
            for (int m = 0; m < 4; ++m) { const int r = ai * 128 + wr * 64 + m * 16 + fr;
                if (r < u.nv) { const f32x4 g0 = acc[ai][0][m][0], g1 = acc[ai][0][m][1], u0 = acc[ai][1][m][0], u1 = acc[ai][1][m][1];
                    v4u w; w.x = pk2(siluf_(g0.x) * u0.x, siluf_(g0.y) * u0.y); w.y = pk2(siluf_(g0.z) * u0.z, siluf_(g0.w) * u0.w);
                    w.z = pk2(siluf_(g1.x) * u1.x, siluf_(g1.y) * u1.y); w.w = pk2(siluf_(g1.z) * u1.z, siluf_(g1.w) * u1.w);
                    *(GAS v4u*)(HB + (size_t)(u.r0 + r) * FF + col) = w; } }
    }
};
struct EpiDown {
    static constexpr bool PERM = true;
    bf16* YAS; const float* wgtl;
    __device__ __forceinline__ void operator()(const f32x4 (&acc)[2][2][4][2], const Unit& u, int wr, int wc, int fr, int fq) const {
        const int colu = u.pn * 256 + wc * 32 + 8 * fq;
#pragma unroll
        for (int ai = 0; ai < 2; ++ai)
#pragma unroll
            for (int m = 0; m < 4; ++m) { const int r = ai * 128 + wr * 64 + m * 16 + fr;
                if (r < u.nv) { const float wg = wgtl[u.lb + r];
#pragma unroll
                    for (int bj = 0; bj < 2; ++bj) { const f32x4 v0 = acc[ai][bj][m][0] * wg, v1 = acc[ai][bj][m][1] * wg;
                        v4u w; w.x = pk2(v0.x, v0.y); w.y = pk2(v0.z, v0.w); w.z = pk2(v1.x, v1.y); w.w = pk2(v1.z, v1.w);
                        *(GAS v4u*)(YAS + (size_t)(u.r0 + r) * D + colu + bj * 128) = w; } } }
    }
};
struct MoeOrder {
    const LAS int* tpref; const LAS int* rbase; const LAS int* cnts; const int* tokl; int NT, G, c, brows;
    __device__ __forceinline__ bool next(int i, Unit& u) const {
        const int L = i * G + c; if (L >= tpref[NEX] * NT) return false;
        const int tg = L / NT, nt = L % NT; int e = 0;
        while (tpref[e + 1] <= tg) ++e;
        const int mt = tg - tpref[e];
        u.e = e; u.pm = mt; u.pn = nt; u.lb = e * T + mt * 256; u.nv = min(256, cnts[e] - mt * 256); u.r0 = rbase[e] + mt * 256; u.arow = u.r0; u.brow = e * brows + nt * 256; return true;
    }
    __device__ __forceinline__ int row_of(const Unit& u, int r) const { return r < u.nv ? tokl[u.lb + r] : 0; }
};
__device__ __forceinline__ void moe_tables(Frame& F) {
    LAS int* tpref = (LAS int*)(F.lds + LDS_TAB); LAS int* rbase = tpref + 72; LAS int* cnts = rbase + 72;
    __syncthreads();
    if (F.wave == 0) {
        const int c = (int)__hip_atomic_load(F.ctl + CW_CNT + 64 * F.lane, RLX_AGENT);
        int tl = (c + 255) >> 8, tp = tl, rb = c;
#pragma unroll
        for (int o = 1; o < 64; o <<= 1) { const int a = __shfl_up(tp, o), b = __shfl_up(rb, o); if (F.lane >= o) { tp += a; rb += b; } }
        tpref[F.lane] = tp - tl; rbase[F.lane] = rb - c; cnts[F.lane] = c;
        if (F.lane == 63) { tpref[64] = tp; rbase[64] = rb; cnts[64] = T; tpref[65] = tp + T / 256; rbase[65] = rb + T; }
    }
    __syncthreads();
}

__device__ __forceinline__ int t5_bucket(int rel) {
    const int n = rel < 0 ? -rel : rel; int b;
    if (n < 8) b = n; else if (n < 12) b = 8; else if (n < 16) b = 9; else if (n < 23) b = 10; else if (n < 32) b = 11; else if (n < 46) b = 12; else if (n < 64) b = 13; else if (n < 91) b = 14; else b = 15;
    return b + (rel > 0 ? 16 : 0);
}
typedef float f32x16 __attribute__((ext_vector_type(16)));
__device__ __forceinline__ bf16x8 cvt8(const f32x16& x, int s) {
    v4u w;
    if (s == 0) { w.x = pk2(x[0], x[1]); w.y = pk2(x[2], x[3]); w.z = pk2(x[4], x[5]); w.w = pk2(x[6], x[7]); }
    else { w.x = pk2(x[8], x[9]); w.y = pk2(x[10], x[11]); w.z = pk2(x[12], x[13]); w.w = pk2(x[14], x[15]); }
    return __builtin_bit_cast(bf16x8, w);
}
constexpr int AT_KP = 272, AT_VP = 144, AT_KB = 64 * AT_KP, AT_VB = 128 * AT_VP, AT_BUF = AT_KB + AT_VB;
constexpr float AT_C1 = 0.125f * 1.4426950408889634f, LOG2E = 1.4426950408889634f;
__device__ __forceinline__ void attn_v2(Frame& F) {
    LAS unsigned char* lds = F.lds;
    LAS float* relb = (LAS float*)(F.lds + 2 * AT_BUF);
    LAS int* qslot = (LAS int*)(relb + 256);
    const bf16* Pq = (const bf16*)(F.ws + WS_P); const bf16* Pk = Pq + PBUF; const bf16* VT = Pq + 2 * PBUF;
    bf16* ya = (bf16*)(F.ws + WS_YA);
    float lam;
    { const float* dl = F.in[6]; float s01 = 0.f, s23 = 0.f;
      for (int d = 0; d < 64; ++d) { s01 += dl[d] * dl[64 + d]; s23 += dl[128 + d] * dl[192 + d]; }
      lam = expf(s01) - expf(s23) + LAMBDA_INIT; }
    for (;;) {
        int tid = F.tid; asm volatile("" : "+v"(tid));
        __syncthreads();
        if (tid == 0) qslot[0] = (int)__hip_atomic_fetch_add(F.ctl + CW_AQ, 1u, RLX_AGENT);
        __syncthreads();
        const int L = qslot[0];
        if (L >= NH * 64) break;
        const int h = L & 7, qb = 63 - (L >> 3), lane = tid & 63, i31 = lane & 31, hh = lane >> 5, sb = F.wave & 3, map = F.wave >> 2;
        const int cw = 2 * qb + (sb >> 1), ntile = 2 * qb + 2;
        if (tid < 256) relb[tid] = F.in[8][t5_bucket(tid - 191) * 8 + h] * LOG2E;
        const int qrow = qb * 128 + 32 * sb + i31;
        bf16x8 qf[4];
#pragma unroll
        for (int ks = 0; ks < 4; ++ks) qf[ks] = *(const GAS bf16x8*)(Pq + (size_t)qrow * 1024 + h * 128 + map * 64 + 16 * ks + 8 * hh);
        const int kr0 = tid >> 4, kc0 = tid & 15, vr0 = tid >> 3, vc0 = tid & 7;
        const bf16* kg = Pk + (size_t)kr0 * 1024 + h * 128 + kc0 * 8;
        const bf16* vg = VT + (size_t)(h * 128 + vr0) * T + vc0 * 8;
        const int klo = kr0 * AT_KP + kc0 * 16, vlo = AT_KB + vr0 * AT_VP + vc0 * 16;
        v4u st[4];
        st[0] = *(const GAS v4u*)kg; st[1] = *(const GAS v4u*)(kg + 32 * 1024); st[2] = *(const GAS v4u*)vg; st[3] = *(const GAS v4u*)(vg + (size_t)64 * T);
        *(LAS v4u*)(lds + klo) = st[0]; *(LAS v4u*)(lds + klo + 32 * AT_KP) = st[1]; *(LAS v4u*)(lds + vlo) = st[2]; *(LAS v4u*)(lds + vlo + 64 * AT_VP) = st[3];
        f32x16 O[4];
#pragma unroll
        for (int db = 0; db < 4; ++db)
#pragma unroll
            for (int r = 0; r < 16; ++r) O[db][r] = 0.f;
        float mrun = -INFINITY, lrun = 0.f;
        __syncthreads();
#pragma unroll 1
        for (int j = 0; j < ntile; ++j) {
            const LAS unsigned char* buf = lds + (j & 1) * AT_BUF;
            if (j + 1 < ntile) { const size_t ko = (size_t)(j + 1) * 64 * 1024; const int vo = (j + 1) * 64;
                st[0] = *(const GAS v4u*)(kg + ko); st[1] = *(const GAS v4u*)(kg + ko + 32 * 1024); st[2] = *(const GAS v4u*)(vg + vo); st[3] = *(const GAS v4u*)(vg + (size_t)64 * T + vo); }
            if (j <= cw) {
                f32x16 S[2];
#pragma unroll
                for (int kb = 0; kb < 2; ++kb) {
#pragma unroll
                    for (int r = 0; r < 16; ++r) S[kb][r] = 0.f;
#pragma unroll
                    for (int ks = 0; ks < 4; ++ks) { const bf16x8 kf = *(const LAS bf16x8*)(buf + (32 * kb + i31) * AT_KP + map * 128 + (16 * ks + 8 * hh) * 2);
                        S[kb] = __builtin_amdgcn_mfma_f32_32x32x16_bf16(kf, qf[ks], S[kb], 0, 0, 0); } }
                float tmax = -INFINITY;
                if (j >= cw - 2) { const int rb = (j * 64) - (qb * 128 + 32 * sb + i31) + 191 + 4 * hh;
#pragma unroll
                    for (int kb = 0; kb < 2; ++kb)
#pragma unroll
                        for (int r = 0; r < 16; ++r) { S[kb][r] = S[kb][r] * AT_C1 + relb[rb + 32 * kb + (r & 3) + 8 * (r >> 2)]; tmax = fmaxf(tmax, S[kb][r]); }
                } else { const float bfar = relb[0];
#pragma unroll
                    for (int kb = 0; kb < 2; ++kb)
#pragma unroll
                        for (int r = 0; r < 16; ++r) { S[kb][r] = S[kb][r] * AT_C1 + bfar; tmax = fmaxf(tmax, S[kb][r]); } }
                tmax = fmaxf(tmax, __shfl_xor(tmax, 32));
                if (__any(tmax > mrun + 8.f)) { const float mn = fmaxf(mrun, tmax), corr = exp2f(mrun - mn); mrun = mn; lrun *= corr;
#pragma unroll
                    for (int db = 0; db < 4; ++db) O[db] = O[db] * corr; }
                float ps = 0.f;
#pragma unroll
                for (int kb = 0; kb < 2; ++kb)
#pragma unroll
                    for (int r = 0; r < 16; ++r) { S[kb][r] = exp2f(S[kb][r] - mrun); ps += S[kb][r]; }
                lrun += ps;
                bf16x8 pf[4];
#pragma unroll
                for (int kb = 0; kb < 2; ++kb) { pf[2 * kb] = cvt8(S[kb], 0); pf[2 * kb + 1] = cvt8(S[kb], 1); }
#pragma unroll
                for (int db = 0; db < 4; ++db)
#pragma unroll
                    for (int ks = 0; ks < 4; ++ks) { const bf16x8 vf = *(const LAS bf16x8*)(buf + AT_KB + (32 * db + i31) * AT_VP + (16 * ks + 8 * hh) * 2);
                        O[db] = __builtin_amdgcn_mfma_f32_32x32x16_bf16(vf, pf[ks], O[db], 0, 0, 0); }
            }
            if (j + 1 < ntile) { LAS unsigned char* nb = lds + ((j + 1) & 1) * AT_BUF;
                *(LAS v4u*)(nb + klo) = st[0]; *(LAS v4u*)(nb + klo + 32 * AT_KP) = st[1]; *(LAS v4u*)(nb + vlo) = st[2]; *(LAS v4u*)(nb + vlo + 64 * AT_VP) = st[3]; }
            __syncthreads();
        }
        lrun += __shfl_xor(lrun, 32);
        const float inv = 1.f / lrun;
        LAS float* X = (LAS float*)lds + sb * 4096;
        if (map == 1) {
#pragma unroll
            for (int db = 0; db < 4; ++db)
#pragma unroll
                for (int r = 0; r < 16; ++r) X[(db * 16 + r) * 64 + lane] = O[db][r] * inv; }
        __syncthreads();
        if (map == 0) { float ss = 0.f;
#pragma unroll
            for (int db = 0; db < 4; ++db)
#pragma unroll
                for (int r = 0; r < 16; ++r) { const float a = O[db][r] * inv - lam * X[(db * 16 + r) * 64 + lane]; O[db][r] = a; ss += a * a; }
            ss += __shfl_xor(ss, 32);
            const float rn = rsqrtf(ss * (1.f / 128.f) + NORM_EPS) * (1.f - LAMBDA_INIT);
            bf16* op = ya + (size_t)qrow * 1024 + h * 128 + 4 * hh;
#pragma unroll
            for (int db = 0; db < 4; ++db)
#pragma unroll
                for (int q4 = 0; q4 < 4; ++q4) { const int dv = 32 * db + 8 * q4 + 4 * hh; const f32x4 sw = *(const GAS f32x4*)(F.in[7] + dv);
                    *(GAS v2u*)(op + 32 * db + 8 * q4) = (v2u){pk2(O[db][4 * q4] * rn * sw.x, O[db][4 * q4 + 1] * rn * sw.y), pk2(O[db][4 * q4 + 2] * rn * sw.z, O[db][4 * q4 + 3] * rn * sw.w)}; } }
    }
}

__device__ __forceinline__ int swap23(int x) { return (x & ~12) | ((x & 4) << 1) | ((x & 8) >> 1); }
__device__ __forceinline__ void gdn_prep_v1(Frame& F) {
    LAS float* Ks = (LAS float*)F.lds;
    LAS float* Qs = Ks + 64 * 129;
    LAS float* Vs = Qs + 64 * 129;
    LAS float* As = Vs + 64 * 128;
    LAS float* Tm = As + 64 * 68;
    LAS float* gcs = Tm + 64 * 68;
    LAS float* bts = gcs + 64;
    LAS float* egs = bts + 64;
    const bf16* P3 = (const bf16*)(F.ws + WS_P) + 3 * PBUF;
    const float* gab = (const float*)(F.ws + WS_GAB);
    float* GLg = (float*)(F.ws + WS_GL);
    const int tid = F.tid, lane = F.lane;
    for (int L = blockIdx.x; L < NH * NCHUNK; L += F.G) {
        const int n = L >> 3, h = L & 7, t0 = n * 64;
        __syncthreads();
        for (int idx = tid; idx < 64 * 384; idx += NTHR) { const int t = idx / 384, ch = idx % 384, which = ch >> 7, i = ch & 127, cg = which * 1024 + h * 128 + i;
            const bf16* src = P3 + (size_t)which * PBUF + h * 128 + i; float a = 0.f;
#pragma unroll
            for (int j = 0; j < 4; ++j) { const int tt = t0 + t - 3 + j; if (tt >= 0) a += bf2f(src[(size_t)tt * 1024]) * F.in[2][j * 3072 + cg]; }
            a = siluf_(a);
            if (which == 0) Qs[t * 129 + i] = a; else if (which == 1) Ks[t * 129 + i] = a; else Vs[t * 128 + i] = a; }
        __syncthreads();
        for (int t = F.wave * 8; t < F.wave * 8 + 8; ++t) {
            const float q0 = Qs[t * 129 + lane], q1 = Qs[t * 129 + 64 + lane], k0 = Ks[t * 129 + lane], k1 = Ks[t * 129 + 64 + lane];
            const float rq = rsqrtf(wave_sum(q0 * q0 + q1 * q1) + NORM_EPS) * 0.08838834764831845f, rk = rsqrtf(wave_sum(k0 * k0 + k1 * k1) + NORM_EPS);
            Qs[t * 129 + lane] = q0 * rq; Qs[t * 129 + 64 + lane] = q1 * rq; Ks[t * 129 + lane] = k0 * rk; Ks[t * 129 + 64 + lane] = k1 * rk; }
        if (F.wave == 0) { const int tok = t0 + lane; const float ga = gab[(size_t)tok * 16 + h] + F.in[4][h], gb = gab[(size_t)tok * 16 + 8 + h];
            const float sp = fmaxf(ga, 0.f) + log1pf(expf(-fabsf(ga))); float g = -expf(F.in[3][h]) * sp;
#pragma unroll
            for (int o = 1; o < 64; o <<= 1) { const float v = __shfl_up(g, o); if (lane >= o) g += v; }
            gcs[lane] = g; bts[lane] = 1.f / (1.f + expf(-gb)); egs[lane] = expf(g); }
        __syncthreads();
        for (int idx = tid; idx < 4096; idx += NTHR) { const int c = idx >> 6, s = idx & 63; float kk = 0.f, qk = 0.f;
            if (s <= c) { for (int i = 0; i < 128; ++i) { const float ks = Ks[s * 129 + i]; kk += Ks[c * 129 + i] * ks; qk += Qs[c * 129 + i] * ks; }
                const float dec = expf(gcs[c] - gcs[s]); kk *= dec * bts[c]; qk *= dec; }
            As[c * 68 + s] = (s < c) ? kk : 0.f; ((bf16*)(F.ws + WS_PK + (size_t)(h * NCHUNK + n) * PK_BYTES + PK_AQ))[c * 72 + swap23(s)] = (bf16)f2bf((s <= c) ? qk : 0.f); }
        __syncthreads();
        if (F.wave == 0) {
            for (int i = 0; i < 64; ++i) { float a = (i == lane) ? 1.f : 0.f;
#pragma unroll 4
                for (int j = 0; j < i; ++j) a -= As[i * 68 + j] * Tm[j * 68 + lane];
                Tm[i * 68 + lane] = a; }
        }
        __syncthreads();
        unsigned char* pk = F.ws + WS_PK + (size_t)(h * NCHUNK + n) * PK_BYTES; float* ul = (float*)(F.ws + WS_UL) + (size_t)(h * NCHUNK + n) * 4 * 64 * 32;
        for (int idx = tid; idx < 64 * 256; idx += NTHR) { const int c = idx >> 8, col = idx & 255; float a = 0.f;
            if (col < 128) { for (int s = 0; s <= c; ++s) a += Tm[c * 68 + s] * bts[s] * Vs[s * 128 + col];
                const int cp = c & 31; ul[(((col >> 5) * 64) + (col & 31) + 32 * ((cp >> 2) & 1)) * 32 + (c >> 5) * 16 + (cp & 3) + 4 * (cp >> 3)] = a; }
            else { const int i = col - 128; for (int s = 0; s <= c; ++s) a += Tm[c * 68 + s] * bts[s] * egs[s] * Ks[s * 129 + i];
                ((bf16*)(pk + PK_WN))[c * 136 + swap23(i)] = (bf16)f2bf(-a); } }
        const float glast = gcs[63];
        for (int idx = tid; idx < 64 * 128; idx += NTHR) { const int t = idx >> 7, i = idx & 127;
            ((bf16*)(pk + PK_QD))[t * 136 + swap23(i)] = (bf16)f2bf(Qs[t * 129 + i] * egs[t]);
            ((bf16*)(pk + PK_KDT))[i * 72 + swap23(t)] = (bf16)f2bf(Ks[t * 129 + i] * expf(glast - gcs[t])); }
        if (tid == 0) GLg[L] = expf(glast);
    }
}
__device__ __forceinline__ void gdn_prep_v2(Frame& F) {
    typedef float f32x16_ __attribute__((ext_vector_type(16)));
    LAS bf16* Kb = (LAS bf16*)F.lds;
    LAS bf16* Qb = Kb + 64 * 136;
    LAS bf16* Vt = Qb + 64 * 136;
    LAS bf16* KBt = Vt + 128 * 72;
    LAS float* As = (LAS float*)(KBt + 128 * 72);
    LAS float* Tm = As + 64 * 68;
    LAS float* Tp = Tm + 64 * 68;
    LAS bf16* Tmb = (LAS bf16*)(Tp + 32 * 36);
    LAS float* gcs = (LAS float*)(Tmb + 64 * 72);
    LAS float* bts = gcs + 64;
    LAS float* egs = bts + 64;
    LAS float* eks = egs + 64;
    const bf16* P3 = (const bf16*)(F.ws + WS_P) + 3 * PBUF;
    const float* gab = (const float*)(F.ws + WS_GAB);
    float* GLg = (float*)(F.ws + WS_GL);
    for (int L = blockIdx.x; L < NH * NCHUNK; L += F.G) {
        int tid = F.tid; asm volatile("" : "+v"(tid));
        const int lane = tid & 63, i31 = lane & 31, hh = lane >> 5;
        const int n = L >> 3, h = L & 7, t0 = n * 64;
        unsigned char* pk = F.ws + WS_PK + (size_t)(h * NCHUNK + n) * PK_BYTES; float* ul = (float*)(F.ws + WS_UL) + (size_t)(h * NCHUNK + n) * 4 * 64 * 32;
        __syncthreads();
        if (F.wave == 0) { const int tok = t0 + lane; const float ga = gab[(size_t)tok * 16 + h] + F.in[4][h], gb = gab[(size_t)tok * 16 + 8 + h];
            const float sp = fmaxf(ga, 0.f) + log1pf(expf(-fabsf(ga))); float g = -expf(F.in[3][h]) * sp;
#pragma unroll
            for (int o = 1; o < 64; o <<= 1) { const float v = __shfl_up(g, o); if (lane >= o) g += v; }
            const float glast = __shfl(g, 63);
            gcs[lane] = g; bts[lane] = 1.f / (1.f + expf(-gb)); egs[lane] = expf(g); eks[lane] = expf(glast - g);
            if (lane == 0) GLg[L] = expf(glast); }
        for (int idx = tid; idx < 64 * 68; idx += NTHR) Tm[idx] = 0.f;
        const int seg = tid & 63, trow = tid >> 6, which = seg >> 4, sc = (seg & 15) * 8;
        float ov[8][8];
        if (seg < 48) {
            const int cg = which * 1024 + h * 128 + sc; float cw[4][8];
#pragma unroll
            for (int j = 0; j < 4; ++j) { const f32x4 a = *(const GAS f32x4*)(F.in[2] + j * 3072 + cg), b = *(const GAS f32x4*)(F.in[2] + j * 3072 + cg + 4);
                cw[j][0] = a.x; cw[j][1] = a.y; cw[j][2] = a.z; cw[j][3] = a.w; cw[j][4] = b.x; cw[j][5] = b.y; cw[j][6] = b.z; cw[j][7] = b.w; }
            const bf16* src = P3 + (size_t)which * PBUF + h * 128 + sc; v4u xw[11];
#pragma unroll
            for (int m = 0; m < 11; ++m) { const int tt = t0 + 8 * trow - 3 + m; xw[m] = (v4u){0u, 0u, 0u, 0u}; if (tt >= 0) xw[m] = *(const GAS v4u*)(src + (size_t)tt * 1024); }
#pragma unroll
            for (int ti = 0; ti < 8; ++ti) {
#pragma unroll
                for (int c2 = 0; c2 < 4; ++c2) { float a0 = 0.f, a1 = 0.f;
#pragma unroll
                    for (int j = 0; j < 4; ++j) { const unsigned w = xw[ti + j][c2]; a0 += bflo(w) * cw[j][2 * c2]; a1 += bfhi(w) * cw[j][2 * c2 + 1]; }
                    ov[ti][2 * c2] = siluf_(a0); ov[ti][2 * c2 + 1] = siluf_(a1); } }
        } else {
#pragma unroll
            for (int ti = 0; ti < 8; ++ti)
#pragma unroll
                for (int ch = 0; ch < 8; ++ch) ov[ti][ch] = 0.f; }
#pragma unroll
        for (int ti = 0; ti < 8; ++ti) { float ss = 0.f;
#pragma unroll
            for (int ch = 0; ch < 8; ++ch) ss += ov[ti][ch] * ov[ti][ch];
            ss += __shfl_xor(ss, 1); ss += __shfl_xor(ss, 2); ss += __shfl_xor(ss, 4); ss += __shfl_xor(ss, 8);
            const float rn = which == 0 ? rsqrtf(ss + NORM_EPS) * 0.08838834764831845f : (which == 1 ? rsqrtf(ss + NORM_EPS) : 1.f);
#pragma unroll
            for (int ch = 0; ch < 8; ++ch) ov[ti][ch] *= rn; }
        __syncthreads();
        if (seg < 48) {
            const int a = (sc >> 3) & 1, g16 = sc & ~15;
            if (which == 0) {
#pragma unroll
                for (int ti = 0; ti < 8; ++ti) { const int t = 8 * trow + ti; const float e = egs[t];
                    *(LAS v4u*)(Qb + t * 136 + sc) = (v4u){pk2(ov[ti][0], ov[ti][1]), pk2(ov[ti][2], ov[ti][3]), pk2(ov[ti][4], ov[ti][5]), pk2(ov[ti][6], ov[ti][7])};
                    bf16* qd = (bf16*)(pk + PK_QD) + t * 136 + g16 + 4 * a;
                    *(GAS v2u*)qd = (v2u){pk2(ov[ti][0] * e, ov[ti][1] * e), pk2(ov[ti][2] * e, ov[ti][3] * e)};
                    *(GAS v2u*)(qd + 8) = (v2u){pk2(ov[ti][4] * e, ov[ti][5] * e), pk2(ov[ti][6] * e, ov[ti][7] * e)}; }
            } else if (which == 1) {
                float be[8], ek[8];
#pragma unroll
                for (int ti = 0; ti < 8; ++ti) { const int t = 8 * trow + ti; be[ti] = bts[t] * egs[t]; ek[ti] = eks[t];
                    *(LAS v4u*)(Kb + t * 136 + sc) = (v4u){pk2(ov[ti][0], ov[ti][1]), pk2(ov[ti][2], ov[ti][3]), pk2(ov[ti][4], ov[ti][5]), pk2(ov[ti][6], ov[ti][7])}; }
                const int ta = trow & 1, tg16 = (8 * trow) & ~15;
#pragma unroll
                for (int ch = 0; ch < 8; ++ch) {
                    *(LAS v4u*)(KBt + (sc + ch) * 72 + 8 * trow) = (v4u){pk2(ov[0][ch] * be[0], ov[1][ch] * be[1]), pk2(ov[2][ch] * be[2], ov[3][ch] * be[3]), pk2(ov[4][ch] * be[4], ov[5][ch] * be[5]), pk2(ov[6][ch] * be[6], ov[7][ch] * be[7])};
                    bf16* kd = (bf16*)(pk + PK_KDT) + (sc + ch) * 72 + tg16 + 4 * ta;
                    *(GAS v2u*)kd = (v2u){pk2(ov[0][ch] * ek[0], ov[1][ch] * ek[1]), pk2(ov[2][ch] * ek[2], ov[3][ch] * ek[3])};
                    *(GAS v2u*)(kd + 8) = (v2u){pk2(ov[4][ch] * ek[4], ov[5][ch] * ek[5]), pk2(ov[6][ch] * ek[6], ov[7][ch] * ek[7])}; }
            } else {
                float be[8];
#pragma unroll
                for (int ti = 0; ti < 8; ++ti) be[ti] = bts[8 * trow + ti];
#pragma unroll
                for (int ch = 0; ch < 8; ++ch)
                    *(LAS v4u*)(Vt + (sc + ch) * 72 + 8 * trow) = (v4u){pk2(ov[0][ch] * be[0], ov[1][ch] * be[1]), pk2(ov[2][ch] * be[2], ov[3][ch] * be[3]), pk2(ov[4][ch] * be[4], ov[5][ch] * be[5]), pk2(ov[6][ch] * be[6], ov[7][ch] * be[7])};
            }
        }
        __syncthreads();
        { const int kind = F.wave >> 2, mb = (F.wave >> 1) & 1, nb = F.wave & 1; const LAS bf16* Am = kind ? Qb : Kb; f32x16_ acc;
#pragma unroll
          for (int r = 0; r < 16; ++r) acc[r] = 0.f;
#pragma unroll
          for (int ks = 0; ks < 8; ++ks) { const bf16x8 a = *(const LAS bf16x8*)(Am + (32 * mb + i31) * 136 + 16 * ks + 8 * hh), b = *(const LAS bf16x8*)(Kb + (32 * nb + i31) * 136 + 16 * ks + 8 * hh);
              acc = __builtin_amdgcn_mfma_f32_32x32x16_bf16(a, b, acc, 0, 0, 0); }
          const int s = 32 * nb + i31; const float gs = gcs[s];
#pragma unroll
          for (int r = 0; r < 16; ++r) { const int c = 32 * mb + (r & 3) + 8 * (r >> 2) + 4 * hh; const float dec = expf(s <= c ? gcs[c] - gs : 0.f);
              if (kind == 0) As[c * 68 + s] = (s < c) ? bts[c] * acc[r] * dec : 0.f;
              else ((bf16*)(pk + PK_AQ))[c * 72 + swap23(s)] = (bf16)f2bf((s <= c) ? acc[r] * dec : 0.f); } }
        __syncthreads();
        if (F.wave < 4 && lane < 16) { const int b0 = 16 * F.wave; float tc[16];
#pragma unroll
            for (int i = 0; i < 16; ++i) { float a = (i == lane) ? 1.f : 0.f;
#pragma unroll
                for (int m = 0; m < i; ++m) a -= As[(b0 + i) * 68 + b0 + m] * tc[m];
                tc[i] = a; Tm[(b0 + i) * 68 + b0 + lane] = a; } }
        __syncthreads();
        { const int p = tid >> 8, o = tid & 255, r = o >> 4, cc = o & 15, rb = 16 + 32 * p, cbs = 32 * p; float a = 0.f;
#pragma unroll
          for (int m = 0; m < 16; ++m) a += As[(rb + r) * 68 + cbs + m] * Tm[(cbs + m) * 68 + cbs + cc];
          Tp[p * 256 + o] = a;
          __syncthreads();
          float b = 0.f;
#pragma unroll
          for (int m = 0; m < 16; ++m) b += Tm[(rb + r) * 68 + rb + m] * Tp[p * 256 + m * 16 + cc];
          __syncthreads();
          Tm[(rb + r) * 68 + cbs + cc] = -b; }
        __syncthreads();
        { float a[2];
#pragma unroll
          for (int q = 0; q < 2; ++q) { const int o = tid + 512 * q, r = o >> 5, cc = o & 31; a[q] = 0.f;
#pragma unroll 8
              for (int m = 0; m < 32; ++m) a[q] += As[(32 + r) * 68 + m] * Tm[m * 68 + cc]; }
          __syncthreads();
#pragma unroll
          for (int q = 0; q < 2; ++q) { const int o = tid + 512 * q; Tp[(o >> 5) * 36 + (o & 31)] = a[q]; }
          __syncthreads();
#pragma unroll
          for (int q = 0; q < 2; ++q) { const int o = tid + 512 * q, r = o >> 5, cc = o & 31; a[q] = 0.f;
#pragma unroll 8
              for (int m = 0; m < 32; ++m) a[q] += Tm[(32 + r) * 68 + 32 + m] * Tp[m * 36 + cc]; }
#pragma unroll
          for (int q = 0; q < 2; ++q) { const int o = tid + 512 * q; Tm[(32 + (o >> 5)) * 68 + (o & 31)] = -a[q]; } }
        __syncthreads();
        for (int idx = tid; idx < 64 * 32; idx += NTHR) { const int c = idx >> 5, s2 = (idx & 31) * 2; *(LAS unsigned*)(Tmb + c * 72 + s2) = pk2(Tm[c * 68 + s2], Tm[c * 68 + s2 + 1]); }
        __syncthreads();
        if (F.wave < 4) { const int cb = F.wave;
#pragma unroll
            for (int mb = 0; mb < 2; ++mb) { f32x16_ acc;
#pragma unroll
                for (int r = 0; r < 16; ++r) acc[r] = 0.f;
#pragma unroll
                for (int ks = 0; ks < 4; ++ks) { const bf16x8 a = *(const LAS bf16x8*)(Tmb + (32 * mb + i31) * 72 + 16 * ks + 8 * hh), b = *(const LAS bf16x8*)(Vt + (32 * cb + i31) * 72 + 16 * ks + 8 * hh);
                    acc = __builtin_amdgcn_mfma_f32_32x32x16_bf16(a, b, acc, 0, 0, 0); }
                float* up = ul + (cb * 64 + lane) * 32 + mb * 16;
#pragma unroll
                for (int q = 0; q < 4; ++q) *(GAS f32x4*)(up + 4 * q) = (f32x4){acc[4 * q], acc[4 * q + 1], acc[4 * q + 2], acc[4 * q + 3]}; }
        } else { const int db = F.wave - 4;
#pragma unroll
            for (int nb = 0; nb < 2; ++nb) { f32x16_ acc;
#pragma unroll
                for (int r = 0; r < 16; ++r) acc[r] = 0.f;
#pragma unroll
                for (int ks = 0; ks < 4; ++ks) { const bf16x8 a = *(const LAS bf16x8*)(KBt + (32 * db + i31) * 72 + 16 * ks + 8 * hh), b = *(const LAS bf16x8*)(Tmb + (32 * nb + i31) * 72 + 16 * ks + 8 * hh);
                    acc = __builtin_amdgcn_mfma_f32_32x32x16_bf16(a, b, acc, 0, 0, 0); }
                bf16* wp = (bf16*)(pk + PK_WN) + (32 * nb + i31) * 136 + 32 * db + 8 * hh;
#pragma unroll
                for (int q = 0; q < 4; ++q) *(GAS v2u*)(wp + 16 * (q >> 1) + 4 * (q & 1)) = (v2u){pk2(-acc[4 * q], -acc[4 * q + 1]), pk2(-acc[4 * q + 2], -acc[4 * q + 3])}; }
        }
    }
}
__device__ __forceinline__ void gdn_scan_v2(Frame& F) {
    if (blockIdx.x >= 8) return;
    const int h = blockIdx.x, lane = F.lane;
    const unsigned char* PK = F.ws + WS_PK + (size_t)(h * NCHUNK) * PK_BYTES;
    if (F.wave >= 4) {
        const int lw = F.wave - 4;
#pragma unroll 1
        for (int n = -1; n < NCHUNK; ++n) {
            if (n + 1 < NCHUNK) { const unsigned char* src = PK + (size_t)(n + 1) * PK_BYTES + lw * 16384 + lane * 16; LAS unsigned char* dst = F.lds + ((n + 1) & 1) * PK_BYTES + lw * 16384;
#pragma unroll
                for (int p = 0; p < 16; ++p) __builtin_amdgcn_global_load_lds((const unsigned*)(src + p * 1024), (LAS unsigned*)(dst + p * 1024), 16, 0, 0); }
            asm volatile("s_waitcnt vmcnt(0)" ::: "memory"); __builtin_amdgcn_s_barrier(); asm volatile("" ::: "memory");
        }
    } else {
        const int cb = F.wave, i31 = lane & 31, hh = lane >> 5;
        const float* GLg = (const float*)(F.ws + WS_GL);
        const float* ul = (const float*)(F.ws + WS_UL) + ((size_t)(h * NCHUNK) * 4 + cb) * 64 * 32 + lane * 32;
        float* og = (float*)(F.ws + WS_OG) + h * 128 + cb * 32 + i31;
        f32x16 S[4], vn[2], O[2];
#pragma unroll
        for (int b = 0; b < 4; ++b)
#pragma unroll
            for (int r = 0; r < 16; ++r) S[b][r] = 0.f;
#pragma unroll
        for (int mb = 0; mb < 2; ++mb)
#pragma unroll
            for (int q = 0; q < 4; ++q) { const f32x4 v = *(const GAS f32x4*)(ul + mb * 16 + 4 * q); vn[mb][4 * q] = v.x; vn[mb][4 * q + 1] = v.y; vn[mb][4 * q + 2] = v.z; vn[mb][4 * q + 3] = v.w; }
        __builtin_amdgcn_s_barrier(); asm volatile("" ::: "memory");
#pragma unroll 1
        for (int n = 0; n < NCHUNK; ++n) {
            const LAS unsigned char* buf = F.lds + (n & 1) * PK_BYTES;
            bf16x8 sf[8];
#pragma unroll
            for (int b = 0; b < 4; ++b) { sf[2 * b] = cvt8(S[b], 0); sf[2 * b + 1] = cvt8(S[b], 1); }
#pragma unroll
            for (int mb = 0; mb < 2; ++mb) {
#pragma unroll
                for (int r = 0; r < 16; ++r) O[mb][r] = 0.f;
#pragma unroll
                for (int ks = 0; ks < 8; ++ks) { const bf16x8 a = *(const LAS bf16x8*)(buf + PK_WN + (32 * mb + i31) * 272 + (16 * ks + 8 * hh) * 2);
                    vn[mb] = __builtin_amdgcn_mfma_f32_32x32x16_bf16(a, sf[ks], vn[mb], 0, 0, 0); }
#pragma unroll
                for (int ks = 0; ks < 8; ++ks) { const bf16x8 a = *(const LAS bf16x8*)(buf + PK_QD + (32 * mb + i31) * 272 + (16 * ks + 8 * hh) * 2);
                    O[mb] = __builtin_amdgcn_mfma_f32_32x32x16_bf16(a, sf[ks], O[mb], 0, 0, 0); } }
            bf16x8 vf[4];
#pragma unroll
            for (int mb = 0; mb < 2; ++mb) { vf[2 * mb] = cvt8(vn[mb], 0); vf[2 * mb + 1] = cvt8(vn[mb], 1); }
            if (n + 1 < NCHUNK) { const float* un = ul + (size_t)(n + 1) * 4 * 64 * 32;
#pragma unroll
                for (int mb = 0; mb < 2; ++mb)
#pragma unroll
                    for (int q = 0; q < 4; ++q) { const f32x4 v = *(const GAS f32x4*)(un + mb * 16 + 4 * q); vn[mb][4 * q] = v.x; vn[mb][4 * q + 1] = v.y; vn[mb][4 * q + 2] = v.z; vn[mb][4 * q + 3] = v.w; } }
#pragma unroll
            for (int mb = 0; mb < 2; ++mb) {
#pragma unroll
                for (int ks = 0; ks < 4; ++ks) { const bf16x8 a = *(const LAS bf16x8*)(buf + PK_AQ + (32 * mb + i31) * 144 + (16 * ks + 8 * hh) * 2);
                    O[mb] = __builtin_amdgcn_mfma_f32_32x32x16_bf16(a, vf[ks], O[mb], 0, 0, 0); }
#pragma unroll
                for (int r = 0; r < 16; ++r) og[(size_t)(n * 64 + 32 * mb + (r & 3) + 8 * (r >> 2) + 4 * hh) * 1024] = O[mb][r]; }
            const float gl = GLg[n * 8 + h];
#pragma unroll
            for (int b = 0; b < 4; ++b) { S[b] = S[b] * gl;
#pragma unroll
                for (int ks = 0; ks < 4; ++ks) { const bf16x8 a = *(const LAS bf16x8*)(buf + PK_KDT + (32 * b + i31) * 144 + (16 * ks + 8 * hh) * 2);
                    S[b] = __builtin_amdgcn_mfma_f32_32x32x16_bf16(a, vf[ks], S[b], 0, 0, 0); } }
            asm volatile("s_waitcnt lgkmcnt(0)" ::: "memory"); __builtin_amdgcn_s_barrier(); asm volatile("" ::: "memory");
        }
    }
}
__device__ __forceinline__ void gdn_norm(Frame& F) {
    const float* og = (const float*)(F.ws + WS_OG); const bf16* Pz = (const bf16*)(F.ws + WS_P) + 6 * PBUF; bf16* yb = (bf16*)(F.ws + WS_YB);
    const int lane = F.lane, col = lane * 16;
    for (int tok = F.vcu * NWAVES + F.wave; tok < T; tok += F.G * NWAVES) {
        const size_t o = (size_t)tok * 1024 + col; float v[16], ss = 0.f;
#pragma unroll
        for (int q = 0; q < 4; ++q) { const f32x4 x = *(const GAS f32x4*)(og + o + 4 * q); v[4 * q] = x.x; v[4 * q + 1] = x.y; v[4 * q + 2] = x.z; v[4 * q + 3] = x.w; ss += (x.x * x.x + x.y * x.y) + (x.z * x.z + x.w * x.w); }
        ss += __shfl_xor(ss, 1); ss += __shfl_xor(ss, 2); ss += __shfl_xor(ss, 4);
        const float r = rsqrtf(ss * (1.f / 128.f) + NORM_EPS);
        const v4u z0 = *(const GAS v4u*)(Pz + o), z1 = *(const GAS v4u*)(Pz + o + 8);
        const float zz[16] = {bflo(z0.x), bfhi(z0.x), bflo(z0.y), bfhi(z0.y), bflo(z0.z), bfhi(z0.z), bflo(z0.w), bfhi(z0.w), bflo(z1.x), bfhi(z1.x), bflo(z1.y), bfhi(z1.y), bflo(z1.z), bfhi(z1.z), bflo(z1.w), bfhi(z1.w)};
        unsigned w[8];
#pragma unroll
        for (int x = 0; x < 8; ++x) { const int c0 = (col & 127) + 2 * x; w[x] = pk2(v[2 * x] * r * F.in[5][c0] * siluf_(zz[2 * x]), v[2 * x + 1] * r * F.in[5][c0 + 1] * siluf_(zz[2 * x + 1])); }
        *(GAS v4u*)(yb + o) = (v4u){w[0], w[1], w[2], w[3]}; *(GAS v4u*)(yb + o + 8) = (v4u){w[4], w[5], w[6], w[7]};
    }
}

__device__ __forceinline__ void ln_router(Frame& F) {
    constexpr int XS = 2052;
    LAS float* X1s = (LAS float*)F.lds;
    LAS float* LG = (LAS float*)(F.lds + 131584);
    LAS int* hist = (LAS int*)(LG + 1024);
    LAS int* gbs = hist + 64;
    const float* y1 = (const float*)(F.ws + WS_Y1); float* x1f = (float*)(F.ws + WS_X1F); bf16* x1b = (bf16*)(F.ws + WS_X1B);
    int* tokl = (int*)(F.ws + WS_TOKL); float* wgtl = (float*)(F.ws + WS_WGTL); unsigned* info = (unsigned*)(F.ws + WS_INFO);
    const float* g1 = F.in[12]; const float* b1 = F.in[13]; const float* wr = F.in[14]; const float* rb = F.in[15];
    const int tid = F.tid, lane = F.lane;
    for (int blk = blockIdx.x; blk < T / 16; blk += F.G) {
        const int tb = blk * 16;
        __syncthreads();
        if (tid < 64) hist[tid] = 0;
#pragma unroll 1
        for (int tt = 0; tt < 2; ++tt) { const int tl = F.wave * 2 + tt, tok = tb + tl;
            const GAS f32x4* yr = (const GAS f32x4*)(y1 + (size_t)tok * D) + lane; f32x4 v[8]; float s = 0.f;
#pragma unroll
            for (int j = 0; j < 8; ++j) { v[j] = yr[64 * j]; s += (v[j].x + v[j].y) + (v[j].z + v[j].w); }
            const float mean = wave_sum(s) * (1.f / D); float s2 = 0.f;
#pragma unroll
            for (int j = 0; j < 8; ++j) { v[j] = v[j] - mean; s2 += (v[j].x * v[j].x + v[j].y * v[j].y) + (v[j].z * v[j].z + v[j].w * v[j].w); }
            const float rstd = rsqrtf(wave_sum(s2) * (1.f / D) + LN_EPS);
#pragma unroll
            for (int j = 0; j < 8; ++j) { const int col = j * 256 + lane * 4; const f32x4 gg = *(const GAS f32x4*)(g1 + col), bb = *(const GAS f32x4*)(b1 + col);
                const f32x4 xo = v[j] * rstd * gg + bb;
                *(GAS f32x4*)(x1f + (size_t)tok * D + col) = xo; *(GAS v2u*)(x1b + (size_t)tok * D + col) = (v2u){pk2(xo.x, xo.y), pk2(xo.z, xo.w)};
                *(LAS f32x4*)(X1s + tl * XS + col) = xo; }
            if (lane == 0) { tokl[NE * T + tok] = tok; wgtl[NE * T + tok] = 1.f; } }
        __syncthreads();
        { const int eg = lane & 15, tg = lane >> 4; f32x4 acc[4];
#pragma unroll
          for (int ti = 0; ti < 4; ++ti) acc[ti] = (f32x4){0.f, 0.f, 0.f, 0.f};
          const float* wp = wr + (size_t)(256 * F.wave) * NE + 4 * eg; const LAS float* xp = X1s + (4 * tg) * XS + 256 * F.wave;
#pragma unroll 4
          for (int d0 = 0; d0 < 256; d0 += 4) { f32x4 xv[4], wv[4];
#pragma unroll
              for (int dd = 0; dd < 4; ++dd) wv[dd] = *(const GAS f32x4*)(wp + (size_t)(d0 + dd) * NE);
#pragma unroll
              for (int ti = 0; ti < 4; ++ti) xv[ti] = *(const LAS f32x4*)(xp + ti * XS + d0);
#pragma unroll
              for (int ti = 0; ti < 4; ++ti) { acc[ti] = acc[ti] + wv[0] * xv[ti].x; acc[ti] = acc[ti] + wv[1] * xv[ti].y; acc[ti] = acc[ti] + wv[2] * xv[ti].z; acc[ti] = acc[ti] + wv[3] * xv[ti].w; } }
          __syncthreads();
#pragma unroll
          for (int ti = 0; ti < 4; ++ti) *(LAS f32x4*)(X1s + ((F.wave * 16 + 4 * tg + ti) * 64 + 4 * eg)) = acc[ti];
          __syncthreads();
          { const int o = tid * 2; float a0 = 0.f, a1 = 0.f;
#pragma unroll
            for (int w = 0; w < 8; ++w) { const f32x2 p = *(const LAS f32x2*)(X1s + w * 1024 + o); a0 += p.x; a1 += p.y; }
            LG[o] = a0; LG[o + 1] = a1; } }
        __syncthreads();
        bool sel[2]; int loc[2]; float wsl[2]; unsigned long long msk[2];
#pragma unroll
        for (int tt = 0; tt < 2; ++tt) { const int tl = F.wave * 2 + tt;
            const float score = 1.f / (1.f + expf(-LG[tl * 64 + lane])), ch = score + rb[lane];
            int rk = 0;
#pragma unroll
            for (int x = 1; x < 8; ++x) { const float cj = __shfl_xor(ch, x); rk += (cj > ch || (cj == ch && (lane ^ x) < lane)) ? 1 : 0; }
            float gs = rk < 2 ? ch : 0.f; gs += __shfl_xor(gs, 1); gs += __shfl_xor(gs, 2); gs += __shfl_xor(gs, 4);
            const int g = lane >> 3; int grk = 0;
#pragma unroll
            for (int x = 1; x < 8; ++x) { const float gj = __shfl_xor(gs, 8 * x); grk += (gj > gs || (gj == gs && (g ^ x) < g)) ? 1 : 0; }
            const float mk = grk < 4 ? ch : -INFINITY; int erk = 0;
#pragma unroll
            for (int j = 0; j < 64; ++j) { const float mj = __builtin_bit_cast(float, __builtin_amdgcn_readlane(__builtin_bit_cast(int, mk), j)); erk += (mj > mk || (mj == mk && j < lane)) ? 1 : 0; }
            sel[tt] = (grk < 4) && (erk < TOPK);
            const float ssum = wave_sum(sel[tt] ? score : 0.f); wsl[tt] = score / ssum * ROUTED_SCALE;
            msk[tt] = __ballot(sel[tt]);
            loc[tt] = sel[tt] ? atomicAdd((int*)&hist[lane], 1) : 0; }
        __syncthreads();
        if (tid < 64) { const int hc = hist[tid]; gbs[tid] = hc ? (int)__hip_atomic_fetch_add(F.ctl + CW_CNT + 64 * tid, (unsigned)hc, RLX_AGENT) : 0; }
        __syncthreads();
#pragma unroll
        for (int tt = 0; tt < 2; ++tt) if (sel[tt]) { const int tok = tb + F.wave * 2 + tt, slot = gbs[lane] + loc[tt];
            tokl[lane * T + slot] = tok; wgtl[lane * T + slot] = wsl[tt];
            const int k = __popcll(msk[tt] & ((1ull << lane) - 1ull)); info[tok * 8 + k] = ((unsigned)lane << 16) | (unsigned)slot; }
    }
}
__device__ __forceinline__ void final_ln(Frame& F) {
    moe_tables(F);
    const LAS int* rbase = (const LAS int*)(F.lds + LDS_TAB) + 72;
    const float* x1f = (const float*)(F.ws + WS_X1F); const bf16* yas = (const bf16*)(F.ws + WS_YAS); const unsigned* info = (const unsigned*)(F.ws + WS_INFO);
    const float* g2 = F.in[22]; const float* b2 = F.in[23];
    const int lane = F.lane;
    for (int tok = F.vcu * NWAVES + F.wave; tok < T; tok += F.G * NWAVES) {
        f32x4 v[8];
        const GAS f32x4* xr = (const GAS f32x4*)(x1f + (size_t)tok * D) + lane;
#pragma unroll
        for (int j = 0; j < 8; ++j) v[j] = xr[64 * j] * ALPHA;
        for (int k = 0; k < 9; ++k) { int row;
            if (k < 8) { const unsigned w = info[tok * 8 + k]; row = rbase[w >> 16] + (int)(w & 0xffffu); } else row = NE * T * 0 + 65536 + tok;
            const GAS v2u* yr = (const GAS v2u*)(yas + (size_t)row * D) + lane;
#pragma unroll
            for (int j = 0; j < 8; ++j) { const v2u w = yr[64 * j]; v[j] = v[j] + (f32x4){bflo(w.x), bfhi(w.x), bflo(w.y), bfhi(w.y)}; } }
        float s = 0.f;
#pragma unroll
        for (int j = 0; j < 8; ++j) s += (v[j].x + v[j].y) + (v[j].z + v[j].w);
        const float mean = wave_sum(s) * (1.f / D); float s2 = 0.f;
#pragma unroll
        for (int j = 0; j < 8; ++j) { v[j] = v[j] - mean; s2 += (v[j].x * v[j].x + v[j].y * v[j].y) + (v[j].z * v[j].z + v[j].w * v[j].w); }
        const float rstd = rsqrtf(wave_sum(s2) * (1.f / D) + LN_EPS);
#pragma unroll
        for (int j = 0; j < 8; ++j) { const int col = j * 256 + lane * 4; const f32x4 gg = *(const GAS f32x4*)(g2 + col), bb = *(const GAS f32x4*)(b2 + col);
            *(GAS f32x4*)(F.out + (size_t)tok * D + col) = v[j] * rstd * gg + bb; }
    }
}

struct Args { const float* in[24]; float* out; unsigned char* ws; int ph_lo, ph_hi; };
__global__ void __launch_bounds__(NTHR, 2) fwd(Args args) {
    extern __shared__ __attribute__((aligned(16))) unsigned char lds[];
    Frame F;
    F.lds = (LAS unsigned char*)lds;
    F.tid = threadIdx.x; F.lane = F.tid & 63; F.wave = __builtin_amdgcn_readfirstlane(F.tid >> 6);
    F.G = gridDim.x; { const int bx = blockIdx.x; F.vcu = (F.G % 8 == 0) ? (bx % 8) * (F.G / 8) + bx / 8 : bx; }
    F.ws = args.ws; F.ctl = (gu32*)(args.ws + WS_CTL); F.out = args.out;
#pragma unroll
    for (int i = 0; i < 24; ++i) F.in[i] = args.in[i];
    volatile LAS unsigned* MISC = (volatile LAS unsigned*)(F.lds + MISC_OFF);
    if (F.tid < 64) MISC[F.tid] = 0u;
    __syncthreads();
    const int lo = args.ph_lo, hi = args.ph_hi;
    const bool multi = (hi - lo) > 1;
    XcdBarrier bar; bar.bar = (unsigned*)(F.ctl + CW_BAR); bar.x = 0; bar.st = nullptr;
    if (multi) bar = xcd_barrier_post((unsigned*)(F.ctl + CW_BAR), MISC + 8);
#ifndef ONLY_PHASE
#define ONLY_PHASE -1
#endif
#define IN(k) ((ONLY_PHASE < 0 || ONLY_PHASE == (k)) && lo <= (k) && (k) < hi)
#define SEAM(k) do { if (IN(k) && IN((k) + 1)) xcd_barrier(bar); } while (0)
    unsigned char* ws = args.ws;
#ifndef DUP_PHASE
#define DUP_PHASE -1
#endif
#define DUPBAR() do { VM_WAIT(); if (multi) xcd_barrier(bar); else __syncthreads(); } while (0)
    if (IN(0)) { p0_prologue(F); if (DUP_PHASE == 0) { __syncthreads(); p0_prologue(F); } SEAM(0); }
    if (IN(1)) {

        pg8::Gemm g{(const bf16*)(ws + WS_XB), (const bf16*)(ws + WS_WIN), T, NPROJ, D}; pg8::StaticOrder S; S.init(T, NPROJ, F.G, (int)blockIdx.x);
        EpiProj E{(bf16*)(ws + WS_P)};
        pg8::gemm_phase<EpiProj, pg8::StaticOrder, true, false>(F.lds, g, S, E);
        if (DUP_PHASE == 1) { VM_WAIT(); __syncthreads(); pg8::gemm_phase<EpiProj, pg8::StaticOrder, true, false>(F.lds, g, S, E); }
        SEAM(1);
    }
    if (IN(2)) { gdn_prep_v2(F); if (DUP_PHASE == 2) { __syncthreads(); gdn_prep_v2(F); } SEAM(2); }
    if (IN(3)) { gdn_scan_v2(F); __syncthreads(); attn_v2(F); SEAM(3); }
    if (IN(4)) { gdn_norm(F); if (DUP_PHASE == 4) { __syncthreads(); gdn_norm(F); } SEAM(4); }
    if (IN(6)) {

        { pg8::Gemm g{(const bf16*)(ws + WS_YA), (const bf16*)(ws + WS_WA), T, D, 1024}; pg8::StaticOrder S; S.init(T, D, F.G, (int)blockIdx.x);
          EpiBranch<0> E{(const bf16*)(ws + WS_P) + 7 * PBUF, (float*)(ws + WS_TMP), (bf16*)(ws + WS_MRG)};
          pg8::gemm_phase<EpiBranch<0>, pg8::StaticOrder, true, false>(F.lds, g, S, E); }
        VM_WAIT(); __syncthreads();
        { pg8::Gemm g{(const bf16*)(ws + WS_YB), (const bf16*)(ws + WS_WB), T, D, 1024}; pg8::StaticOrder S; S.init(T, D, F.G, (int)blockIdx.x);
          EpiBranch<1> E{(const bf16*)(ws + WS_P) + 9 * PBUF, (float*)(ws + WS_TMP), (bf16*)(ws + WS_MRG)};
          pg8::gemm_phase<EpiBranch<1>, pg8::StaticOrder, true, false>(F.lds, g, S, E); }
        SEAM(6);
    }
    if (IN(7)) {

        pg8::Gemm g{(const bf16*)(ws + WS_MRG), (const bf16*)(ws + WS_WO), T, D, D}; pg8::StaticOrder S; S.init(T, D, F.G, (int)blockIdx.x);
        EpiOut E{F.in[0], (float*)(ws + WS_Y1)};
        pg8::gemm_phase<EpiOut, pg8::StaticOrder, true, false>(F.lds, g, S, E);
        if (DUP_PHASE == 7) { VM_WAIT(); __syncthreads(); pg8::gemm_phase<EpiOut, pg8::StaticOrder, true, false>(F.lds, g, S, E); }
        SEAM(7);
    }
    if (IN(8)) { ln_router(F); SEAM(8); }
    if (IN(9)) {

        moe_tables(F);
        const LAS int* tp = (const LAS int*)(F.lds + LDS_TAB);
        MoeOrder S{tp, tp + 72, tp + 144, (const int*)(ws + WS_TOKL), 4, F.G, (int)blockIdx.x, 1024};
        pg8::Gemm g{(const bf16*)(ws + WS_X1B), (const bf16*)(ws + WS_WGU), T, 1024, D};
        EpiGU E{(bf16*)(ws + WS_HB)};
        pg8::gemm_phase<EpiGU, MoeOrder, true, true>(F.lds, g, S, E);
        if (DUP_PHASE == 9) { VM_WAIT(); __syncthreads(); pg8::gemm_phase<EpiGU, MoeOrder, true, true>(F.lds, g, S, E); }
        SEAM(9);
    }
    if (IN(10)) {

        moe_tables(F);
        const LAS int* tp = (const LAS int*)(F.lds + LDS_TAB);
        MoeOrder S{tp, tp + 72, tp + 144, (const int*)(ws + WS_TOKL), 8, F.G, (int)blockIdx.x, D};
        pg8::Gemm g{(const bf16*)(ws + WS_HB), (const bf16*)(ws + WS_WD), T, D, FF};
        EpiDown E{(bf16*)(ws + WS_YAS), (const float*)(ws + WS_WGTL)};
        pg8::gemm_phase<EpiDown, MoeOrder, true, false>(F.lds, g, S, E);
        if (DUP_PHASE == 10) { VM_WAIT(); __syncthreads(); pg8::gemm_phase<EpiDown, MoeOrder, true, false>(F.lds, g, S, E); }
        SEAM(10);
    }
    if (IN(11)) { final_ln(F); if (DUP_PHASE == 11) { VM_WAIT(); __syncthreads(); final_ln(F); } }
#undef IN
#undef SEAM
}

extern "C" void kernel_launch(void* const* d_in, const int* in_sizes, int n_in, void* d_out, int out_size, void* d_ws, size_t ws_size, hipStream_t stream) {
    static int grid = 0;
    if (grid == 0) {
        if (n_in != 24 || in_sizes[0] != T * D || out_size != T * D || ws_size < WS_END) { fprintf(stderr, "kernel_launch: unexpected shapes (n_in %d, ws %zu); nothing launched\n", n_in, ws_size); grid = -1; return; }
        int dev = 0, cus = 0, per_cu = 0;
        if (hipGetDevice(&dev) != hipSuccess || hipDeviceGetAttribute(&cus, hipDeviceAttributeMultiprocessorCount, dev) != hipSuccess) { grid = -1; return; }
        if (hipFuncSetAttribute((const void*)fwd, hipFuncAttributeMaxDynamicSharedMemorySize, LDS_BYTES) != hipSuccess) { fprintf(stderr, "kernel_launch: hipFuncSetAttribute failed\n"); grid = -1; return; }
        if (hipOccupancyMaxActiveBlocksPerMultiprocessor(&per_cu, (const void*)fwd, NTHR, LDS_BYTES) != hipSuccess || per_cu < 1) { fprintf(stderr, "kernel_launch: occupancy query says %d\n", per_cu); }
        (void)hipGetLastError();
        grid = cus;
    }
    if (grid < 0) return;
    if (hipMemsetAsync((char*)d_ws + WS_CTL, 0, CTL_ZERO_BYTES, stream) != hipSuccess) return;
    Args a{};
    for (int i = 0; i < 24; ++i) a.in[i] = (const float*)d_in[i];
    a.out = (float*)d_out; a.ws = (unsigned char*)d_ws;
#if MK_N_LAUNCHES == 1
    a.ph_lo = 0; a.ph_hi = NPHASE;
    hipLaunchKernelGGL(fwd, dim3(grid), dim3(NTHR), LDS_BYTES, stream, a);
#else
    for (int p = 0; p < NPHASE; ++p) { a.ph_lo = p; a.ph_hi = p + 1; hipLaunchKernelGGL(fwd, dim3(grid), dim3(NTHR), LDS_BYTES, stream, a); }
#endif
}
```

```cpp
#include <hip/hip_runtime.h>
#include <cstdio>
#include <cstdint>

#ifndef MK_N_LAUNCHES
#define MK_N_LAUNCHES 1
#endif

namespace pg8 {
#define PG8_LAS __attribute__((address_space(3)))
typedef unsigned short bf16_t;
typedef short bf16x8 __attribute__((ext_vector_type(8)));
typedef float f32x4 __attribute__((ext_vector_type(4)));
typedef unsigned u32x4 __attribute__((ext_vector_type(4)));
typedef unsigned u32x2 __attribute__((ext_vector_type(2)));
constexpr int BM = 256, BK = 64, HALF = 128, HTB = HALF * BK * 2  , STAGE_BYTES = 8 * HTB, NXCD = 8, WGM = 8;

__host__ __device__ __forceinline__ int lds_byte(int r, int c) { const int st = (r >> 4) * 2 + (c >> 5), rr = r & 15, cc = c & 31, ob = rr * 64 + cc * 2; return st * 1024 + (ob ^ (((ob >> 9) & 1) << 5)); }
__host__ __device__ __forceinline__ void stage_rc(int b, int& R, int& C) { const int st = b / 1024, sb = b % 1024, swz = sb ^ (((sb >> 9) & 1) << 5); R = (st >> 1) * 16 + swz / 64; C = (st & 1) * 32 + (swz % 64) / 2; }
__host__ __device__ __forceinline__ int perm32(int rho) { const int n = rho >> 4, i = rho & 15; return 8 * (i >> 2) + 4 * n + (i & 3); }

struct Unit { int pm, pn, arow, brow, r0, nv, e, lb; };
struct Gemm { const bf16_t* A; const bf16_t* Bt; int M, N, K; };

struct StaticOrder {
    int nM, nN, nwg, G, c;
    __host__ __device__ void init(int M, int N, int G_, int c_) { nM = M / BM; nN = N / BM; nwg = nM * nN; G = G_; c = c_; }
    __host__ __device__ bool next(int i, Unit& u) const {
        const long L = (long)i * G + c; if (L >= nwg) return false;
        int wgid = (int)L; { const int q = nwg / NXCD, r = nwg % NXCD, xcd = wgid % NXCD, off = wgid / NXCD; wgid = (xcd < r ? xcd * (q + 1) : r * (q + 1) + (xcd - r) * q) + off; }
        const int nig = WGM * nN, gid = wgid / nig, fm = gid * WGM, gsz = (nM - fm) < WGM ? (nM - fm) : WGM;
        u.pm = fm + ((wgid % nig) % gsz); u.pn = (wgid % nig) / gsz; u.arow = u.pm * BM; u.brow = u.pn * BM; u.r0 = u.arow; u.nv = BM; u.e = 0; u.lb = 0; return true;
    }
    __device__ __forceinline__ int row_of(const Unit&, int) const { return 0; }
};

__device__ __forceinline__ unsigned cvt_pk_bf16(float lo, float hi) { unsigned r; asm volatile("v_cvt_pk_bf16_f32 %0, %1, %2" : "=v"(r) : "v"(lo), "v"(hi)); return r; }

template <class Epi, class Sched, bool ALIGN_EPI, bool GATHER>
__device__ __forceinline__ void gemm_phase(PG8_LAS unsigned char* lds, const Gemm g, const Sched& S, const Epi& E) {
    static_assert(Epi::PERM, "epilogues use the PERM column layout");
    const int tid = threadIdx.x, wid = __builtin_amdgcn_readfirstlane(tid >> 6), lane = tid & 63, wr = wid >> 2, wc = wid & 3, fr = lane & 15, fq = lane >> 4;
    const int K = g.K, nt = K / BK;
    unsigned voffA[2], voffB[2]; int stR[2], stC[2];
#pragma unroll
    for (int i = 0; i < 2; ++i) { int R, C; stage_rc(tid * 16 + i * 8192, R, C); const int Rb = (R & ~31) + perm32(R & 31); stR[i] = R; stC[i] = C;
        voffA[i] = (unsigned)(R * K + C) * 2u; voffB[i] = (unsigned)(Rb * K + C) * 2u; }
    const size_t kstep = (size_t)(BK * 2);
    const size_t hstep = (size_t)HALF * K * 2;
    const size_t rstep = (size_t)K * 2;
    const unsigned ldsw = (unsigned)wid * 1024u;
    const int aoff = lds_byte(wr * 64 + fr, fq * 8), boff = lds_byte(wc * 32 + fr, fq * 8);
#define PG8_SA(b, h) (((b) * 2 + (h)) * HTB)
#define PG8_SB(b, h) ((4 + (b) * 2 + (h)) * HTB)
#define PG8_STAGE(bufoff, gbase, voff) do { _Pragma("unroll") for (int _i = 0; _i < 2; ++_i) \
        __builtin_amdgcn_global_load_lds((const unsigned*)((const char*)(gbase) + (voff)[_i]), (PG8_LAS unsigned*)(lds + (bufoff) + ldsw + _i * 8192), 16, 0, 0); } while (0)
#define PG8_STAGE_A(b, h, P, V) do { if constexpr (GATHER) { PG8_STAGE(PG8_SA(b, h), P, V[h]); } else { PG8_STAGE(PG8_SA(b, h), (P) + (h) * hstep, voffA); } } while (0)
#define PG8_LDA(dst, b, h) do { _Pragma("unroll") for (int m = 0; m < 4; ++m) _Pragma("unroll") for (int k = 0; k < 2; ++k) dst[m][k] = *(const PG8_LAS bf16x8*)(lds + PG8_SA(b, h) + aoff + m * 2048 + k * 1024); } while (0)
#define PG8_LDB(dst, b, h) do { _Pragma("unroll") for (int n = 0; n < 2; ++n) _Pragma("unroll") for (int k = 0; k < 2; ++k) dst[n][k] = *(const PG8_LAS bf16x8*)(lds + PG8_SB(b, h) + boff + n * 2048 + k * 1024); } while (0)
#define PG8_MMA(ai, bj, At, Bt) do { __builtin_amdgcn_s_setprio(1); _Pragma("unroll") for (int m = 0; m < 4; ++m) _Pragma("unroll") for (int n = 0; n < 2; ++n) _Pragma("unroll") for (int k = 0; k < 2; ++k) \
        acc[ai][bj][m][n] = __builtin_amdgcn_mfma_f32_16x16x32_bf16(Bt[n][k], At[m][k], acc[ai][bj][m][n], 0, 0, 0); __builtin_amdgcn_s_setprio(0); } while (0)
#define PG8_WAIT_V(n) asm volatile("s_waitcnt vmcnt(" #n ")" ::: "memory")
#define PG8_WAIT_L(n) asm volatile("s_waitcnt lgkmcnt(" #n ")" ::: "memory")
#define PG8_BAR __builtin_amdgcn_s_barrier()
#define PG8_SCHED __builtin_amdgcn_sched_barrier(0)
#define PG8_GOFF(V, u) do { if constexpr (GATHER) { _Pragma("unroll") for (int _h = 0; _h < 2; ++_h) _Pragma("unroll") for (int _i = 0; _i < 2; ++_i) \
        V[_h][_i] = (unsigned)(S.row_of(u, _h * HALF + stR[_i]) * K + stC[_i]) * 2u; } } while (0)
    Unit cur, nxt; int ui = 0;
    if (!S.next(0, cur)) return;
    f32x4 acc[2][2][4][2];
#pragma unroll
    for (int a = 0; a < 2; ++a)
#pragma unroll
        for (int b = 0; b < 2; ++b)
#pragma unroll
            for (int m = 0; m < 4; ++m)
#pragma unroll
                for (int n = 0; n < 2; ++n) acc[a][b][m][n] = (f32x4){0.f, 0.f, 0.f, 0.f};
    bf16x8 At[4][2], B0[2][2], B1[2][2];
    unsigned vcur[2][2] = {{0u, 0u}, {0u, 0u}}, vnxt[2][2] = {{0u, 0u}, {0u, 0u}}, v2[2][2] = {{0u, 0u}, {0u, 0u}};
    PG8_GOFF(vcur, cur);
    const char* cA = GATHER ? (const char*)g.A : (const char*)g.A + (size_t)cur.arow * rstep; const char* cB = (const char*)g.Bt + (size_t)cur.brow * rstep;
    PG8_STAGE(PG8_SB(0, 0), cB, voffB); PG8_STAGE(PG8_SB(0, 1), cB + hstep, voffB); PG8_STAGE_A(0, 0, cA, vcur); PG8_STAGE_A(0, 1, cA, vcur);
    if (wr == 1) PG8_BAR;
    PG8_WAIT_V(2); PG8_BAR;
    PG8_STAGE(PG8_SB(1, 0), cB + kstep, voffB); PG8_STAGE_A(1, 0, cA + kstep, vcur); PG8_STAGE(PG8_SB(1, 1), cB + hstep + kstep, voffB);
    PG8_WAIT_V(6); PG8_BAR;
    for (;;) {
        const bool has_next = S.next(ui + 1, nxt);
        if constexpr (GATHER) { if (has_next) { PG8_GOFF(vnxt, nxt); } else {
#pragma unroll
            for (int h = 0; h < 2; ++h)
#pragma unroll
                for (int i = 0; i < 2; ++i) vnxt[h][i] = vcur[h][i]; } }
        const char* nA = GATHER ? cA : (has_next ? (const char*)g.A + (size_t)nxt.arow * rstep : cA); const char* nB = has_next ? (const char*)g.Bt + (size_t)nxt.brow * rstep : cB;
        for (int t = 0; t < nt; t += 2) {
            const bool last = (t == nt - 2);
            const char* a1 = cA + (size_t)(t + 1) * kstep;
            const char* a2 = last ? nA : cA + (size_t)(t + 2) * kstep; const char* b2 = last ? nB : cB + (size_t)(t + 2) * kstep;
            const char* a3 = a2 + kstep; const char* b3 = b2 + kstep;
            if constexpr (GATHER) {
#pragma unroll
                for (int h = 0; h < 2; ++h)
#pragma unroll
                    for (int i = 0; i < 2; ++i) v2[h][i] = last ? vnxt[h][i] : vcur[h][i]; }
            PG8_LDB(B0, 0, 0); PG8_LDB(B1, 0, 1); PG8_SCHED; PG8_LDA(At, 0, 0); PG8_STAGE_A(1, 1, a1, vcur);
            PG8_WAIT_V(8); PG8_WAIT_L(0); PG8_BAR; PG8_MMA(0, 0, At, B0); PG8_MMA(0, 1, At, B1); PG8_BAR; PG8_SCHED;
            PG8_LDA(At, 0, 1); PG8_STAGE(PG8_SB(0, 0), b2, voffB); PG8_STAGE(PG8_SB(0, 1), b2 + hstep, voffB); PG8_STAGE_A(0, 0, a2, v2);
            PG8_WAIT_V(8); PG8_WAIT_L(0); PG8_BAR; PG8_MMA(1, 0, At, B0); PG8_MMA(1, 1, At, B1); PG8_BAR; PG8_SCHED;
            PG8_LDB(B0, 1, 0); PG8_LDB(B1, 1, 1); PG8_SCHED; PG8_LDA(At, 1, 0); PG8_STAGE_A(0, 1, a2, v2);
            PG8_WAIT_V(8); PG8_WAIT_L(0); PG8_BAR; PG8_MMA(0, 0, At, B0); PG8_MMA(0, 1, At, B1); PG8_BAR; PG8_SCHED;
            PG8_LDA(At, 1, 1); PG8_STAGE(PG8_SB(1, 0), b3, voffB); PG8_STAGE(PG8_SB(1, 1), b3 + hstep, voffB); PG8_STAGE_A(1, 0, a3, v2);
            PG8_WAIT_V(8); PG8_WAIT_L(0); PG8_BAR; PG8_MMA(1, 0, At, B0); PG8_MMA(1, 1, At, B1); PG8_BAR; PG8_SCHED;
        }
        if constexpr (ALIGN_EPI) { if (wr == 0) PG8_BAR; }
        E(acc, cur, wr, wc, fr, fq);
        if (!has_next) break;
#pragma unroll
        for (int a = 0; a < 2; ++a)
#pragma unroll
            for (int b = 0; b < 2; ++b)
#pragma unroll
                for (int m = 0; m < 4; ++m)
#pragma unroll
                    for (int n = 0; n < 2; ++n) acc[a][b][m][n] = (f32x4){0.f, 0.f, 0.f, 0.f};
        cur = nxt; cA = nA; cB = nB; ++ui;
        if constexpr (GATHER) {
#pragma unroll
            for (int h = 0; h < 2; ++h)
#pragma unroll
                for (int i = 0; i < 2; ++i) vcur[h][i] = vnxt[h][i]; }
        if constexpr (ALIGN_EPI) { if (wr == 1) PG8_BAR; }
    }
    PG8_WAIT_V(0);
    if constexpr (!ALIGN_EPI) { if (wr == 0) PG8_BAR; }
    PG8_BAR;
#undef PG8_SA
#undef PG8_SB
#undef PG8_STAGE
#undef PG8_STAGE_A
#undef PG8_LDA
#undef PG8_LDB
#undef PG8_MMA
#undef PG8_WAIT_V
#undef PG8_WAIT_L
#undef PG8_BAR
#undef PG8_SCHED
#undef PG8_GOFF
}
}

constexpr int NWAVES = 8, NTHR = 512;
constexpr int T = 8192, D = 2048, NPROJ = 11264, WIN_PITCH = 11280, NH = 8, NE = 64, NEX = 65, FF = 512, TOPK = 8, NCHUNK = 128;
constexpr float ALPHA = 1.18920711500272106672f, LN_EPS = 1e-5f, NORM_EPS = 1e-6f, LAMBDA_INIT = 0.2f, ROUTED_SCALE = 2.5f;
constexpr int NPHASE = 12;

constexpr size_t MiB = 1u << 20;
constexpr size_t WS_CTL = 0, CTL_ZERO_BYTES = 1 * MiB;
constexpr size_t WS_WA = 2 * MiB, WS_WB = 6 * MiB, WS_WO = 10 * MiB, WS_WGU = 18 * MiB, WS_WD = 278 * MiB;
constexpr size_t WS_X1F = 408 * MiB, WS_X1B = 472 * MiB, WS_YA = 504 * MiB, WS_YB = 520 * MiB;
constexpr size_t WS_TOKL = 536 * MiB, WS_WGTL = 539 * MiB, WS_INFO = 542 * MiB, WS_GL = 542 * MiB + 512 * 1024, WS_GAB = 543 * MiB;
constexpr size_t WS_WIN = 544 * MiB, WS_XB = 588 * MiB, WS_P = 620 * MiB;
constexpr size_t WS_U = 796 * MiB, WS_W = 828 * MiB, WS_QD = 860 * MiB, WS_KD = 892 * MiB, WS_AQK = 924 * MiB, WS_SST = 940 * MiB, WS_END = 1004 * MiB;
constexpr size_t WS_PK = 796 * MiB, WS_UL = 860 * MiB, WS_OG = 892 * MiB;
constexpr int PKL = 62464, OST_OFF = 2 * PKL, OST_P = 272, OST_BYTES = 64 * OST_P;
constexpr int PK_BYTES = 65536, PK_WN = 0, PK_QD = 17408, PK_KDT = 34816, PK_AQ = 53248;
constexpr size_t WS_TMP = 796 * MiB, WS_MRG = 860 * MiB, WS_Y1 = 892 * MiB;
constexpr size_t WS_HB = 544 * MiB, WS_YAS = 620 * MiB;
constexpr size_t PBUF = (size_t)T * 1024;
constexpr int CW_BAR = 4096;
constexpr int CW_CNT = 32768;
constexpr int CW_AQ = 40960;
constexpr int CW_SP = 41024;

constexpr int RING_BYTES = 131072;
constexpr int LDS_TAB = RING_BYTES;
constexpr int LDS_BYTES = 163840;
constexpr int MISC_OFF = LDS_BYTES - 256;

#define GAS __attribute__((address_space(1)))
#define LAS __attribute__((address_space(3)))
typedef unsigned short bf16;
typedef unsigned v4u __attribute__((ext_vector_type(4)));
typedef unsigned v2u __attribute__((ext_vector_type(2)));
typedef float f32x4 __attribute__((ext_vector_type(4)));
typedef float f32x2 __attribute__((ext_vector_type(2)));
typedef short bf16x8 __attribute__((ext_vector_type(8)));
typedef GAS unsigned gu32;
#define RLX_AGENT __ATOMIC_RELAXED, __HIP_MEMORY_SCOPE_AGENT
#define LDS_WAIT() asm volatile("s_waitcnt lgkmcnt(0)" ::: "memory")
#define VM_WAIT() asm volatile("s_waitcnt vmcnt(0)" ::: "memory")
__device__ __forceinline__ unsigned f2bf(float f) { unsigned u = __builtin_bit_cast(unsigned, f); return (u + 0x7fffu + ((u >> 16) & 1u)) >> 16; }
__device__ __forceinline__ unsigned pk2(float lo, float hi) { unsigned r; asm("v_cvt_pk_bf16_f32 %0, %1, %2" : "=v"(r) : "v"(lo), "v"(hi)); return r; }
__device__ __forceinline__ float bflo(unsigned w) { return __builtin_bit_cast(float, w << 16); }
__device__ __forceinline__ float bfhi(unsigned w) { return __builtin_bit_cast(float, w & 0xffff0000u); }
__device__ __forceinline__ float bf2f(bf16 b) { return __builtin_bit_cast(float, (unsigned)b << 16); }
__device__ __forceinline__ float sigmoidf_(float x) { return 1.f / (1.f + __expf(-x)); }
__device__ __forceinline__ float siluf_(float x) { return x / (1.f + __expf(-x)); }

#define XB_TMO      128
#define XB_XCNT(j)  (256  + 64 * (j))
#define XB_XSUB(j)  (1280 + 64 * (j))
#define XB_XGEN(j)  (2304 + 64 * (j))
#define XB_TOP      3328
#define XB_TOPGEN   3392
#define XCD_BAR_WORDS 3456
#define XB_SPIN_CAP (1u << 22)

__device__ __forceinline__ unsigned xb_ld(unsigned* p)              { return __hip_atomic_load(p, __ATOMIC_RELAXED, __HIP_MEMORY_SCOPE_AGENT); }
__device__ __forceinline__ unsigned xb_add(unsigned* p, unsigned v) { return __hip_atomic_fetch_add(p, v, __ATOMIC_RELAXED, __HIP_MEMORY_SCOPE_AGENT); }
__device__ __forceinline__ unsigned xb_xcc_id() { return (unsigned)__builtin_amdgcn_s_getreg((3 << 11) | 20) & 0xFu; }
#define XB_SPIN(cond, bar) do { unsigned _sp = 0; while (cond) { __builtin_amdgcn_s_sleep(1); \
    if ((++_sp & 255u) == 0u) { if (xb_ld(&(bar)[XB_TMO])) break; if (_sp > XB_SPIN_CAP) { atomicAdd(&(bar)[XB_TMO], 1u); break; } } } } while (0)

struct XcdBarrier {
    unsigned* bar; unsigned x;
    volatile LAS unsigned* st;
};
__device__ __forceinline__ XcdBarrier xcd_barrier_post(unsigned* bar, volatile LAS unsigned* st) {
    XcdBarrier b; b.bar = bar; b.x = xb_xcc_id(); b.st = st;
    if (threadIdx.x == 0) (void)xb_add(&bar[XB_XCNT(b.x)], 1u);
    return b;
}
__device__ __forceinline__ void xcd_barrier_complete(unsigned* bar, unsigned x, unsigned& nloc, unsigned& nx) {
    const unsigned G = gridDim.x * gridDim.y * gridDim.z;
    unsigned sum, cnt, mine, sp = 0u;
    for (;;) {
        sum = 0u; cnt = 0u; mine = 0u;
#pragma unroll
        for (unsigned j = 0; j < 16; ++j) { const unsigned c = xb_ld(&bar[XB_XCNT(j)]); sum += c; cnt += (c > 0u) ? 1u : 0u; mine = (j == x) ? c : mine; }
        if (sum == G) break;
        __builtin_amdgcn_s_sleep(1);
        if ((++sp & 255u) == 0u) { if (xb_ld(&bar[XB_TMO])) break; if (sp > XB_SPIN_CAP) { atomicAdd(&bar[XB_TMO], 1u); break; } }
    }
    nloc = mine > 0u ? mine : 1u; nx = cnt > 0u ? cnt : 1u;
}
__device__ __forceinline__ void xcd_barrier(const XcdBarrier& b) {
    asm volatile("s_waitcnt vmcnt(0)" ::: "memory");
    __syncthreads();
    if (threadIdx.x == 0) {
        unsigned* bar = b.bar;
        __builtin_amdgcn_s_waitcnt(0);
        unsigned nloc = b.st[0], nx = b.st[1];
        if (nloc == 0u) { xcd_barrier_complete(bar, b.x, nloc, nx); b.st[0] = nloc; b.st[1] = nx; }
        const unsigned old = xb_add(&bar[XB_XSUB(b.x)], 1u);
        const unsigned gen = old / nloc;
        if (old + 1u == (gen + 1u) * nloc) {
            __builtin_amdgcn_fence(__ATOMIC_RELEASE, "agent");
            asm volatile("s_waitcnt vmcnt(0)" ::: "memory");
            const unsigned og = xb_add(&bar[XB_TOP], 1u);
            const unsigned tg = og / nx;
            if (og + 1u == (tg + 1u) * nx) xb_add(&bar[XB_TOPGEN], 1u);
            else XB_SPIN(xb_ld(&bar[XB_TOPGEN]) == tg, bar);
            __builtin_amdgcn_fence(__ATOMIC_ACQUIRE, "agent");
            xb_add(&bar[XB_XGEN(b.x)], 1u);
            asm volatile("s_waitcnt vmcnt(0)" ::: "memory");
        } else {
            XB_SPIN(xb_ld(&bar[XB_XGEN(b.x)]) == gen, bar);
            __builtin_amdgcn_fence(__ATOMIC_ACQUIRE, "agent");
            asm volatile("s_waitcnt vmcnt(0)" ::: "memory");
        }
    }
    __syncthreads();
}

struct Frame {
    LAS unsigned char* lds;
    gu32* ctl;
    int tid, lane, wave;
    int vcu, G;
    const float* in[24]; float* out; unsigned char* ws;
};
__device__ __forceinline__ float wave_sum(float v) {
#pragma unroll
    for (int o = 1; o < 64; o <<= 1) v += __shfl_xor(v, o);
    return v;
}
__device__ __forceinline__ float wave_max(float v) {
#pragma unroll
    for (int o = 1; o < 64; o <<= 1) v = fmaxf(v, __shfl_xor(v, o));
    return v;
}

__device__ __forceinline__ void p0_transpose_item(const float* W, int pitch, int sn0, bf16* WT, int dpitch, int dr0, int k0, LAS float* scr, int lane) {
#pragma unroll 8
    for (int i = 0; i < 32; ++i) { const int kk = 2 * i + (lane >> 5); scr[kk * 33 + (lane & 31)] = W[(size_t)(k0 + kk) * pitch + sn0 + (lane & 31)]; }
    LDS_WAIT(); asm volatile("" ::: "memory");
    const int c = lane & 7;
#pragma unroll
    for (int j = 0; j < 4; ++j) { const int n = (lane >> 3) + 8 * j; const LAS float* s = scr + (8 * c) * 33 + n;
        v4u o; o.x = pk2(s[0 * 33], s[1 * 33]); o.y = pk2(s[2 * 33], s[3 * 33]); o.z = pk2(s[4 * 33], s[5 * 33]); o.w = pk2(s[6 * 33], s[7 * 33]);
        *(GAS v4u*)(WT + (size_t)(dr0 + n) * dpitch + k0 + 8 * c) = o; }
    LDS_WAIT(); asm volatile("" ::: "memory");
}
__device__ __forceinline__ void p0_prologue(Frame& F) {
    unsigned char* ws = F.ws;
    {
        LAS float* w16 = (LAS float*)F.lds;
        for (int idx = F.tid; idx < 2048 * 4; idx += NTHR) { const int k = idx >> 2, q = idx & 3;
            const f32x4 v = *(const GAS f32x4*)(F.in[1] + (size_t)k * WIN_PITCH + 7168 + 4 * q); *(LAS f32x4*)(w16 + k * 16 + 4 * q) = v; }
        __syncthreads();
        float* gab = (float*)(ws + WS_GAB);
        for (int tok = F.vcu * NWAVES + F.wave; tok < T; tok += F.G * NWAVES) {
            float acc[16];
#pragma unroll
            for (int e = 0; e < 16; ++e) acc[e] = 0.f;
            const float* xr = F.in[0] + (size_t)tok * D;
#pragma unroll 2
            for (int j = 0; j < 32; ++j) { const int k = j * 64 + F.lane; const float xv = xr[k];
#pragma unroll
                for (int q = 0; q < 4; ++q) { const f32x4 w = *(const LAS f32x4*)(w16 + k * 16 + 4 * q);
                    acc[4 * q + 0] += xv * w.x; acc[4 * q + 1] += xv * w.y; acc[4 * q + 2] += xv * w.z; acc[4 * q + 3] += xv * w.w; } }
#pragma unroll
            for (int e = 0; e < 16; ++e) acc[e] = wave_sum(acc[e]);
            if (F.lane == 0) {
#pragma unroll
                for (int q = 0; q < 4; ++q) *(GAS f32x4*)(gab + (size_t)tok * 16 + 4 * q) = (f32x4){acc[4 * q], acc[4 * q + 1], acc[4 * q + 2], acc[4 * q + 3]}; }
        }
        __syncthreads();
    }
    LAS float* scr = (LAS float*)(F.lds + F.wave * 16384);
    const int gw = F.vcu * NWAVES + F.wave, NGW = F.G * NWAVES;
    constexpr int I_IN = 32 * 352, I_A = 16 * 64, I_O = 32 * 64, I_GU = NEX * 2 * 512, I_D = NEX * 512;
    constexpr int NITEMS = I_IN + 2 * I_A + I_O + I_GU + I_D;
    for (int it = gw; it < NITEMS; it += NGW) {
        int r = it;
        if (r < I_IN) { const int kb = r / 352, nb = r % 352, n0 = 32 * nb; p0_transpose_item(F.in[1], WIN_PITCH, n0 + (n0 >= 7168 ? 16 : 0), (bf16*)(ws + WS_WIN), D, n0, 64 * kb, scr, F.lane); continue; } r -= I_IN;
        if (r < I_A) { const int kb = r / 64, nb = r % 64; p0_transpose_item(F.in[9], D, 32 * nb, (bf16*)(ws + WS_WA), 1024, 32 * nb, 64 * kb, scr, F.lane); continue; } r -= I_A;
        if (r < I_A) { const int kb = r / 64, nb = r % 64; p0_transpose_item(F.in[10], D, 32 * nb, (bf16*)(ws + WS_WB), 1024, 32 * nb, 64 * kb, scr, F.lane); continue; } r -= I_A;
        if (r < I_O) { const int kb = r / 64, nb = r % 64; p0_transpose_item(F.in[11], D, 32 * nb, (bf16*)(ws + WS_WO), D, 32 * nb, 64 * kb, scr, F.lane); continue; } r -= I_O;
        if (r < I_GU) { const int e = r / 1024, which = (r >> 9) & 1, q = r & 511, kb = q & 31, nb = q >> 5;
            const float* src = e < NE ? (which ? F.in[17] : F.in[16]) + (size_t)e * D * FF : (which ? F.in[20] : F.in[19]);
            p0_transpose_item(src, FF, 32 * nb, (bf16*)(ws + WS_WGU) + (size_t)e * 1024 * D, D, 256 * (nb >> 2) + 32 * (nb & 3) + 128 * which, 64 * kb, scr, F.lane); continue; } r -= I_GU;
        { const int e = r / 512, q = r & 511, kb = q & 7, nb = q >> 3;
            const float* src = e < NE ? F.in[18] + (size_t)e * FF * D : F.in[21];
            p0_transpose_item(src, D, 32 * nb, (bf16*)(ws + WS_WD) + (size_t)e * D * FF, FF, 32 * nb, 64 * kb, scr, F.lane); }
    }
    { const GAS f32x4* x4 = (const GAS f32x4*)F.in[0]; GAS v4u* o = (GAS v4u*)(ws + WS_XB);
#pragma unroll 4
      for (size_t i = (size_t)F.vcu * NTHR + F.tid; i < (size_t)T * D / 8; i += (size_t)F.G * NTHR) { const f32x4 a = x4[2 * i], b = x4[2 * i + 1];
          v4u w; w.x = pk2(a.x, a.y); w.y = pk2(a.z, a.w); w.z = pk2(b.x, b.y); w.w = pk2(b.z, b.w); o[i] = w; } }
}

using pg8::Unit;
struct EpiProj {
    static constexpr bool PERM = true;
    bf16* P;
    __device__ __forceinline__ void operator()(const f32x4 (&acc)[2][2][4][2], const Unit& u, int wr, int wc, int fr, int fq) const {
        const int buf = u.pn >> 2, colt = (u.pn & 3) * 256; bf16* base = P + (size_t)buf * PBUF;
        const int row0 = u.r0 + wr * 64 + fr, col0 = colt + wc * 32 + 8 * fq; const bool sg = buf >= 7;
        if (buf == 2) {
            const int frp = (fr & ~12) | ((fr & 4) << 1) | ((fr & 8) >> 1);
#pragma unroll
            for (int ai = 0; ai < 2; ++ai)
#pragma unroll
                for (int m = 0; m < 4; ++m) { const int tokp = u.r0 + wr * 64 + ai * 128 + m * 16 + frp;
#pragma unroll
                    for (int bj = 0; bj < 2; ++bj)
#pragma unroll
                        for (int n = 0; n < 2; ++n)
#pragma unroll
                            for (int x = 0; x < 4; ++x) base[(size_t)(col0 + bj * 128 + 4 * n + x) * T + tokp] = (bf16)f2bf(acc[ai][bj][m][n][x]); }
            return; }
#pragma unroll
        for (int ai = 0; ai < 2; ++ai)
#pragma unroll
            for (int m = 0; m < 4; ++m) { bf16* rowp = base + (size_t)(row0 + ai * 128 + m * 16) * 1024 + col0;
#pragma unroll
                for (int bj = 0; bj < 2; ++bj) { f32x4 v0 = acc[ai][bj][m][0], v1 = acc[ai][bj][m][1];
                    if (sg) { v0 = (f32x4){sigmoidf_(v0.x), sigmoidf_(v0.y), sigmoidf_(v0.z), sigmoidf_(v0.w)}; v1 = (f32x4){sigmoidf_(v1.x), sigmoidf_(v1.y), sigmoidf_(v1.z), sigmoidf_(v1.w)}; }
                    v4u w; w.x = pk2(v0.x, v0.y); w.y = pk2(v0.z, v0.w); w.z = pk2(v1.x, v1.y); w.w = pk2(v1.z, v1.w);
                    *(GAS v4u*)(rowp + bj * 128) = w; } }
    }
};
template <int STEP> struct EpiBranch {
    static constexpr bool PERM = true;
    const bf16* SG; float* tmp; bf16* mrg;
    __device__ __forceinline__ void operator()(const f32x4 (&acc)[2][2][4][2], const Unit& u, int wr, int wc, int fr, int fq) const {
        const int row0 = u.r0 + wr * 64 + fr, colu = u.pn * 256 + wc * 32 + 8 * fq;
#pragma unroll
        for (int ai = 0; ai < 2; ++ai)
#pragma unroll
            for (int m = 0; m < 4; ++m) { const int row = row0 + ai * 128 + m * 16;
#pragma unroll
                for (int bj = 0; bj < 2; ++bj) { const int col = colu + bj * 128;
                    const v4u g = *(const GAS v4u*)(SG + (size_t)(col >> 10) * PBUF + (size_t)row * 1024 + (col & 1023));
                    f32x4 v0 = acc[ai][bj][m][0], v1 = acc[ai][bj][m][1];
                    v0 = v0 * (f32x4){bflo(g.x), bfhi(g.x), bflo(g.y), bfhi(g.y)}; v1 = v1 * (f32x4){bflo(g.z), bfhi(g.z), bflo(g.w), bfhi(g.w)};
                    float* tp = tmp + (size_t)row * D + col;
                    if (STEP == 0) { *(GAS f32x4*)tp = v0; *(GAS f32x4*)(tp + 4) = v1; }
                    else { v0 = v0 + *(const GAS f32x4*)tp; v1 = v1 + *(const GAS f32x4*)(tp + 4);
                        v4u w; w.x = pk2(v0.x, v0.y); w.y = pk2(v0.z, v0.w); w.z = pk2(v1.x, v1.y); w.w = pk2(v1.z, v1.w);
                        *(GAS v4u*)(mrg + (size_t)row * D + col) = w; } } }
    }
};
struct EpiOut {
    static constexpr bool PERM = true;
    const float* x; float* y1;
    __device__ __forceinline__ void operator()(const f32x4 (&acc)[2][2][4][2], const Unit& u, int wr, int wc, int fr, int fq) const {
        const int row0 = u.r0 + wr * 64 + fr, colu = u.pn * 256 + wc * 32 + 8 * fq;
#pragma unroll
        for (int ai = 0; ai < 2; ++ai)
#pragma unroll
            for (int m = 0; m < 4; ++m) { const size_t ro = (size_t)(row0 + ai * 128 + m * 16) * D;
#pragma unroll
                for (int bj = 0; bj < 2; ++bj) { const size_t o = ro + colu + bj * 128;
                    const f32x4 x0 = *(const GAS f32x4*)(x + o), x1 = *(const GAS f32x4*)(x + o + 4);
                    *(GAS f32x4*)(y1 + o) = x0 * ALPHA + acc[ai][bj][m][0]; *(GAS f32x4*)(y1 + o + 4) = x1 * ALPHA + acc[ai][bj][m][1]; } }
    }
};
struct EpiGU {
    static constexpr bool PERM = true;
    bf16* HB;
    __device__ __forceinline__ void operator()(const f32x4 (&acc)[2][2][4][2], const Unit& u, int wr, int wc, int fr, int fq) const {
        const int col = u.pn * 128 + wc * 32 + 8 * fq;
#pragma unroll
        for (int ai = 0; ai < 2; ++ai)
#pragma unroll
            for (int m = 0; m < 4; ++m) { const int r = ai * 128 + wr * 64 + m * 16 + fr;
                if (r < u.nv) { const f32x4 g0 = acc[ai][0][m][0], g1 = acc[ai][0][m][1], u0 = acc[ai][1][m][0], u1 = acc[ai][1][m][1];
                    v4u w; w.x = pk2(siluf_(g0.x) * u0.x, siluf_(g0.y) * u0.y); w.y = pk2(siluf_(g0.z) * u0.z, siluf_(g0.w) * u0.w);
                    w.z = pk2(siluf_(g1.x) * u1.x, siluf_(g1.y) * u1.y); w.w = pk2(siluf_(g1.z) * u1.z, siluf_(g1.w) * u1.w);
                    *(GAS v4u*)(HB + (size_t)(u.r0 + r) * FF + col) = w; } }
    }
};
struct EpiDown {
    static constexpr bool PERM = true;
    bf16* YAS; const float* wgtl;
    __device__ __forceinline__ void operator()(const f32x4 (&acc)[2][2][4][2], const Unit& u, int wr, int wc, int fr, int fq) const {
        const int colu = u.pn * 256 + wc * 32 + 8 * fq;
#pragma unroll
        for (int ai = 0; ai < 2; ++ai)
#pragma unroll
            for (int m = 0; m < 4; ++m) { const int r = ai * 128 + wr * 64 + m * 16 + fr;
                if (r < u.nv) { const float wg = wgtl[u.lb + r];
#pragma unroll
                    for (int bj = 0; bj < 2; ++bj) { const f32x4 v0 = acc[ai][bj][m][0] * wg, v1 = acc[ai][bj][m][1] * wg;
                        v4u w; w.x = pk2(v0.x, v0.y); w.y = pk2(v0.z, v0.w); w.z = pk2(v1.x, v1.y); w.w = pk2(v1.z, v1.w);
                        *(GAS v4u*)(YAS + (size_t)(u.r0 + r) * D + colu + bj * 128) = w; } } }
    }
};
struct MoeOrder {
    const LAS int* units; const int* tokl;
    __device__ __forceinline__ bool next(int i, Unit& u) const {
        if (i >= 16) return false;
        const LAS int* p = units + i * 8; const int pm = p[0]; if (pm < 0) return false;
        u.pm = pm; u.pn = p[1]; u.arow = p[2]; u.brow = p[3]; u.r0 = p[4]; u.nv = p[5]; u.e = p[6]; u.lb = p[7]; return true;
    }
    __device__ __forceinline__ int row_of(const Unit& u, int r) const { return r < u.nv ? tokl[u.lb + r] : 0; }
};
__device__ __forceinline__ void moe_tables(Frame& F, int NT, int brows) {
    LAS int* tpref = (LAS int*)(F.lds + LDS_TAB); LAS int* rbase = tpref + 72; LAS int* cnts = rbase + 72;
    __syncthreads();
    if (F.wave == 0) {
        const int c = (int)__hip_atomic_load(F.ctl + CW_CNT + 64 * F.lane, RLX_AGENT);
        int tl = (c + 255) >> 8, tp = tl, rb = c;
#pragma unroll
        for (int o = 1; o < 64; o <<= 1) { const int a = __shfl_up(tp, o), b = __shfl_up(rb, o); if (F.lane >= o) { tp += a; rb += b; } }
        tpref[F.lane] = tp - tl; rbase[F.lane] = rb - c; cnts[F.lane] = c;
        if (F.lane == 63) { tpref[64] = tp; rbase[64] = rb; cnts[64] = T; tpref[65] = tp + T / 256; rbase[65] = rb + T; }
    }
    __syncthreads();
    if (NT > 0 && F.tid < 16) {
        LAS int* p = (LAS int*)(F.lds + LDS_TAB + 1024) + F.tid * 8; const int L = F.tid * F.G + (int)blockIdx.x;
        if (L >= tpref[NEX] * NT) p[0] = -1;
        else { const int tg = L / NT, nt = L % NT; int e = 0;
            while (tpref[e + 1] <= tg) ++e;
            const int mt = tg - tpref[e], rem = cnts[e] - mt * 256, r0 = rbase[e] + mt * 256;
            p[0] = mt; p[1] = nt; p[2] = r0; p[3] = e * brows + nt * 256; p[4] = r0; p[5] = rem < 256 ? rem : 256; p[6] = e; p[7] = e * T + mt * 256; }
    }
    __syncthreads();
}
#ifndef DUP_PHASE
#define DUP_PHASE -1
#endif

__device__ __forceinline__ int t5_bucket(int rel) {
    const int n = rel < 0 ? -rel : rel; int b;
    if (n < 8) b = n; else if (n < 12) b = 8; else if (n < 16) b = 9; else if (n < 23) b = 10; else if (n < 32) b = 11; else if (n < 46) b = 12; else if (n < 64) b = 13; else if (n < 91) b = 14; else b = 15;
    return b + (rel > 0 ? 16 : 0);
}
typedef float f32x16 __attribute__((ext_vector_type(16)));
__device__ __forceinline__ bf16x8 cvt8(const f32x16& x, int s) {
    v4u w;
    if (s == 0) { w.x = pk2(x[0], x[1]); w.y = pk2(x[2], x[3]); w.z = pk2(x[4], x[5]); w.w = pk2(x[6], x[7]); }
    else { w.x = pk2(x[8], x[9]); w.y = pk2(x[10], x[11]); w.z = pk2(x[12], x[13]); w.w = pk2(x[14], x[15]); }
    return __builtin_bit_cast(bf16x8, w);
}
constexpr int AT_KP = 272, AT_VP = 144, AT_KB = 64 * AT_KP, AT_VB = 128 * AT_VP, AT_BUF = AT_KB + AT_VB;
constexpr float AT_C1 = 0.125f * 1.4426950408889634f, LOG2E = 1.4426950408889634f;
__device__ __forceinline__ void attn_v2(Frame& F) {
    LAS unsigned char* lds = F.lds;
    LAS float* relb = (LAS float*)(F.lds + 2 * AT_BUF);
    LAS int* qslot = (LAS int*)(relb + 256);
    const bf16* Pq = (const bf16*)(F.ws + WS_P); const bf16* Pk = Pq + PBUF; const bf16* VT = Pq + 2 * PBUF;
    bf16* ya = (bf16*)(F.ws + WS_YA);
    float lam;
    { const float* dl = F.in[6]; float s01 = 0.f, s23 = 0.f;
      for (int d = 0; d < 64; ++d) { s01 += dl[d] * dl[64 + d]; s23 += dl[128 + d] * dl[192 + d]; }
      lam = expf(s01) - expf(s23) + LAMBDA_INIT; }
    for (;;) {
        int tid = F.tid; asm volatile("" : "+v"(tid));
        __syncthreads();
        if (tid == 0) qslot[0] = (int)__hip_atomic_fetch_add(F.ctl + CW_AQ, 1u, RLX_AGENT);
        __syncthreads();
        const int L = qslot[0];
        if (L >= NH * 64) break;
        const int h = L & 7, qb = 63 - (L >> 3), lane = tid & 63, i31 = lane & 31, hh = lane >> 5, sb = F.wave & 3, map = F.wave >> 2;
        const int cw = 2 * qb + (sb >> 1), ntile = 2 * qb + 2;
        if (tid < 256) relb[tid] = F.in[8][t5_bucket(tid - 191) * 8 + h] * LOG2E;
        const int qrow = qb * 128 + 32 * sb + i31;
        bf16x8 qf[4];
#pragma unroll
        for (int ks = 0; ks < 4; ++ks) qf[ks] = *(const GAS bf16x8*)(Pq + (size_t)qrow * 1024 + h * 128 + map * 64 + 16 * ks + 8 * hh);
        const int kr0 = tid >> 4, kc0 = tid & 15, vr0 = tid >> 3, vc0 = tid & 7;
        const bf16* kg = Pk + (size_t)kr0 * 1024 + h * 128 + kc0 * 8;
        const bf16* vg = VT + (size_t)(h * 128 + vr0) * T + vc0 * 8;
        const int klo = kr0 * AT_KP + kc0 * 16, vlo = AT_KB + vr0 * AT_VP + vc0 * 16;
        v4u st[4];
        st[0] = *(const GAS v4u*)kg; st[1] = *(const GAS v4u*)(kg + 32 * 1024); st[2] = *(const GAS v4u*)vg; st[3] = *(const GAS v4u*)(vg + (size_t)64 * T);
        *(LAS v4u*)(lds + klo) = st[0]; *(LAS v4u*)(lds + klo + 32 * AT_KP) = st[1]; *(LAS v4u*)(lds + vlo) = st[2]; *(LAS v4u*)(lds + vlo + 64 * AT_VP) = st[3];
        f32x16 O[4];
#pragma unroll
        for (int db = 0; db < 4; ++db)
#pragma unroll
            for (int r = 0; r < 16; ++r) O[db][r] = 0.f;
        float mrun = -INFINITY, lrun = 0.f;
        __syncthreads();
#pragma unroll 1
        for (int j = 0; j < ntile; ++j) {
            const LAS unsigned char* buf = lds + (j & 1) * AT_BUF;
            if (j + 1 < ntile) { const size_t ko = (size_t)(j + 1) * 64 * 1024; const int vo = (j + 1) * 64;
                st[0] = *(const GAS v4u*)(kg + ko); st[1] = *(const GAS v4u*)(kg + ko + 32 * 1024); st[2] = *(const GAS v4u*)(vg + vo); st[3] = *(const GAS v4u*)(vg + (size_t)64 * T + vo); }
            if (j <= cw) {
                f32x16 S[2]; bf16x8 kf[8], vf[8];
#pragma unroll
                for (int kb = 0; kb < 2; ++kb)
#pragma unroll
                    for (int ks = 0; ks < 4; ++ks) kf[4 * kb + ks] = *(const LAS bf16x8*)(buf + (32 * kb + i31) * AT_KP + map * 128 + (16 * ks + 8 * hh) * 2);
#pragma unroll
                for (int kb = 0; kb < 2; ++kb) {
#pragma unroll
                    for (int r = 0; r < 16; ++r) S[kb][r] = 0.f;
#pragma unroll
                    for (int ks = 0; ks < 4; ++ks) S[kb] = __builtin_amdgcn_mfma_f32_32x32x16_bf16(kf[4 * kb + ks], qf[ks], S[kb], 0, 0, 0); }
#pragma unroll
                for (int db = 0; db < 2; ++db)
#pragma unroll
                    for (int ks = 0; ks < 4; ++ks) vf[4 * db + ks] = *(const LAS bf16x8*)(buf + AT_KB + (32 * db + i31) * AT_VP + (16 * ks + 8 * hh) * 2);
                float tmax = -INFINITY;
                if (j >= cw - 2) { const int rb = (j * 64) - (qb * 128 + 32 * sb + i31) + 191 + 4 * hh;
#pragma unroll
                    for (int kb = 0; kb < 2; ++kb)
#pragma unroll
                        for (int r = 0; r < 16; ++r) { S[kb][r] = S[kb][r] * AT_C1 + relb[rb + 32 * kb + (r & 3) + 8 * (r >> 2)]; tmax = fmaxf(tmax, S[kb][r]); }
                } else { const float bfar = relb[0];
#pragma unroll
                    for (int kb = 0; kb < 2; ++kb)
#pragma unroll
                        for (int r = 0; r < 16; ++r) { S[kb][r] = S[kb][r] * AT_C1 + bfar; tmax = fmaxf(tmax, S[kb][r]); } }
                tmax = fmaxf(tmax, __shfl_xor(tmax, 32));
                if (__any(tmax > mrun + 8.f)) { const float mn = fmaxf(mrun, tmax), corr = __builtin_amdgcn_exp2f(mrun - mn); mrun = mn; lrun *= corr;
#pragma unroll
                    for (int db = 0; db < 4; ++db) O[db] = O[db] * corr; }
                float ps = 0.f;
#pragma unroll
                for (int kb = 0; kb < 2; ++kb)
#pragma unroll
                    for (int r = 0; r < 16; ++r) { S[kb][r] = __builtin_amdgcn_exp2f(S[kb][r] - mrun); ps += S[kb][r]; }
                lrun += ps;
                bf16x8 pf[4];
#pragma unroll
                for (int kb = 0; kb < 2; ++kb) { pf[2 * kb] = cvt8(S[kb], 0); pf[2 * kb + 1] = cvt8(S[kb], 1); }
#pragma unroll
                for (int db = 0; db < 4; ++db) {
#pragma unroll
                    for (int ks = 0; ks < 4; ++ks) O[db] = __builtin_amdgcn_mfma_f32_32x32x16_bf16(vf[4 * (db & 1) + ks], pf[ks], O[db], 0, 0, 0);
                    if (db < 2) {
#pragma unroll
                        for (int ks = 0; ks < 4; ++ks) vf[4 * (db & 1) + ks] = *(const LAS bf16x8*)(buf + AT_KB + (32 * (db + 2) + i31) * AT_VP + (16 * ks + 8 * hh) * 2); } }
            }
            if (j + 1 < ntile) { LAS unsigned char* nb = lds + ((j + 1) & 1) * AT_BUF;
                *(LAS v4u*)(nb + klo) = st[0]; *(LAS v4u*)(nb + klo + 32 * AT_KP) = st[1]; *(LAS v4u*)(nb + vlo) = st[2]; *(LAS v4u*)(nb + vlo + 64 * AT_VP) = st[3]; }
            __syncthreads();
        }
        lrun += __shfl_xor(lrun, 32);
        const float inv = 1.f / lrun;
        LAS float* X = (LAS float*)lds + sb * 4096;
        if (map == 1) {
#pragma unroll
            for (int db = 0; db < 4; ++db)
#pragma unroll
                for (int r = 0; r < 16; ++r) X[(db * 16 + r) * 64 + lane] = O[db][r] * inv; }
        __syncthreads();
        if (map == 0) { float ss = 0.f;
#pragma unroll
            for (int db = 0; db < 4; ++db)
#pragma unroll
                for (int r = 0; r < 16; ++r) { const float a = O[db][r] * inv - lam * X[(db * 16 + r) * 64 + lane]; O[db][r] = a; ss += a * a; }
            ss += __shfl_xor(ss, 32);
            const float rn = rsqrtf(ss * (1.f / 128.f) + NORM_EPS) * (1.f - LAMBDA_INIT);
            bf16* op = ya + (size_t)qrow * 1024 + h * 128 + 4 * hh;
#pragma unroll
            for (int db = 0; db < 4; ++db)
#pragma unroll
                for (int q4 = 0; q4 < 4; ++q4) { const int dv = 32 * db + 8 * q4 + 4 * hh; const f32x4 sw = *(const GAS f32x4*)(F.in[7] + dv);
                    *(GAS v2u*)(op + 32 * db + 8 * q4) = (v2u){pk2(O[db][4 * q4] * rn * sw.x, O[db][4 * q4 + 1] * rn * sw.y), pk2(O[db][4 * q4 + 2] * rn * sw.z, O[db][4 * q4 + 3] * rn * sw.w)}; } }
    }
}

__device__ __forceinline__ int swap23(int x) { return (x & ~12) | ((x & 4) << 1) | ((x & 8) >> 1); }
__device__ __forceinline__ void gdn_prep_v1(Frame& F) {
    LAS float* Ks = (LAS float*)F.lds;
    LAS float* Qs = Ks + 64 * 129;
    LAS float* Vs = Qs + 64 * 129;
    LAS float* As = Vs + 64 * 128;
    LAS float* Tm = As + 64 * 68;
    LAS float* gcs = Tm + 64 * 68;
    LAS float* bts = gcs + 64;
    LAS float* egs = bts + 64;
    const bf16* P3 = (const bf16*)(F.ws + WS_P) + 3 * PBUF;
    const float* gab = (const float*)(F.ws + WS_GAB);
    float* GLg = (float*)(F.ws + WS_GL);
    const int tid = F.tid, lane = F.lane;
    for (int L = blockIdx.x; L < NH * NCHUNK; L += F.G) {
        const int n = L >> 3, h = L & 7, t0 = n * 64;
        __syncthreads();
        for (int idx = tid; idx < 64 * 384; idx += NTHR) { const int t = idx / 384, ch = idx % 384, which = ch >> 7, i = ch & 127, cg = which * 1024 + h * 128 + i;
            const bf16* src = P3 + (size_t)which * PBUF + h * 128 + i; float a = 0.f;
#pragma unroll
            for (int j = 0; j < 4; ++j) { const int tt = t0 + t - 3 + j; if (tt >= 0) a += bf2f(src[(size_t)tt * 1024]) * F.in[2][j * 3072 + cg]; }
            a = siluf_(a);
            if (which == 0) Qs[t * 129 + i] = a; else if (which == 1) Ks[t * 129 + i] = a; else Vs[t * 128 + i] = a; }
        __syncthreads();
        for (int t = F.wave * 8; t < F.wave * 8 + 8; ++t) {
            const float q0 = Qs[t * 129 + lane], q1 = Qs[t * 129 + 64 + lane], k0 = Ks[t * 129 + lane], k1 = Ks[t * 129 + 64 + lane];
            const float rq = rsqrtf(wave_sum(q0 * q0 + q1 * q1) + NORM_EPS) * 0.08838834764831845f, rk = rsqrtf(wave_sum(k0 * k0 + k1 * k1) + NORM_EPS);
            Qs[t * 129 + lane] = q0 * rq; Qs[t * 129 + 64 + lane] = q1 * rq; Ks[t * 129 + lane] = k0 * rk; Ks[t * 129 + 64 + lane] = k1 * rk; }
        if (F.wave == 0) { const int tok = t0 + lane; const float ga = gab[(size_t)tok * 16 + h] + F.in[4][h], gb = gab[(size_t)tok * 16 + 8 + h];
            const float sp = fmaxf(ga, 0.f) + log1pf(expf(-fabsf(ga))); float g = -expf(F.in[3][h]) * sp;
#pragma unroll
            for (int o = 1; o < 64; o <<= 1) { const float v = __shfl_up(g, o); if (lane >= o) g += v; }
            gcs[lane] = g; bts[lane] = 1.f / (1.f + expf(-gb)); egs[lane] = expf(g); }
        __syncthreads();
        for (int idx = tid; idx < 4096; idx += NTHR) { const int c = idx >> 6, s = idx & 63; float kk = 0.f, qk = 0.f;
            if (s <= c) { for (int i = 0; i < 128; ++i) { const float ks = Ks[s * 129 + i]; kk += Ks[c * 129 + i] * ks; qk += Qs[c * 129 + i] * ks; }
                const float dec = expf(gcs[c] - gcs[s]); kk *= dec * bts[c]; qk *= dec; }
            As[c * 68 + s] = (s < c) ? kk : 0.f; ((bf16*)(F.ws + WS_PK + (size_t)(h * NCHUNK + n) * PK_BYTES + PK_AQ))[c * 72 + swap23(s)] = (bf16)f2bf((s <= c) ? qk : 0.f); }
        __syncthreads();
        if (F.wave == 0) {
            for (int i = 0; i < 64; ++i) { float a = (i == lane) ? 1.f : 0.f;
#pragma unroll 4
                for (int j = 0; j < i; ++j) a -= As[i * 68 + j] * Tm[j * 68 + lane];
                Tm[i * 68 + lane] = a; }
        }
        __syncthreads();
        unsigned char* pk = F.ws + WS_PK + (size_t)(h * NCHUNK + n) * PK_BYTES; float* ul = (float*)(F.ws + WS_UL) + (size_t)(h * NCHUNK + n) * 4 * 64 * 32;
        for (int idx = tid; idx < 64 * 256; idx += NTHR) { const int c = idx >> 8, col = idx & 255; float a = 0.f;
            if (col < 128) { for (int s = 0; s <= c; ++s) a += Tm[c * 68 + s] * bts[s] * Vs[s * 128 + col];
                const int cp = c & 31; ul[(((col >> 5) * 64) + (col & 31) + 32 * ((cp >> 2) & 1)) * 32 + (c >> 5) * 16 + (cp & 3) + 4 * (cp >> 3)] = a; }
            else { const int i = col - 128; for (int s = 0; s <= c; ++s) a += Tm[c * 68 + s] * bts[s] * egs[s] * Ks[s * 129 + i];
                ((bf16*)(pk + PK_WN))[c * 136 + swap23(i)] = (bf16)f2bf(-a); } }
        const float glast = gcs[63];
        for (int idx = tid; idx < 64 * 128; idx += NTHR) { const int t = idx >> 7, i = idx & 127;
            ((bf16*)(pk + PK_QD))[t * 136 + swap23(i)] = (bf16)f2bf(Qs[t * 129 + i] * egs[t]);
            ((bf16*)(pk + PK_KDT))[i * 72 + swap23(t)] = (bf16)f2bf(Ks[t * 129 + i] * expf(glast - gcs[t])); }
        if (tid == 0) GLg[L] = expf(glast);
    }
}
__device__ __forceinline__ void gdn_prep_v2(Frame& F) {
    typedef float f32x16_ __attribute__((ext_vector_type(16)));
    LAS bf16* Kb = (LAS bf16*)F.lds;
    LAS bf16* Qb = Kb + 64 * 136;
    LAS bf16* Vt = Qb + 64 * 136;
    LAS bf16* KBt = Vt + 128 * 72;
    LAS float* As = (LAS float*)(KBt + 128 * 72);
    LAS float* Tm = As + 64 * 68;
    LAS float* Tp = Tm + 64 * 68;
    LAS bf16* Tmb = (LAS bf16*)(Tp + 32 * 36);
    LAS float* gcs = (LAS float*)(Tmb + 64 * 72);
    LAS float* bts = gcs + 64;
    LAS float* egs = bts + 64;
    LAS float* eks = egs + 64;
    const bf16* P3 = (const bf16*)(F.ws + WS_P) + 3 * PBUF;
    const float* gab = (const float*)(F.ws + WS_GAB);
    float* GLg = (float*)(F.ws + WS_GL);
    for (int L = blockIdx.x; L < NH * NCHUNK; L += F.G) {
        int tid = F.tid; asm volatile("" : "+v"(tid));
        const int lane = tid & 63, i31 = lane & 31, hh = lane >> 5;
        const int n = L >> 3, h = L & 7, t0 = n * 64;
        unsigned char* pk = F.ws + WS_PK + (size_t)(h * NCHUNK + n) * PK_BYTES; float* ul = (float*)(F.ws + WS_UL) + (size_t)(h * NCHUNK + n) * 4 * 64 * 32;
        __syncthreads();
        if (F.wave == 0) { const int tok = t0 + lane; const float ga = gab[(size_t)tok * 16 + h] + F.in[4][h], gb = gab[(size_t)tok * 16 + 8 + h];
            const float sp = fmaxf(ga, 0.f) + log1pf(expf(-fabsf(ga))); float g = -expf(F.in[3][h]) * sp;
#pragma unroll
            for (int o = 1; o < 64; o <<= 1) { const float v = __shfl_up(g, o); if (lane >= o) g += v; }
            const float glast = __shfl(g, 63);
            gcs[lane] = g; bts[lane] = 1.f / (1.f + expf(-gb)); egs[lane] = expf(g); eks[lane] = expf(glast - g);
            if (lane == 0) GLg[L] = expf(glast); }
        for (int idx = tid; idx < 64 * 68; idx += NTHR) Tm[idx] = 0.f;
        const int seg = tid & 63, trow = tid >> 6, which = seg >> 4, sc = (seg & 15) * 8;
        float ov[8][8];
        if (seg < 48) {
            const int cg = which * 1024 + h * 128 + sc; float cw[4][8];
#pragma unroll
            for (int j = 0; j < 4; ++j) { const f32x4 a = *(const GAS f32x4*)(F.in[2] + j * 3072 + cg), b = *(const GAS f32x4*)(F.in[2] + j * 3072 + cg + 4);
                cw[j][0] = a.x; cw[j][1] = a.y; cw[j][2] = a.z; cw[j][3] = a.w; cw[j][4] = b.x; cw[j][5] = b.y; cw[j][6] = b.z; cw[j][7] = b.w; }
            const bf16* src = P3 + (size_t)which * PBUF + h * 128 + sc; v4u xw[11];
#pragma unroll
            for (int m = 0; m < 11; ++m) { const int tt = t0 + 8 * trow - 3 + m; xw[m] = (v4u){0u, 0u, 0u, 0u}; if (tt >= 0) xw[m] = *(const GAS v4u*)(src + (size_t)tt * 1024); }
#pragma unroll
            for (int ti = 0; ti < 8; ++ti) {
#pragma unroll
                for (int c2 = 0; c2 < 4; ++c2) { float a0 = 0.f, a1 = 0.f;
#pragma unroll
                    for (int j = 0; j < 4; ++j) { const unsigned w = xw[ti + j][c2]; a0 += bflo(w) * cw[j][2 * c2]; a1 += bfhi(w) * cw[j][2 * c2 + 1]; }
                    ov[ti][2 * c2] = siluf_(a0); ov[ti][2 * c2 + 1] = siluf_(a1); } }
        } else {
#pragma unroll
            for (int ti = 0; ti < 8; ++ti)
#pragma unroll
                for (int ch = 0; ch < 8; ++ch) ov[ti][ch] = 0.f; }
#pragma unroll
        for (int ti = 0; ti < 8; ++ti) { float ss = 0.f;
#pragma unroll
            for (int ch = 0; ch < 8; ++ch) ss += ov[ti][ch] * ov[ti][ch];
            ss += __shfl_xor(ss, 1); ss += __shfl_xor(ss, 2); ss += __shfl_xor(ss, 4); ss += __shfl_xor(ss, 8);
            const float rn = which == 0 ? rsqrtf(ss + NORM_EPS) * 0.08838834764831845f : (which == 1 ? rsqrtf(ss + NORM_EPS) : 1.f);
#pragma unroll
            for (int ch = 0; ch < 8; ++ch) ov[ti][ch] *= rn; }
        __syncthreads();
        if (seg < 48) {
            const int a = (sc >> 3) & 1, g16 = sc & ~15;
            if (which == 0) {
#pragma unroll
                for (int ti = 0; ti < 8; ++ti) { const int t = 8 * trow + ti; const float e = egs[t];
                    *(LAS v4u*)(Qb + t * 136 + sc) = (v4u){pk2(ov[ti][0], ov[ti][1]), pk2(ov[ti][2], ov[ti][3]), pk2(ov[ti][4], ov[ti][5]), pk2(ov[ti][6], ov[ti][7])};
                    bf16* qd = (bf16*)(pk + PK_QD) + t * 136 + g16 + 4 * a;
                    *(GAS v2u*)qd = (v2u){pk2(ov[ti][0] * e, ov[ti][1] * e), pk2(ov[ti][2] * e, ov[ti][3] * e)};
                    *(GAS v2u*)(qd + 8) = (v2u){pk2(ov[ti][4] * e, ov[ti][5] * e), pk2(ov[ti][6] * e, ov[ti][7] * e)}; }
            } else if (which == 1) {
                float be[8], ek[8];
#pragma unroll
                for (int ti = 0; ti < 8; ++ti) { const int t = 8 * trow + ti; be[ti] = bts[t] * egs[t]; ek[ti] = eks[t];
                    *(LAS v4u*)(Kb + t * 136 + sc) = (v4u){pk2(ov[ti][0], ov[ti][1]), pk2(ov[ti][2], ov[ti][3]), pk2(ov[ti][4], ov[ti][5]), pk2(ov[ti][6], ov[ti][7])}; }
                const int ta = trow & 1, tg16 = (8 * trow) & ~15;
#pragma unroll
                for (int ch = 0; ch < 8; ++ch) {
                    *(LAS v4u*)(KBt + (sc + ch) * 72 + 8 * trow) = (v4u){pk2(ov[0][ch] * be[0], ov[1][ch] * be[1]), pk2(ov[2][ch] * be[2], ov[3][ch] * be[3]), pk2(ov[4][ch] * be[4], ov[5][ch] * be[5]), pk2(ov[6][ch] * be[6], ov[7][ch] * be[7])};
                    bf16* kd = (bf16*)(pk + PK_KDT) + (sc + ch) * 72 + tg16 + 4 * ta;
                    *(GAS v2u*)kd = (v2u){pk2(ov[0][ch] * ek[0], ov[1][ch] * ek[1]), pk2(ov[2][ch] * ek[2], ov[3][ch] * ek[3])};
                    *(GAS v2u*)(kd + 8) = (v2u){pk2(ov[4][ch] * ek[4], ov[5][ch] * ek[5]), pk2(ov[6][ch] * ek[6], ov[7][ch] * ek[7])}; }
            } else {
                float be[8];
#pragma unroll
                for (int ti = 0; ti < 8; ++ti) be[ti] = bts[8 * trow + ti];
#pragma unroll
                for (int ch = 0; ch < 8; ++ch)
                    *(LAS v4u*)(Vt + (sc + ch) * 72 + 8 * trow) = (v4u){pk2(ov[0][ch] * be[0], ov[1][ch] * be[1]), pk2(ov[2][ch] * be[2], ov[3][ch] * be[3]), pk2(ov[4][ch] * be[4], ov[5][ch] * be[5]), pk2(ov[6][ch] * be[6], ov[7][ch] * be[7])};
            }
        }
        __syncthreads();
        { const int kind = F.wave >> 2, mb = (F.wave >> 1) & 1, nb = F.wave & 1; const LAS bf16* Am = kind ? Qb : Kb; f32x16_ acc;
#pragma unroll
          for (int r = 0; r < 16; ++r) acc[r] = 0.f;
#pragma unroll
          for (int ks = 0; ks < 8; ++ks) { const bf16x8 a = *(const LAS bf16x8*)(Am + (32 * mb + i31) * 136 + 16 * ks + 8 * hh), b = *(const LAS bf16x8*)(Kb + (32 * nb + i31) * 136 + 16 * ks + 8 * hh);
              acc = __builtin_amdgcn_mfma_f32_32x32x16_bf16(a, b, acc, 0, 0, 0); }
          const int s = 32 * nb + i31; const float gs = gcs[s];
#pragma unroll
          for (int r = 0; r < 16; ++r) { const int c = 32 * mb + (r & 3) + 8 * (r >> 2) + 4 * hh; const float dec = expf(s <= c ? gcs[c] - gs : 0.f);
              if (kind == 0) As[c * 68 + s] = (s < c) ? bts[c] * acc[r] * dec : 0.f;
              else ((bf16*)(pk + PK_AQ))[c * 72 + swap23(s)] = (bf16)f2bf((s <= c) ? acc[r] * dec : 0.f); } }
        __syncthreads();
        if (F.wave < 4 && lane < 16) { const int b0 = 16 * F.wave; float tc[16];
#pragma unroll
            for (int i = 0; i < 16; ++i) { float a = (i == lane) ? 1.f : 0.f;
#pragma unroll
                for (int m = 0; m < i; ++m) a -= As[(b0 + i) * 68 + b0 + m] * tc[m];
                tc[i] = a; Tm[(b0 + i) * 68 + b0 + lane] = a; } }
        __syncthreads();
        { const int p = tid >> 8, o = tid & 255, r = o >> 4, cc = o & 15, rb = 16 + 32 * p, cbs = 32 * p; float a = 0.f;
#pragma unroll
          for (int m = 0; m < 16; ++m) a += As[(rb + r) * 68 + cbs + m] * Tm[(cbs + m) * 68 + cbs + cc];
          Tp[p * 256 + o] = a;
          __syncthreads();
          float b = 0.f;
#pragma unroll
          for (int m = 0; m < 16; ++m) b += Tm[(rb + r) * 68 + rb + m] * Tp[p * 256 + m * 16 + cc];
          __syncthreads();
          Tm[(rb + r) * 68 + cbs + cc] = -b; }
        __syncthreads();
        { float a[2];
#pragma unroll
          for (int q = 0; q < 2; ++q) { const int o = tid + 512 * q, r = o >> 5, cc = o & 31; a[q] = 0.f;
#pragma unroll 8
              for (int m = 0; m < 32; ++m) a[q] += As[(32 + r) * 68 + m] * Tm[m * 68 + cc]; }
          __syncthreads();
#pragma unroll
          for (int q = 0; q < 2; ++q) { const int o = tid + 512 * q; Tp[(o >> 5) * 36 + (o & 31)] = a[q]; }
          __syncthreads();
#pragma unroll
          for (int q = 0; q < 2; ++q) { const int o = tid + 512 * q, r = o >> 5, cc = o & 31; a[q] = 0.f;
#pragma unroll 8
              for (int m = 0; m < 32; ++m) a[q] += Tm[(32 + r) * 68 + 32 + m] * Tp[m * 36 + cc]; }
#pragma unroll
          for (int q = 0; q < 2; ++q) { const int o = tid + 512 * q; Tm[(32 + (o >> 5)) * 68 + (o & 31)] = -a[q]; } }
        __syncthreads();
        for (int idx = tid; idx < 64 * 32; idx += NTHR) { const int c = idx >> 5, s2 = (idx & 31) * 2; *(LAS unsigned*)(Tmb + c * 72 + s2) = pk2(Tm[c * 68 + s2], Tm[c * 68 + s2 + 1]); }
        __syncthreads();
        if (F.wave < 4) { const int cb = F.wave;
#pragma unroll
            for (int mb = 0; mb < 2; ++mb) { f32x16_ acc;
#pragma unroll
                for (int r = 0; r < 16; ++r) acc[r] = 0.f;
#pragma unroll
                for (int ks = 0; ks < 4; ++ks) { const bf16x8 a = *(const LAS bf16x8*)(Tmb + (32 * mb + i31) * 72 + 16 * ks + 8 * hh), b = *(const LAS bf16x8*)(Vt + (32 * cb + i31) * 72 + 16 * ks + 8 * hh);
                    acc = __builtin_amdgcn_mfma_f32_32x32x16_bf16(a, b, acc, 0, 0, 0); }
                float* up = ul + (cb * 64 + lane) * 32 + mb * 16;
#pragma unroll
                for (int q = 0; q < 4; ++q) *(GAS f32x4*)(up + 4 * q) = (f32x4){acc[4 * q], acc[4 * q + 1], acc[4 * q + 2], acc[4 * q + 3]}; }
        } else { const int db = F.wave - 4;
#pragma unroll
            for (int nb = 0; nb < 2; ++nb) { f32x16_ acc;
#pragma unroll
                for (int r = 0; r < 16; ++r) acc[r] = 0.f;
#pragma unroll
                for (int ks = 0; ks < 4; ++ks) { const bf16x8 a = *(const LAS bf16x8*)(KBt + (32 * db + i31) * 72 + 16 * ks + 8 * hh), b = *(const LAS bf16x8*)(Tmb + (32 * nb + i31) * 72 + 16 * ks + 8 * hh);
                    acc = __builtin_amdgcn_mfma_f32_32x32x16_bf16(a, b, acc, 0, 0, 0); }
                bf16* wp = (bf16*)(pk + PK_WN) + (32 * nb + i31) * 136 + 32 * db + 8 * hh;
#pragma unroll
                for (int q = 0; q < 4; ++q) *(GAS v2u*)(wp + 16 * (q >> 1) + 4 * (q & 1)) = (v2u){pk2(-acc[4 * q], -acc[4 * q + 1]), pk2(-acc[4 * q + 2], -acc[4 * q + 3])}; }
        }
    }
}
__device__ __forceinline__ void gdn_scan_helper(Frame& F) {
    const int hb = blockIdx.x - 8; if (hb < 0 || hb >= 16) return;
    const int h = hb & 7, par = hb >> 3;
    const unsigned char* PK = F.ws + WS_PK + (size_t)(h * NCHUNK) * PK_BYTES + F.tid * 16;
#pragma unroll 1
    for (int n = par; n < NCHUNK; n += 2) {
        if (n > 8) { unsigned spin = 0; while ((int)__hip_atomic_load(F.ctl + CW_SP + 64 * h, RLX_AGENT) + 8 < n && ++spin < (1u << 16)) __builtin_amdgcn_s_sleep(8); }
        v4u x[8];
#pragma unroll
        for (int q = 0; q < 8; ++q) x[q] = *(const GAS v4u*)(PK + (size_t)n * PK_BYTES + q * 8192);
#pragma unroll
        for (int q = 0; q < 8; ++q) asm volatile("" :: "v"(x[q]));
    }
}
__device__ __forceinline__ void gdn_scan_v2(Frame& F) {
    if (blockIdx.x >= 8) return;
    const int h = blockIdx.x, lane = F.lane;
    const unsigned char* PK = F.ws + WS_PK + (size_t)(h * NCHUNK) * PK_BYTES;
    if (F.wave >= 4) {
        const int lw = F.wave - 4;
        bf16* ogb = (bf16*)(F.ws + WS_OG) + h * 128;
#pragma unroll 1
        for (int n = -1; n <= NCHUNK; ++n) {
            if (n + 1 < NCHUNK) { const unsigned char* src = PK + (size_t)(n + 1) * PK_BYTES + lane * 16; LAS unsigned char* dst = F.lds + ((n + 1) & 1) * PKL;
#pragma unroll
                for (int q = 0; q < 16; ++q) { const int p = lw + 4 * q; if (p < 61) __builtin_amdgcn_global_load_lds((const unsigned*)(src + p * 1024), (LAS unsigned*)(dst + p * 1024), 16, 0, 0); } }
            if (n >= 1) { const LAS unsigned char* ost = F.lds + OST_OFF + ((n - 1) & 1) * OST_BYTES;
#pragma unroll
                for (int it = 0; it < 4; ++it) { const int id = it * 64 + lane, row = 16 * lw + (id >> 4), c16 = id & 15;
                    const v4u v = *(const LAS v4u*)(ost + row * OST_P + c16 * 16);
                    *(GAS v4u*)(ogb + (size_t)((n - 1) * 64 + row) * 1024 + c16 * 8) = v; } }
            if (n == NCHUNK) break;
            asm volatile("s_waitcnt vmcnt(0) lgkmcnt(0)" ::: "memory"); __builtin_amdgcn_s_barrier(); asm volatile("" ::: "memory");
        }
    } else {
        const int cb = F.wave, i31 = lane & 31, hh = lane >> 5;
        const float* GLg = (const float*)(F.ws + WS_GL);
        const float* ul = (const float*)(F.ws + WS_UL) + ((size_t)(h * NCHUNK) * 4 + cb) * 64 * 32 + lane * 32;
        f32x16 S[4], vn[2], O[2];
#pragma unroll
        for (int b = 0; b < 4; ++b)
#pragma unroll
            for (int r = 0; r < 16; ++r) S[b][r] = 0.f;
#pragma unroll
        for (int mb = 0; mb < 2; ++mb)
#pragma unroll
            for (int q = 0; q < 4; ++q) { const f32x4 v = *(const GAS f32x4*)(ul + mb * 16 + 4 * q); vn[mb][4 * q] = v.x; vn[mb][4 * q + 1] = v.y; vn[mb][4 * q + 2] = v.z; vn[mb][4 * q + 3] = v.w; }
        __builtin_amdgcn_s_barrier(); asm volatile("" ::: "memory");
#pragma unroll 1
        for (int n = 0; n < NCHUNK; ++n) {
            const LAS unsigned char* buf = F.lds + (n & 1) * PKL;
            const LAS unsigned char* a136 = buf + i31 * 272 + hh * 16;
            const LAS unsigned char* a72 = buf + i31 * 144 + hh * 16;
            bf16x8 sf[8], fa[8], fb[8];
#define SC_LD136(dst, off, mb) do { _Pragma("unroll") for (int ks = 0; ks < 8; ++ks) dst[ks] = *(const LAS bf16x8*)(a136 + (off) + (mb) * 32 * 272 + ks * 32); } while (0)
            SC_LD136(fa, PK_WN, 0); SC_LD136(fb, PK_WN, 1);
#pragma unroll
            for (int b = 0; b < 4; ++b) { sf[2 * b] = cvt8(S[b], 0); sf[2 * b + 1] = cvt8(S[b], 1); }
#pragma unroll
            for (int ks = 0; ks < 8; ++ks) vn[0] = __builtin_amdgcn_mfma_f32_32x32x16_bf16(fa[ks], sf[ks], vn[0], 0, 0, 0);
            SC_LD136(fa, PK_QD, 0);
#pragma unroll
            for (int ks = 0; ks < 8; ++ks) vn[1] = __builtin_amdgcn_mfma_f32_32x32x16_bf16(fb[ks], sf[ks], vn[1], 0, 0, 0);
            SC_LD136(fb, PK_QD, 1);
#pragma unroll
            for (int mb = 0; mb < 2; ++mb)
#pragma unroll
                for (int r = 0; r < 16; ++r) O[mb][r] = 0.f;
#pragma unroll
            for (int ks = 0; ks < 8; ++ks) O[0] = __builtin_amdgcn_mfma_f32_32x32x16_bf16(fa[ks], sf[ks], O[0], 0, 0, 0);
#pragma unroll
            for (int q = 0; q < 8; ++q) fa[q] = *(const LAS bf16x8*)(a72 + PK_AQ + (q >> 2) * 32 * 144 + (q & 3) * 32);
#pragma unroll
            for (int ks = 0; ks < 8; ++ks) O[1] = __builtin_amdgcn_mfma_f32_32x32x16_bf16(fb[ks], sf[ks], O[1], 0, 0, 0);
#pragma unroll
            for (int q = 0; q < 8; ++q) fb[q] = *(const LAS bf16x8*)(a72 + PK_KDT + (q >> 2) * 32 * 144 + (q & 3) * 32);
            bf16x8 vf[4];
#pragma unroll
            for (int mb = 0; mb < 2; ++mb) { vf[2 * mb] = cvt8(vn[mb], 0); vf[2 * mb + 1] = cvt8(vn[mb], 1); }
            if (n + 1 < NCHUNK) { const float* un = ul + (size_t)(n + 1) * 4 * 64 * 32;
#pragma unroll
                for (int mb = 0; mb < 2; ++mb)
#pragma unroll
                    for (int q = 0; q < 4; ++q) { const f32x4 v = *(const GAS f32x4*)(un + mb * 16 + 4 * q); vn[mb][4 * q] = v.x; vn[mb][4 * q + 1] = v.y; vn[mb][4 * q + 2] = v.z; vn[mb][4 * q + 3] = v.w; } }
#pragma unroll
            for (int q = 0; q < 8; ++q) O[q >> 2] = __builtin_amdgcn_mfma_f32_32x32x16_bf16(fa[q], vf[q & 3], O[q >> 2], 0, 0, 0);
#pragma unroll
            for (int q = 0; q < 8; ++q) fa[q] = *(const LAS bf16x8*)(a72 + PK_KDT + (2 + (q >> 2)) * 32 * 144 + (q & 3) * 32);
            const float gl = GLg[n * 8 + h];
            if (cb == 0 && lane == 0) __hip_atomic_store(F.ctl + CW_SP + 64 * h, (unsigned)(n + 1), RLX_AGENT);
#pragma unroll
            for (int b = 0; b < 2; ++b) { S[b] = S[b] * gl;
#pragma unroll
                for (int ks = 0; ks < 4; ++ks) S[b] = __builtin_amdgcn_mfma_f32_32x32x16_bf16(fb[4 * b + ks], vf[ks], S[b], 0, 0, 0); }
            { LAS bf16* ost = (LAS bf16*)(F.lds + OST_OFF + (n & 1) * OST_BYTES) + cb * 32 + i31;
#pragma unroll
              for (int mb = 0; mb < 2; ++mb)
#pragma unroll
                  for (int r = 0; r < 16; ++r) ost[(32 * mb + (r & 3) + 8 * (r >> 2) + 4 * hh) * (OST_P / 2)] = (bf16)(pk2(O[mb][r], 0.f) & 0xffffu); }
#pragma unroll
            for (int b = 2; b < 4; ++b) { S[b] = S[b] * gl;
#pragma unroll
                for (int ks = 0; ks < 4; ++ks) S[b] = __builtin_amdgcn_mfma_f32_32x32x16_bf16(fa[4 * (b - 2) + ks], vf[ks], S[b], 0, 0, 0); }
#undef SC_LD136
            asm volatile("s_waitcnt lgkmcnt(0)" ::: "memory"); __builtin_amdgcn_s_barrier(); asm volatile("" ::: "memory");
        }
    }
}
__device__ __forceinline__ void gdn_norm(Frame& F) {
    const bf16* og = (const bf16*)(F.ws + WS_OG); const bf16* Pz = (const bf16*)(F.ws + WS_P) + 6 * PBUF; bf16* yb = (bf16*)(F.ws + WS_YB);
    const int lane = F.lane, col = lane * 16;
    for (int tok = F.vcu * NWAVES + F.wave; tok < T; tok += F.G * NWAVES) {
        const size_t o = (size_t)tok * 1024 + col; float v[16], ss = 0.f;
        { const v4u x0 = *(const GAS v4u*)(og + o), x1 = *(const GAS v4u*)(og + o + 8); const unsigned xw[8] = {x0.x, x0.y, x0.z, x0.w, x1.x, x1.y, x1.z, x1.w};
#pragma unroll
          for (int q = 0; q < 8; ++q) { v[2 * q] = bflo(xw[q]); v[2 * q + 1] = bfhi(xw[q]); ss += v[2 * q] * v[2 * q] + v[2 * q + 1] * v[2 * q + 1]; } }
        ss += __shfl_xor(ss, 1); ss += __shfl_xor(ss, 2); ss += __shfl_xor(ss, 4);
        const float r = rsqrtf(ss * (1.f / 128.f) + NORM_EPS);
        const v4u z0 = *(const GAS v4u*)(Pz + o), z1 = *(const GAS v4u*)(Pz + o + 8);
        const float zz[16] = {bflo(z0.x), bfhi(z0.x), bflo(z0.y), bfhi(z0.y), bflo(z0.z), bfhi(z0.z), bflo(z0.w), bfhi(z0.w), bflo(z1.x), bfhi(z1.x), bflo(z1.y), bfhi(z1.y), bflo(z1.z), bfhi(z1.z), bflo(z1.w), bfhi(z1.w)};
        unsigned w[8];
#pragma unroll
        for (int x = 0; x < 8; ++x) { const int c0 = (col & 127) + 2 * x; w[x] = pk2(v[2 * x] * r * F.in[5][c0] * siluf_(zz[2 * x]), v[2 * x + 1] * r * F.in[5][c0 + 1] * siluf_(zz[2 * x + 1])); }
        *(GAS v4u*)(yb + o) = (v4u){w[0], w[1], w[2], w[3]}; *(GAS v4u*)(yb + o + 8) = (v4u){w[4], w[5], w[6], w[7]};
    }
}

__device__ __forceinline__ void ln_router(Frame& F) {
    constexpr int XS = 2052;
    LAS float* X1s = (LAS float*)F.lds;
    LAS float* LG = (LAS float*)(F.lds + 131584);
    LAS int* hist = (LAS int*)(LG + 1024);
    LAS int* gbs = hist + 64;
    const float* y1 = (const float*)(F.ws + WS_Y1); float* x1f = (float*)(F.ws + WS_X1F); bf16* x1b = (bf16*)(F.ws + WS_X1B);
    int* tokl = (int*)(F.ws + WS_TOKL); float* wgtl = (float*)(F.ws + WS_WGTL); unsigned* info = (unsigned*)(F.ws + WS_INFO);
    const float* g1 = F.in[12]; const float* b1 = F.in[13]; const float* wr = F.in[14]; const float* rb = F.in[15];
    const int tid = F.tid, lane = F.lane;
    for (int blk = blockIdx.x; blk < T / 16; blk += F.G) {
        const int tb = blk * 16;
        __syncthreads();
        if (tid < 64) hist[tid] = 0;
        for (int rep8 = 0; rep8 < (DUP_PHASE == 8 ? 2 : 1); ++rep8) { if (rep8) __syncthreads();
#pragma unroll 1
        for (int tt = 0; tt < 2; ++tt) { const int tl = F.wave * 2 + tt, tok = tb + tl;
            const GAS f32x4* yr = (const GAS f32x4*)(y1 + (size_t)tok * D) + lane; f32x4 v[8]; float s = 0.f;
#pragma unroll
            for (int j = 0; j < 8; ++j) { v[j] = yr[64 * j]; s += (v[j].x + v[j].y) + (v[j].z + v[j].w); }
            const float mean = wave_sum(s) * (1.f / D); float s2 = 0.f;
#pragma unroll
            for (int j = 0; j < 8; ++j) { v[j] = v[j] - mean; s2 += (v[j].x * v[j].x + v[j].y * v[j].y) + (v[j].z * v[j].z + v[j].w * v[j].w); }
            const float rstd = rsqrtf(wave_sum(s2) * (1.f / D) + LN_EPS);
#pragma unroll
            for (int j = 0; j < 8; ++j) { const int col = j * 256 + lane * 4; const f32x4 gg = *(const GAS f32x4*)(g1 + col), bb = *(const GAS f32x4*)(b1 + col);
                const f32x4 xo = v[j] * rstd * gg + bb;
                *(GAS f32x4*)(x1f + (size_t)tok * D + col) = xo; *(GAS v2u*)(x1b + (size_t)tok * D + col) = (v2u){pk2(xo.x, xo.y), pk2(xo.z, xo.w)};
                *(LAS f32x4*)(X1s + tl * XS + col) = xo; }
            if (lane == 0) { tokl[NE * T + tok] = tok; wgtl[NE * T + tok] = 1.f; } }
        __syncthreads();
        { const int eg = lane & 15, tg = lane >> 4; f32x4 acc[4];
#pragma unroll
          for (int ti = 0; ti < 4; ++ti) acc[ti] = (f32x4){0.f, 0.f, 0.f, 0.f};
          const float* wp = wr + (size_t)(256 * F.wave) * NE + 4 * eg; const LAS float* xp = X1s + (4 * tg) * XS + 256 * F.wave;
#pragma unroll 4
          for (int d0 = 0; d0 < 256; d0 += 4) { f32x4 xv[4], wv[4];
#pragma unroll
              for (int dd = 0; dd < 4; ++dd) wv[dd] = *(const GAS f32x4*)(wp + (size_t)(d0 + dd) * NE);
#pragma unroll
              for (int ti = 0; ti < 4; ++ti) xv[ti] = *(const LAS f32x4*)(xp + ti * XS + d0);
#pragma unroll
              for (int ti = 0; ti < 4; ++ti) { acc[ti] = acc[ti] + wv[0] * xv[ti].x; acc[ti] = acc[ti] + wv[1] * xv[ti].y; acc[ti] = acc[ti] + wv[2] * xv[ti].z; acc[ti] = acc[ti] + wv[3] * xv[ti].w; } }
          __syncthreads();
#pragma unroll
          for (int ti = 0; ti < 4; ++ti) *(LAS f32x4*)(X1s + ((F.wave * 16 + 4 * tg + ti) * 64 + 4 * eg)) = acc[ti];
          __syncthreads();
          { const int o = tid * 2; float a0 = 0.f, a1 = 0.f;
#pragma unroll
            for (int w = 0; w < 8; ++w) { const f32x2 p = *(const LAS f32x2*)(X1s + w * 1024 + o); a0 += p.x; a1 += p.y; }
            LG[o] = a0; LG[o + 1] = a1; } }
        __syncthreads();
        }
        bool sel[2]; int loc[2]; float wsl[2]; unsigned long long msk[2];
#pragma unroll
        for (int tt = 0; tt < 2; ++tt) { const int tl = F.wave * 2 + tt;
            const float score = 1.f / (1.f + expf(-LG[tl * 64 + lane])), ch = score + rb[lane];
            int rk = 0;
#pragma unroll
            for (int x = 1; x < 8; ++x) { const float cj = __shfl_xor(ch, x); rk += (cj > ch || (cj == ch && (lane ^ x) < lane)) ? 1 : 0; }
            float gs = rk < 2 ? ch : 0.f; gs += __shfl_xor(gs, 1); gs += __shfl_xor(gs, 2); gs += __shfl_xor(gs, 4);
            const int g = lane >> 3; int grk = 0;
#pragma unroll
            for (int x = 1; x < 8; ++x) { const float gj = __shfl_xor(gs, 8 * x); grk += (gj > gs || (gj == gs && (g ^ x) < g)) ? 1 : 0; }
            const float mk = grk < 4 ? ch : -INFINITY; int erk = 0;
#pragma unroll
            for (int j = 0; j < 64; ++j) { const float mj = __builtin_bit_cast(float, __builtin_amdgcn_readlane(__builtin_bit_cast(int, mk), j)); erk += (mj > mk || (mj == mk && j < lane)) ? 1 : 0; }
            sel[tt] = (grk < 4) && (erk < TOPK);
            const float ssum = wave_sum(sel[tt] ? score : 0.f); wsl[tt] = score / ssum * ROUTED_SCALE;
            msk[tt] = __ballot(sel[tt]);
            loc[tt] = sel[tt] ? atomicAdd((int*)&hist[lane], 1) : 0; }
        __syncthreads();
        if (tid < 64) { const int hc = hist[tid]; gbs[tid] = hc ? (int)__hip_atomic_fetch_add(F.ctl + CW_CNT + 64 * tid, (unsigned)hc, RLX_AGENT) : 0; }
        __syncthreads();
#pragma unroll
        for (int tt = 0; tt < 2; ++tt) if (sel[tt]) { const int tok = tb + F.wave * 2 + tt, slot = gbs[lane] + loc[tt];
            tokl[lane * T + slot] = tok; wgtl[lane * T + slot] = wsl[tt];
            const int k = __popcll(msk[tt] & ((1ull << lane) - 1ull)); info[tok * 8 + k] = ((unsigned)lane << 16) | (unsigned)slot; info[T * 8 + tok * 8 + k] = __builtin_bit_cast(unsigned, wsl[tt]); }
    }
}
__device__ __forceinline__ void final_ln(Frame& F) {
    moe_tables(F, 0, 0);
    const LAS int* rbase = (const LAS int*)(F.lds + LDS_TAB) + 72;
    const float* x1f = (const float*)(F.ws + WS_X1F); const bf16* yas = (const bf16*)(F.ws + WS_YAS); const unsigned* info = (const unsigned*)(F.ws + WS_INFO);
    const float* g2 = F.in[22]; const float* b2 = F.in[23];
    const int lane = F.lane;
    for (int tok = F.vcu * NWAVES + F.wave; tok < T; tok += F.G * NWAVES) {
        f32x4 v[8];
        const GAS f32x4* xr = (const GAS f32x4*)(x1f + (size_t)tok * D) + lane;
#pragma unroll
        for (int j = 0; j < 8; ++j) v[j] = xr[64 * j] * ALPHA;
        const v4u i0 = *(const GAS v4u*)(info + tok * 8), i1 = *(const GAS v4u*)(info + tok * 8 + 4);
        const unsigned iw[8] = {i0.x, i0.y, i0.z, i0.w, i1.x, i1.y, i1.z, i1.w};
        int rows[9];
#pragma unroll
        for (int k = 0; k < 8; ++k) rows[k] = rbase[iw[k] >> 16] + (int)(iw[k] & 0xffffu);
        rows[8] = 65536 + tok;
        const v4u g0 = *(const GAS v4u*)(info + T * 8 + tok * 8), g1 = *(const GAS v4u*)(info + T * 8 + tok * 8 + 4);
        const float gw[9] = {__builtin_bit_cast(float, g0.x), __builtin_bit_cast(float, g0.y), __builtin_bit_cast(float, g0.z), __builtin_bit_cast(float, g0.w), __builtin_bit_cast(float, g1.x), __builtin_bit_cast(float, g1.y), __builtin_bit_cast(float, g1.z), __builtin_bit_cast(float, g1.w), 1.f};
#pragma unroll
        for (int kb = 0; kb < 3; ++kb) { v2u w[3][8];
#pragma unroll
            for (int kk = 0; kk < 3; ++kk) { const GAS v2u* yr = (const GAS v2u*)(yas + (size_t)rows[3 * kb + kk] * D) + lane;
#pragma unroll
                for (int j = 0; j < 8; ++j) w[kk][j] = yr[64 * j]; }
#pragma unroll
            for (int kk = 0; kk < 3; ++kk)
#pragma unroll
                for (int j = 0; j < 8; ++j) v[j] = v[j] + (f32x4){bflo(w[kk][j].x), bfhi(w[kk][j].x), bflo(w[kk][j].y), bfhi(w[kk][j].y)}; }
        float s = 0.f;
#pragma unroll
        for (int j = 0; j < 8; ++j) s += (v[j].x + v[j].y) + (v[j].z + v[j].w);
        const float mean = wave_sum(s) * (1.f / D); float s2 = 0.f;
#pragma unroll
        for (int j = 0; j < 8; ++j) { v[j] = v[j] - mean; s2 += (v[j].x * v[j].x + v[j].y * v[j].y) + (v[j].z * v[j].z + v[j].w * v[j].w); }
        const float rstd = rsqrtf(wave_sum(s2) * (1.f / D) + LN_EPS);
#pragma unroll
        for (int j = 0; j < 8; ++j) { const int col = j * 256 + lane * 4; const f32x4 gg = *(const GAS f32x4*)(g2 + col), bb = *(const GAS f32x4*)(b2 + col);
            *(GAS f32x4*)(F.out + (size_t)tok * D + col) = v[j] * rstd * gg + bb; }
    }
}

struct Args { const float* in[24]; float* out; unsigned char* ws; int ph_lo, ph_hi; };
__global__ void __launch_bounds__(NTHR, 2) fwd(Args args) {
    extern __shared__ __attribute__((aligned(16))) unsigned char lds[];
    Frame F;
    F.lds = (LAS unsigned char*)lds;
    F.tid = threadIdx.x; F.lane = F.tid & 63; F.wave = __builtin_amdgcn_readfirstlane(F.tid >> 6);
    F.G = gridDim.x; { const int bx = blockIdx.x; F.vcu = (F.G % 8 == 0) ? (bx % 8) * (F.G / 8) + bx / 8 : bx; }
    F.ws = args.ws; F.ctl = (gu32*)(args.ws + WS_CTL); F.out = args.out;
#pragma unroll
    for (int i = 0; i < 24; ++i) F.in[i] = args.in[i];
    volatile LAS unsigned* MISC = (volatile LAS unsigned*)(F.lds + MISC_OFF);
    if (F.tid < 64) MISC[F.tid] = 0u;
    __syncthreads();
    const int lo = args.ph_lo, hi = args.ph_hi;
    const bool multi = (hi - lo) > 1;
    XcdBarrier bar; bar.bar = (unsigned*)(F.ctl + CW_BAR); bar.x = 0; bar.st = nullptr;
    if (multi) bar = xcd_barrier_post((unsigned*)(F.ctl + CW_BAR), MISC + 8);
#ifndef ONLY_PHASE
#define ONLY_PHASE -1
#endif
#define IN(k) ((ONLY_PHASE < 0 || ONLY_PHASE == (k)) && lo <= (k) && (k) < hi)
#define SEAM(k) do { if (IN(k) && IN((k) + 1)) xcd_barrier(bar); } while (0)
    unsigned char* ws = args.ws;
#define DUPBAR() do { VM_WAIT(); if (multi) xcd_barrier(bar); else __syncthreads(); } while (0)
    if (IN(0)) { p0_prologue(F); if (DUP_PHASE == 0) { __syncthreads(); p0_prologue(F); } SEAM(0); }
    if (IN(1)) {

        pg8::Gemm g{(const bf16*)(ws + WS_XB), (const bf16*)(ws + WS_WIN), T, NPROJ, D}; pg8::StaticOrder S; S.init(T, NPROJ, F.G, (int)blockIdx.x);
        EpiProj E{(bf16*)(ws + WS_P)};
        pg8::gemm_phase<EpiProj, pg8::StaticOrder, true, false>(F.lds, g, S, E);
        if (DUP_PHASE == 1) { VM_WAIT(); __syncthreads(); pg8::gemm_phase<EpiProj, pg8::StaticOrder, true, false>(F.lds, g, S, E); }
        SEAM(1);
    }
    if (IN(2)) { gdn_prep_v2(F); if (DUP_PHASE == 2) { __syncthreads(); gdn_prep_v2(F); } SEAM(2); }
    if (IN(3)) { gdn_scan_v2(F); gdn_scan_helper(F); __syncthreads(); attn_v2(F); SEAM(3); }
    if (IN(4)) { gdn_norm(F); if (DUP_PHASE == 4) { __syncthreads(); gdn_norm(F); } SEAM(4); }
    if (IN(6)) {

        { pg8::Gemm g{(const bf16*)(ws + WS_YA), (const bf16*)(ws + WS_WA), T, D, 1024}; pg8::StaticOrder S; S.init(T, D, F.G, (int)blockIdx.x);
          EpiBranch<0> E{(const bf16*)(ws + WS_P) + 7 * PBUF, (float*)(ws + WS_TMP), (bf16*)(ws + WS_MRG)};
          pg8::gemm_phase<EpiBranch<0>, pg8::StaticOrder, true, false>(F.lds, g, S, E); }
        VM_WAIT(); __syncthreads();
        { pg8::Gemm g{(const bf16*)(ws + WS_YB), (const bf16*)(ws + WS_WB), T, D, 1024}; pg8::StaticOrder S; S.init(T, D, F.G, (int)blockIdx.x);
          EpiBranch<1> E{(const bf16*)(ws + WS_P) + 9 * PBUF, (float*)(ws + WS_TMP), (bf16*)(ws + WS_MRG)};
          pg8::gemm_phase<EpiBranch<1>, pg8::StaticOrder, true, false>(F.lds, g, S, E); }
        SEAM(6);
    }
    if (IN(7)) {

        pg8::Gemm g{(const bf16*)(ws + WS_MRG), (const bf16*)(ws + WS_WO), T, D, D}; pg8::StaticOrder S; S.init(T, D, F.G, (int)blockIdx.x);
        EpiOut E{F.in[0], (float*)(ws + WS_Y1)};
        pg8::gemm_phase<EpiOut, pg8::StaticOrder, true, false>(F.lds, g, S, E);
        if (DUP_PHASE == 7) { VM_WAIT(); __syncthreads(); pg8::gemm_phase<EpiOut, pg8::StaticOrder, true, false>(F.lds, g, S, E); }
        SEAM(7);
    }
    if (IN(8)) { ln_router(F); SEAM(8); }
    if (IN(9)) {

        moe_tables(F, 4, 1024);
        MoeOrder S{(const LAS int*)(F.lds + LDS_TAB + 1024), (const int*)(ws + WS_TOKL)};
        pg8::Gemm g{(const bf16*)(ws + WS_X1B), (const bf16*)(ws + WS_WGU), T, 1024, D};
        EpiGU E{(bf16*)(ws + WS_HB)};
        pg8::gemm_phase<EpiGU, MoeOrder, true, true>(F.lds, g, S, E);
        if (DUP_PHASE == 9) { VM_WAIT(); __syncthreads(); pg8::gemm_phase<EpiGU, MoeOrder, true, true>(F.lds, g, S, E); }
        SEAM(9);
    }
    if (IN(10)) {

        moe_tables(F, 8, D);
        MoeOrder S{(const LAS int*)(F.lds + LDS_TAB + 1024), (const int*)(ws + WS_TOKL)};
        pg8::Gemm g{(const bf16*)(ws + WS_HB), (const bf16*)(ws + WS_WD), T, D, FF};
        EpiDown E{(bf16*)(ws + WS_YAS), (const float*)(ws + WS_WGTL)};
        pg8::gemm_phase<EpiDown, MoeOrder, true, false>(F.lds, g, S, E);
        if (DUP_PHASE == 10) { VM_WAIT(); __syncthreads(); pg8::gemm_phase<EpiDown, MoeOrder, true, false>(F.lds, g, S, E); }
        SEAM(10);
    }
    if (IN(11)) { final_ln(F); if (DUP_PHASE == 11) { VM_WAIT(); __syncthreads(); final_ln(F); } }
#undef IN
#undef SEAM
}

extern "C" void kernel_launch(void* const* d_in, const int* in_sizes, int n_in, void* d_out, int out_size, void* d_ws, size_t ws_size, hipStream_t stream) {
    static int grid = 0;
    if (grid == 0) {
        if (n_in != 24 || in_sizes[0] != T * D || out_size != T * D || ws_size < WS_END) { fprintf(stderr, "kernel_launch: unexpected shapes (n_in %d, ws %zu); nothing launched\n", n_in, ws_size); grid = -1; return; }
        int dev = 0, cus = 0, per_cu = 0;
        if (hipGetDevice(&dev) != hipSuccess || hipDeviceGetAttribute(&cus, hipDeviceAttributeMultiprocessorCount, dev) != hipSuccess) { grid = -1; return; }
        if (hipFuncSetAttribute((const void*)fwd, hipFuncAttributeMaxDynamicSharedMemorySize, LDS_BYTES) != hipSuccess) { fprintf(stderr, "kernel_launch: hipFuncSetAttribute failed\n"); grid = -1; return; }
        if (hipOccupancyMaxActiveBlocksPerMultiprocessor(&per_cu, (const void*)fwd, NTHR, LDS_BYTES) != hipSuccess || per_cu < 1) { fprintf(stderr, "kernel_launch: occupancy query says %d\n", per_cu); }
        (void)hipGetLastError();
        grid = cus;
    }
    if (grid < 0) return;
    if (hipMemsetAsync((char*)d_ws + WS_CTL, 0, CTL_ZERO_BYTES, stream) != hipSuccess) return;
    Args a{};
    for (int i = 0; i < 24; ++i) a.in[i] = (const float*)d_in[i];
    a.out = (float*)d_out; a.ws = (unsigned char*)d_ws;
#if MK_N_LAUNCHES == 1
    a.ph_lo = 0; a.ph_hi = NPHASE;
    hipLaunchKernelGGL(fwd, dim3(grid), dim3(NTHR), LDS_BYTES, stream, a);
#else
    for (int p = 0; p < NPHASE; ++p) { a.ph_lo = p; a.ph_hi = p + 1; hipLaunchKernelGGL(fwd, dim3(grid), dim3(NTHR), LDS_BYTES, stream, a); }
#endif
}
```

```cpp
#include <hip/hip_runtime.h>
#include <cstdio>
#include <cstdint>

#ifndef MK_N_LAUNCHES
#define MK_N_LAUNCHES 1
#endif

namespace pg8 {
#define PG8_LAS __attribute__((address_space(3)))
typedef unsigned short bf16_t;
typedef short bf16x8 __attribute__((ext_vector_type(8)));
typedef float f32x4 __attribute__((ext_vector_type(4)));
typedef unsigned u32x4 __attribute__((ext_vector_type(4)));
typedef unsigned u32x2 __attribute__((ext_vector_type(2)));
constexpr int BM = 256, BK = 64, HALF = 128, HTB = HALF * BK * 2  , STAGE_BYTES = 8 * HTB, NXCD = 8, WGM = 8;

__host__ __device__ __forceinline__ int lds_byte(int r, int c) { const int st = (r >> 4) * 2 + (c >> 5), rr = r & 15, cc = c & 31, ob = rr * 64 + cc * 2; return st * 1024 + (ob ^ (((ob >> 9) & 1) << 5)); }
__host__ __device__ __forceinline__ void stage_rc(int b, int& R, int& C) { const int st = b / 1024, sb = b % 1024, swz = sb ^ (((sb >> 9) & 1) << 5); R = (st >> 1) * 16 + swz / 64; C = (st & 1) * 32 + (swz % 64) / 2; }
__host__ __device__ __forceinline__ int perm32(int rho) { const int n = rho >> 4, i = rho & 15; return 8 * (i >> 2) + 4 * n + (i & 3); }

struct Unit { int pm, pn, arow, brow, r0, nv, e, lb; };
struct Gemm { const bf16_t* A; const bf16_t* Bt; int M, N, K; };

struct StaticOrder {
    int nM, nN, nwg, G, c;
    __host__ __device__ void init(int M, int N, int G_, int c_) { nM = M / BM; nN = N / BM; nwg = nM * nN; G = G_; c = c_; }
    __host__ __device__ bool next(int i, Unit& u) const {
        const long L = (long)i * G + c; if (L >= nwg) return false;
        int wgid = (int)L; { const int q = nwg / NXCD, r = nwg % NXCD, xcd = wgid % NXCD, off = wgid / NXCD; wgid = (xcd < r ? xcd * (q + 1) : r * (q + 1) + (xcd - r) * q) + off; }
        const int nig = WGM * nN, gid = wgid / nig, fm = gid * WGM, gsz = (nM - fm) < WGM ? (nM - fm) : WGM;
        u.pm = fm + ((wgid % nig) % gsz); u.pn = (wgid % nig) / gsz; u.arow = u.pm * BM; u.brow = u.pn * BM; u.r0 = u.arow; u.nv = BM; u.e = 0; u.lb = 0; return true;
    }
    __device__ __forceinline__ int row_of(const Unit&, int) const { return 0; }
};

__device__ __forceinline__ unsigned cvt_pk_bf16(float lo, float hi) { unsigned r; asm volatile("v_cvt_pk_bf16_f32 %0, %1, %2" : "=v"(r) : "v"(lo), "v"(hi)); return r; }

template <class Epi, class Sched, bool ALIGN_EPI, bool GATHER>
__device__ __forceinline__ void gemm_phase(PG8_LAS unsigned char* lds, const Gemm g, const Sched& S, const Epi& E) {
    static_assert(Epi::PERM, "epilogues use the PERM column layout");
    const int tid = threadIdx.x, wid = __builtin_amdgcn_readfirstlane(tid >> 6), lane = tid & 63, wr = wid >> 2, wc = wid & 3, fr = lane & 15, fq = lane >> 4;
    const int K = g.K, nt = K / BK;
    unsigned voffA[2], voffB[2]; int stR[2], stC[2];
#pragma unroll
    for (int i = 0; i < 2; ++i) { int R, C; stage_rc(tid * 16 + i * 8192, R, C); const int Rb = (R & ~31) + perm32(R & 31); stR[i] = R; stC[i] = C;
        voffA[i] = (unsigned)(R * K + C) * 2u; voffB[i] = (unsigned)(Rb * K + C) * 2u; }
    const size_t kstep = (size_t)(BK * 2);
    const size_t hstep = (size_t)HALF * K * 2;
    const size_t rstep = (size_t)K * 2;
    const unsigned ldsw = (unsigned)wid * 1024u;
    const int aoff = lds_byte(wr * 64 + fr, fq * 8), boff = lds_byte(wc * 32 + fr, fq * 8);
#define PG8_SA(b, h) (((b) * 2 + (h)) * HTB)
#define PG8_SB(b, h) ((4 + (b) * 2 + (h)) * HTB)
#define PG8_STAGE(bufoff, gbase, voff) do { _Pragma("unroll") for (int _i = 0; _i < 2; ++_i) \
        __builtin_amdgcn_global_load_lds((const unsigned*)((const char*)(gbase) + (voff)[_i]), (PG8_LAS unsigned*)(lds + (bufoff) + ldsw + _i * 8192), 16, 0, 0); } while (0)
#define PG8_STAGE_A(b, h, P, V) do { if constexpr (GATHER) { PG8_STAGE(PG8_SA(b, h), P, V[h]); } else { PG8_STAGE(PG8_SA(b, h), (P) + (h) * hstep, voffA); } } while (0)
#define PG8_LDA(dst, b, h) do { _Pragma("unroll") for (int m = 0; m < 4; ++m) _Pragma("unroll") for (int k = 0; k < 2; ++k) dst[m][k] = *(const PG8_LAS bf16x8*)(lds + PG8_SA(b, h) + aoff + m * 2048 + k * 1024); } while (0)
#define PG8_LDB(dst, b, h) do { _Pragma("unroll") for (int n = 0; n < 2; ++n) _Pragma("unroll") for (int k = 0; k < 2; ++k) dst[n][k] = *(const PG8_LAS bf16x8*)(lds + PG8_SB(b, h) + boff + n * 2048 + k * 1024); } while (0)
#define PG8_MMA(ai, bj, At, Bt) do { __builtin_amdgcn_s_setprio(1); _Pragma("unroll") for (int m = 0; m < 4; ++m) _Pragma("unroll") for (int n = 0; n < 2; ++n) _Pragma("unroll") for (int k = 0; k < 2; ++k) \
        acc[ai][bj][m][n] = __builtin_amdgcn_mfma_f32_16x16x32_bf16(Bt[n][k], At[m][k], acc[ai][bj][m][n], 0, 0, 0); __builtin_amdgcn_s_setprio(0); } while (0)
#define PG8_WAIT_V(n) asm volatile("s_waitcnt vmcnt(" #n ")" ::: "memory")
#define PG8_WAIT_L(n) asm volatile("s_waitcnt lgkmcnt(" #n ")" ::: "memory")
#define PG8_BAR __builtin_amdgcn_s_barrier()
#define PG8_SCHED __builtin_amdgcn_sched_barrier(0)
#define PG8_GOFF(V, u) do { if constexpr (GATHER) { _Pragma("unroll") for (int _h = 0; _h < 2; ++_h) _Pragma("unroll") for (int _i = 0; _i < 2; ++_i) \
        V[_h][_i] = (unsigned)(S.row_of(u, _h * HALF + stR[_i]) * K + stC[_i]) * 2u; } } while (0)
    Unit cur, nxt; int ui = 0;
    if (!S.next(0, cur)) return;
    f32x4 acc[2][2][4][2];
#pragma unroll
    for (int a = 0; a < 2; ++a)
#pragma unroll
        for (int b = 0; b < 2; ++b)
#pragma unroll
            for (int m = 0; m < 4; ++m)
#pragma unroll
                for (int n = 0; n < 2; ++n) acc[a][b][m][n] = (f32x4){0.f, 0.f, 0.f, 0.f};
    bf16x8 At[4][2], B0[2][2], B1[2][2];
    unsigned vcur[2][2] = {{0u, 0u}, {0u, 0u}}, vnxt[2][2] = {{0u, 0u}, {0u, 0u}}, v2[2][2] = {{0u, 0u}, {0u, 0u}};
    PG8_GOFF(vcur, cur);
    const char* cA = GATHER ? (const char*)g.A : (const char*)g.A + (size_t)cur.arow * rstep; const char* cB = (const char*)g.Bt + (size_t)cur.brow * rstep;
    PG8_STAGE(PG8_SB(0, 0), cB, voffB); PG8_STAGE(PG8_SB(0, 1), cB + hstep, voffB); PG8_STAGE_A(0, 0, cA, vcur); PG8_STAGE_A(0, 1, cA, vcur);
    if (wr == 1) PG8_BAR;
    PG8_WAIT_V(2); PG8_BAR;
    PG8_STAGE(PG8_SB(1, 0), cB + kstep, voffB); PG8_STAGE_A(1, 0, cA + kstep, vcur); PG8_STAGE(PG8_SB(1, 1), cB + hstep + kstep, voffB);
    PG8_WAIT_V(6); PG8_BAR;
    for (;;) {
        const bool has_next = S.next(ui + 1, nxt);
        if constexpr (GATHER) { if (has_next) { PG8_GOFF(vnxt, nxt); } else {
#pragma unroll
            for (int h = 0; h < 2; ++h)
#pragma unroll
                for (int i = 0; i < 2; ++i) vnxt[h][i] = vcur[h][i]; } }
        const char* nA = GATHER ? cA : (has_next ? (const char*)g.A + (size_t)nxt.arow * rstep : cA); const char* nB = has_next ? (const char*)g.Bt + (size_t)nxt.brow * rstep : cB;
        for (int t = 0; t < nt; t += 2) {
            const bool last = (t == nt - 2);
            const char* a1 = cA + (size_t)(t + 1) * kstep;
            const char* a2 = last ? nA : cA + (size_t)(t + 2) * kstep; const char* b2 = last ? nB : cB + (size_t)(t + 2) * kstep;
            const char* a3 = a2 + kstep; const char* b3 = b2 + kstep;
            if constexpr (GATHER) {
#pragma unroll
                for (int h = 0; h < 2; ++h)
#pragma unroll
                    for (int i = 0; i < 2; ++i) v2[h][i] = last ? vnxt[h][i] : vcur[h][i]; }
            PG8_LDB(B0, 0, 0); PG8_LDB(B1, 0, 1); PG8_SCHED; PG8_LDA(At, 0, 0); PG8_STAGE_A(1, 1, a1, vcur);
            PG8_WAIT_V(8); PG8_WAIT_L(0); PG8_BAR; PG8_MMA(0, 0, At, B0); PG8_MMA(0, 1, At, B1); PG8_BAR; PG8_SCHED;
            PG8_LDA(At, 0, 1); PG8_STAGE(PG8_SB(0, 0), b2, voffB); PG8_STAGE(PG8_SB(0, 1), b2 + hstep, voffB); PG8_STAGE_A(0, 0, a2, v2);
            PG8_WAIT_V(8); PG8_WAIT_L(0); PG8_BAR; PG8_MMA(1, 0, At, B0); PG8_MMA(1, 1, At, B1); PG8_BAR; PG8_SCHED;
            PG8_LDB(B0, 1, 0); PG8_LDB(B1, 1, 1); PG8_SCHED; PG8_LDA(At, 1, 0); PG8_STAGE_A(0, 1, a2, v2);
            PG8_WAIT_V(8); PG8_WAIT_L(0); PG8_BAR; PG8_MMA(0, 0, At, B0); PG8_MMA(0, 1, At, B1); PG8_BAR; PG8_SCHED;
            PG8_LDA(At, 1, 1); PG8_STAGE(PG8_SB(1, 0), b3, voffB); PG8_STAGE(PG8_SB(1, 1), b3 + hstep, voffB); PG8_STAGE_A(1, 0, a3, v2);
            PG8_WAIT_V(8); PG8_WAIT_L(0); PG8_BAR; PG8_MMA(1, 0, At, B0); PG8_MMA(1, 1, At, B1); PG8_BAR; PG8_SCHED;
        }
        if constexpr (ALIGN_EPI) { if (wr == 0) PG8_BAR; }
        E(acc, cur, wr, wc, fr, fq);
        if (!has_next) break;
#pragma unroll
        for (int a = 0; a < 2; ++a)
#pragma unroll
            for (int b = 0; b < 2; ++b)
#pragma unroll
                for (int m = 0; m < 4; ++m)
#pragma unroll
                    for (int n = 0; n < 2; ++n) acc[a][b][m][n] = (f32x4){0.f, 0.f, 0.f, 0.f};
        cur = nxt; cA = nA; cB = nB; ++ui;
        if constexpr (GATHER) {
#pragma unroll
            for (int h = 0; h < 2; ++h)
#pragma unroll
                for (int i = 0; i < 2; ++i) vcur[h][i] = vnxt[h][i]; }
        if constexpr (ALIGN_EPI) { if (wr == 1) PG8_BAR; }
    }
    PG8_WAIT_V(0);
    if constexpr (!ALIGN_EPI) { if (wr == 0) PG8_BAR; }
    PG8_BAR;
#undef PG8_SA
#undef PG8_SB
#undef PG8_STAGE
#undef PG8_STAGE_A
#undef PG8_LDA
#undef PG8_LDB
#undef PG8_MMA
#undef PG8_WAIT_V
#undef PG8_WAIT_L
#undef PG8_BAR
#undef PG8_SCHED
#undef PG8_GOFF
}
}

constexpr int NWAVES = 8, NTHR = 512;
constexpr int T = 8192, D = 2048, NPROJ = 11264, WIN_PITCH = 11280, NH = 8, NE = 64, NEX = 65, FF = 512, TOPK = 8, NCHUNK = 128;
constexpr float ALPHA = 1.18920711500272106672f, LN_EPS = 1e-5f, NORM_EPS = 1e-6f, LAMBDA_INIT = 0.2f, ROUTED_SCALE = 2.5f;
constexpr int NPHASE = 12;

constexpr size_t MiB = 1u << 20;
constexpr size_t WS_CTL = 0, CTL_ZERO_BYTES = 1 * MiB;
constexpr size_t WS_WA = 2 * MiB, WS_WB = 6 * MiB, WS_WO = 10 * MiB, WS_WGU = 18 * MiB, WS_WD = 278 * MiB;
constexpr size_t WS_X1F = 408 * MiB, WS_X1B = 472 * MiB, WS_YA = 504 * MiB, WS_YB = 520 * MiB;
constexpr size_t WS_TOKL = 536 * MiB, WS_WGTL = 539 * MiB, WS_INFO = 542 * MiB, WS_GL = 542 * MiB + 512 * 1024, WS_GAB = 543 * MiB;
constexpr size_t WS_WIN = 544 * MiB, WS_XB = 588 * MiB, WS_P = 620 * MiB;
constexpr size_t WS_U = 796 * MiB, WS_W = 828 * MiB, WS_QD = 860 * MiB, WS_KD = 892 * MiB, WS_AQK = 924 * MiB, WS_SST = 940 * MiB, WS_END = 1004 * MiB;
constexpr size_t WS_PK = 796 * MiB, WS_UL = 860 * MiB, WS_OG = 892 * MiB;
constexpr int PKL = 62464, OST_OFF = 2 * PKL, OST_P = 272, OST_BYTES = 64 * OST_P;
constexpr int PK_BYTES = 65536, PK_WN = 0, PK_QD = 17408, PK_KDT = 34816, PK_AQ = 53248;
constexpr size_t WS_TMP = 796 * MiB, WS_MRG = 860 * MiB, WS_Y1 = 892 * MiB;
constexpr size_t WS_HB = 544 * MiB, WS_YAS = 620 * MiB;
constexpr size_t PBUF = (size_t)T * 1024;
constexpr int CW_BAR = 4096;
constexpr int CW_CNT = 32768;
constexpr int CW_AQ = 40960;
constexpr int CW_SP = 41024;

constexpr int RING_BYTES = 131072;
constexpr int LDS_TAB = RING_BYTES;
constexpr int LDS_BYTES = 163840;
constexpr int MISC_OFF = LDS_BYTES - 256;

#define GAS __attribute__((address_space(1)))
#define LAS __attribute__((address_space(3)))
typedef unsigned short bf16;
typedef unsigned v4u __attribute__((ext_vector_type(4)));
typedef unsigned v2u __attribute__((ext_vector_type(2)));
typedef float f32x4 __attribute__((ext_vector_type(4)));
typedef float f32x2 __attribute__((ext_vector_type(2)));
typedef short bf16x8 __attribute__((ext_vector_type(8)));
typedef GAS unsigned gu32;
#define RLX_AGENT __ATOMIC_RELAXED, __HIP_MEMORY_SCOPE_AGENT
#define LDS_WAIT() asm volatile("s_waitcnt lgkmcnt(0)" ::: "memory")
#define VM_WAIT() asm volatile("s_waitcnt vmcnt(0)" ::: "memory")
__device__ __forceinline__ unsigned f2bf(float f) { unsigned u = __builtin_bit_cast(unsigned, f); return (u + 0x7fffu + ((u >> 16) & 1u)) >> 16; }
typedef __bf16 bf16x2_hw __attribute__((ext_vector_type(2)));
__device__ __forceinline__ unsigned pk2(float lo, float hi) { const f32x2 v = {lo, hi}; return __builtin_bit_cast(unsigned, __builtin_convertvector(v, bf16x2_hw)); }
__device__ __forceinline__ float bflo(unsigned w) { return __builtin_bit_cast(float, w << 16); }
__device__ __forceinline__ float bfhi(unsigned w) { return __builtin_bit_cast(float, w & 0xffff0000u); }
__device__ __forceinline__ float bf2f(bf16 b) { return __builtin_bit_cast(float, (unsigned)b << 16); }
__device__ __forceinline__ float sigmoidf_(float x) { return 1.f / (1.f + __expf(-x)); }
__device__ __forceinline__ float siluf_(float x) { return x / (1.f + __expf(-x)); }

#define XB_TMO      128
#define XB_XCNT(j)  (256  + 64 * (j))
#define XB_XSUB(j)  (1280 + 64 * (j))
#define XB_XGEN(j)  (2304 + 64 * (j))
#define XB_TOP      3328
#define XB_TOPGEN   3392
#define XCD_BAR_WORDS 3456
#define XB_SPIN_CAP (1u << 22)

__device__ __forceinline__ unsigned xb_ld(unsigned* p)              { return __hip_atomic_load(p, __ATOMIC_RELAXED, __HIP_MEMORY_SCOPE_AGENT); }
__device__ __forceinline__ unsigned xb_add(unsigned* p, unsigned v) { return __hip_atomic_fetch_add(p, v, __ATOMIC_RELAXED, __HIP_MEMORY_SCOPE_AGENT); }
__device__ __forceinline__ unsigned xb_xcc_id() { return (unsigned)__builtin_amdgcn_s_getreg((3 << 11) | 20) & 0xFu; }
#define XB_SPIN(cond, bar) do { unsigned _sp = 0; while (cond) { __builtin_amdgcn_s_sleep(1); \
    if ((++_sp & 255u) == 0u) { if (xb_ld(&(bar)[XB_TMO])) break; if (_sp > XB_SPIN_CAP) { atomicAdd(&(bar)[XB_TMO], 1u); break; } } } } while (0)

struct XcdBarrier {
    unsigned* bar; unsigned x;
    volatile LAS unsigned* st;
};
__device__ __forceinline__ XcdBarrier xcd_barrier_post(unsigned* bar, volatile LAS unsigned* st) {
    XcdBarrier b; b.bar = bar; b.x = xb_xcc_id(); b.st = st;
    if (threadIdx.x == 0) (void)xb_add(&bar[XB_XCNT(b.x)], 1u);
    return b;
}
__device__ __forceinline__ void xcd_barrier_complete(unsigned* bar, unsigned x, unsigned& nloc, unsigned& nx) {
    const unsigned G = gridDim.x * gridDim.y * gridDim.z;
    unsigned sum, cnt, mine, sp = 0u;
    for (;;) {
        sum = 0u; cnt = 0u; mine = 0u;
#pragma unroll
        for (unsigned j = 0; j < 16; ++j) { const unsigned c = xb_ld(&bar[XB_XCNT(j)]); sum += c; cnt += (c > 0u) ? 1u : 0u; mine = (j == x) ? c : mine; }
        if (sum == G) break;
        __builtin_amdgcn_s_sleep(1);
        if ((++sp & 255u) == 0u) { if (xb_ld(&bar[XB_TMO])) break; if (sp > XB_SPIN_CAP) { atomicAdd(&bar[XB_TMO], 1u); break; } }
    }
    nloc = mine > 0u ? mine : 1u; nx = cnt > 0u ? cnt : 1u;
}
__device__ __forceinline__ void xcd_barrier(const XcdBarrier& b) {
    asm volatile("s_waitcnt vmcnt(0)" ::: "memory");
    __syncthreads();
    if (threadIdx.x == 0) {
        unsigned* bar = b.bar;
        __builtin_amdgcn_s_waitcnt(0);
        unsigned nloc = b.st[0], nx = b.st[1];
        if (nloc == 0u) { xcd_barrier_complete(bar, b.x, nloc, nx); b.st[0] = nloc; b.st[1] = nx; }
        const unsigned old = xb_add(&bar[XB_XSUB(b.x)], 1u);
        const unsigned gen = old / nloc;
        if (old + 1u == (gen + 1u) * nloc) {
            __builtin_amdgcn_fence(__ATOMIC_RELEASE, "agent");
            asm volatile("s_waitcnt vmcnt(0)" ::: "memory");
            const unsigned og = xb_add(&bar[XB_TOP], 1u);
            const unsigned tg = og / nx;
            if (og + 1u == (tg + 1u) * nx) xb_add(&bar[XB_TOPGEN], 1u);
            else XB_SPIN(xb_ld(&bar[XB_TOPGEN]) == tg, bar);
            __builtin_amdgcn_fence(__ATOMIC_ACQUIRE, "agent");
            xb_add(&bar[XB_XGEN(b.x)], 1u);
            asm volatile("s_waitcnt vmcnt(0)" ::: "memory");
        } else {
            XB_SPIN(xb_ld(&bar[XB_XGEN(b.x)]) == gen, bar);
            __builtin_amdgcn_fence(__ATOMIC_ACQUIRE, "agent");
            asm volatile("s_waitcnt vmcnt(0)" ::: "memory");
        }
    }
    __syncthreads();
}

struct Frame {
    LAS unsigned char* lds;
    gu32* ctl;
    int tid, lane, wave;
    int vcu, G;
    const float* in[24]; float* out; unsigned char* ws;
};
__device__ __forceinline__ float wave_sum(float v) {
#pragma unroll
    for (int o = 1; o < 64; o <<= 1) v += __shfl_xor(v, o);
    return v;
}
__device__ __forceinline__ float wave_max(float v) {
#pragma unroll
    for (int o = 1; o < 64; o <<= 1) v = fmaxf(v, __shfl_xor(v, o));
    return v;
}

__device__ __forceinline__ void p0_transpose_item(const float* W, int pitch, int sn0, bf16* WT, int dpitch, int dr0, int k0, LAS float* scr, int lane) {
#pragma unroll 8
    for (int i = 0; i < 32; ++i) { const int kk = 2 * i + (lane >> 5); scr[kk * 33 + (lane & 31)] = W[(size_t)(k0 + kk) * pitch + sn0 + (lane & 31)]; }
    LDS_WAIT(); asm volatile("" ::: "memory");
    const int c = lane & 7;
#pragma unroll
    for (int j = 0; j < 4; ++j) { const int n = (lane >> 3) + 8 * j; const LAS float* s = scr + (8 * c) * 33 + n;
        v4u o; o.x = pk2(s[0 * 33], s[1 * 33]); o.y = pk2(s[2 * 33], s[3 * 33]); o.z = pk2(s[4 * 33], s[5 * 33]); o.w = pk2(s[6 * 33], s[7 * 33]);
        *(GAS v4u*)(WT + (size_t)(dr0 + n) * dpitch + k0 + 8 * c) = o; }
    LDS_WAIT(); asm volatile("" ::: "memory");
}
constexpr int P0_I_IN = 32 * 352, P0_I_A = 16 * 64, P0_I_O = 32 * 64, P0_I_GU = NEX * 2 * 512, P0_I_D = NEX * 512;
constexpr int P0_NITEMS = P0_I_IN + 2 * P0_I_A + P0_I_O + P0_I_GU + P0_I_D, P1_TAIL_ITEMS = 16384;
__device__ __forceinline__ void p0_items(Frame& F, int lo, int hi, int gw, int NGW) {
    unsigned char* ws = F.ws;
    LAS float* scr = (LAS float*)(F.lds + F.wave * 16384);
    constexpr int I_IN = P0_I_IN, I_A = P0_I_A, I_O = P0_I_O, I_GU = P0_I_GU;
    for (int it = lo + gw; it < hi; it += NGW) {
        int r = it;
        if (r < I_IN) { const int kb = r / 352, nb = r % 352, n0 = 32 * nb; p0_transpose_item(F.in[1], WIN_PITCH, n0 + (n0 >= 7168 ? 16 : 0), (bf16*)(ws + WS_WIN), D, n0, 64 * kb, scr, F.lane); continue; } r -= I_IN;
        if (r < I_A) { const int kb = r / 64, nb = r % 64; p0_transpose_item(F.in[9], D, 32 * nb, (bf16*)(ws + WS_WA), 1024, 32 * nb, 64 * kb, scr, F.lane); continue; } r -= I_A;
        if (r < I_A) { const int kb = r / 64, nb = r % 64; p0_transpose_item(F.in[10], D, 32 * nb, (bf16*)(ws + WS_WB), 1024, 32 * nb, 64 * kb, scr, F.lane); continue; } r -= I_A;
        if (r < I_O) { const int kb = r / 64, nb = r % 64; p0_transpose_item(F.in[11], D, 32 * nb, (bf16*)(ws + WS_WO), D, 32 * nb, 64 * kb, scr, F.lane); continue; } r -= I_O;
        if (r < I_GU) { const int e = r / 1024, which = (r >> 9) & 1, q = r & 511, kb = q & 31, nb = q >> 5;
            const float* src = e < NE ? (which ? F.in[17] : F.in[16]) + (size_t)e * D * FF : (which ? F.in[20] : F.in[19]);
            p0_transpose_item(src, FF, 32 * nb, (bf16*)(ws + WS_WGU) + (size_t)e * 1024 * D, D, 256 * (nb >> 2) + 32 * (nb & 3) + 128 * which, 64 * kb, scr, F.lane); continue; } r -= I_GU;
        { const int e = r / 512, q = r & 511, kb = q & 7, nb = q >> 3;
            const float* src = e < NE ? F.in[18] + (size_t)e * FF * D : F.in[21];
            p0_transpose_item(src, D, 32 * nb, (bf16*)(ws + WS_WD) + (size_t)e * D * FF, FF, 32 * nb, 64 * kb, scr, F.lane); }
    }
}
__device__ __forceinline__ void p0_prologue(Frame& F) {
    unsigned char* ws = F.ws;
    {
        LAS float* w16 = (LAS float*)F.lds;
        for (int idx = F.tid; idx < 2048 * 4; idx += NTHR) { const int k = idx >> 2, q = idx & 3;
            const f32x4 v = *(const GAS f32x4*)(F.in[1] + (size_t)k * WIN_PITCH + 7168 + 4 * q); *(LAS f32x4*)(w16 + k * 16 + 4 * q) = v; }
        __syncthreads();
        float* gab = (float*)(ws + WS_GAB);
        for (int tok = F.vcu * NWAVES + F.wave; tok < T; tok += F.G * NWAVES) {
            float acc[16];
#pragma unroll
            for (int e = 0; e < 16; ++e) acc[e] = 0.f;
            const float* xr = F.in[0] + (size_t)tok * D;
#pragma unroll 2
            for (int j = 0; j < 32; ++j) { const int k = j * 64 + F.lane; const float xv = xr[k];
#pragma unroll
                for (int q = 0; q < 4; ++q) { const f32x4 w = *(const LAS f32x4*)(w16 + k * 16 + 4 * q);
                    acc[4 * q + 0] += xv * w.x; acc[4 * q + 1] += xv * w.y; acc[4 * q + 2] += xv * w.z; acc[4 * q + 3] += xv * w.w; } }
#pragma unroll
            for (int e = 0; e < 16; ++e) acc[e] = wave_sum(acc[e]);
            if (F.lane == 0) {
#pragma unroll
                for (int q = 0; q < 4; ++q) *(GAS f32x4*)(gab + (size_t)tok * 16 + 4 * q) = (f32x4){acc[4 * q], acc[4 * q + 1], acc[4 * q + 2], acc[4 * q + 3]}; }
        }
        __syncthreads();
    }
    p0_items(F, 0, P0_NITEMS - P1_TAIL_ITEMS, F.vcu * NWAVES + F.wave, F.G * NWAVES);
    { const GAS f32x4* x4 = (const GAS f32x4*)F.in[0]; GAS v4u* o = (GAS v4u*)(ws + WS_XB);
#pragma unroll 4
      for (size_t i = (size_t)F.vcu * NTHR + F.tid; i < (size_t)T * D / 8; i += (size_t)F.G * NTHR) { const f32x4 a = x4[2 * i], b = x4[2 * i + 1];
          v4u w; w.x = pk2(a.x, a.y); w.y = pk2(a.z, a.w); w.z = pk2(b.x, b.y); w.w = pk2(b.z, b.w); o[i] = w; } }
}

using pg8::Unit;
struct EpiProj {
    static constexpr bool PERM = true;
    bf16* P;
    __device__ __forceinline__ void operator()(const f32x4 (&acc)[2][2][4][2], const Unit& u, int wr, int wc, int fr, int fq) const {
        const int buf = u.pn >> 2, colt = (u.pn & 3) * 256; bf16* base = P + (size_t)buf * PBUF;
        const int row0 = u.r0 + wr * 64 + fr, col0 = colt + wc * 32 + 8 * fq; const bool sg = buf >= 7;
        if (buf == 2) {
            const int frp = (fr & ~12) | ((fr & 4) << 1) | ((fr & 8) >> 1);
#pragma unroll
            for (int ai = 0; ai < 2; ++ai)
#pragma unroll
                for (int m = 0; m < 4; ++m) { const int tokp = u.r0 + wr * 64 + ai * 128 + m * 16 + frp;
#pragma unroll
                    for (int bj = 0; bj < 2; ++bj)
#pragma unroll
                        for (int n = 0; n < 2; ++n)
#pragma unroll
                            for (int x = 0; x < 4; ++x) base[(size_t)(col0 + bj * 128 + 4 * n + x) * T + tokp] = (bf16)f2bf(acc[ai][bj][m][n][x]); }
            return; }
#pragma unroll
        for (int ai = 0; ai < 2; ++ai)
#pragma unroll
            for (int m = 0; m < 4; ++m) { bf16* rowp = base + (size_t)(row0 + ai * 128 + m * 16) * 1024 + col0;
#pragma unroll
                for (int bj = 0; bj < 2; ++bj) { f32x4 v0 = acc[ai][bj][m][0], v1 = acc[ai][bj][m][1];
                    if (sg) { v0 = (f32x4){sigmoidf_(v0.x), sigmoidf_(v0.y), sigmoidf_(v0.z), sigmoidf_(v0.w)}; v1 = (f32x4){sigmoidf_(v1.x), sigmoidf_(v1.y), sigmoidf_(v1.z), sigmoidf_(v1.w)}; }
                    v4u w; w.x = pk2(v0.x, v0.y); w.y = pk2(v0.z, v0.w); w.z = pk2(v1.x, v1.y); w.w = pk2(v1.z, v1.w);
                    *(GAS v4u*)(rowp + bj * 128) = w; } }
    }
};
template <int STEP> struct EpiBranch {
    static constexpr bool PERM = true;
    const bf16* SG; float* tmp; bf16* mrg;
    __device__ __forceinline__ void operator()(const f32x4 (&acc)[2][2][4][2], const Unit& u, int wr, int wc, int fr, int fq) const {
        const int row0 = u.r0 + wr * 64 + fr, colu = u.pn * 256 + wc * 32 + 8 * fq;
#pragma unroll
        for (int ai = 0; ai < 2; ++ai)
#pragma unroll
            for (int m = 0; m < 4; ++m) { const int row = row0 + ai * 128 + m * 16;
#pragma unroll
                for (int bj = 0; bj < 2; ++bj) { const int col = colu + bj * 128;
                    const v4u g = *(const GAS v4u*)(SG + (size_t)(col >> 10) * PBUF + (size_t)row * 1024 + (col & 1023));
                    f32x4 v0 = acc[ai][bj][m][0], v1 = acc[ai][bj][m][1];
                    v0 = v0 * (f32x4){bflo(g.x), bfhi(g.x), bflo(g.y), bfhi(g.y)}; v1 = v1 * (f32x4){bflo(g.z), bfhi(g.z), bflo(g.w), bfhi(g.w)};
                    float* tp = tmp + (size_t)row * D + col;
                    if (STEP == 0) { *(GAS f32x4*)tp = v0; *(GAS f32x4*)(tp + 4) = v1; }
                    else { v0 = v0 + *(const GAS f32x4*)tp; v1 = v1 + *(const GAS f32x4*)(tp + 4);
                        v4u w; w.x = pk2(v0.x, v0.y); w.y = pk2(v0.z, v0.w); w.z = pk2(v1.x, v1.y); w.w = pk2(v1.z, v1.w);
                        *(GAS v4u*)(mrg + (size_t)row * D + col) = w; } } }
    }
};
struct EpiOut {
    static constexpr bool PERM = true;
    const float* x; float* y1;
    __device__ __forceinline__ void operator()(const f32x4 (&acc)[2][2][4][2], const Unit& u, int wr, int wc, int fr, int fq) const {
        const int row0 = u.r0 + wr * 64 + fr, colu = u.pn * 256 + wc * 32 + 8 * fq;
#pragma unroll
        for (int ai = 0; ai < 2; ++ai)
#pragma unroll
            for (int m = 0; m < 4; ++m) { const size_t ro = (size_t)(row0 + ai * 128 + m * 16) * D;
#pragma unroll
                for (int bj = 0; bj < 2; ++bj) { const size_t o = ro + colu + bj * 128;
                    const f32x4 x0 = *(const GAS f32x4*)(x + o), x1 = *(const GAS f32x4*)(x + o + 4);
                    *(GAS f32x4*)(y1 + o) = x0 * ALPHA + acc[ai][bj][m][0]; *(GAS f32x4*)(y1 + o + 4) = x1 * ALPHA + acc[ai][bj][m][1]; } }
    }
};
struct EpiGU {
    static constexpr bool PERM = true;
    bf16* HB;
    __device__ __forceinline__ void operator()(const f32x4 (&acc)[2][2][4][2], const Unit& u, int wr, int wc, int fr, int fq) const {
        const int col = u.pn * 128 + wc * 32 + 8 * fq;
#pragma unroll
        for (int ai = 0; ai < 2; ++ai)
#pragma unroll
            for (int m = 0; m < 4; ++m) { const int r = ai * 128 + wr * 64 + m * 16 + fr;
                if (r < u.nv) { const f32x4 g0 = acc[ai][0][m][0], g1 = acc[ai][0][m][1], u0 = acc[ai][1][m][0], u1 = acc[ai][1][m][1];
                    v4u w; w.x = pk2(siluf_(g0.x) * u0.x, siluf_(g0.y) * u0.y); w.y = pk2(siluf_(g0.z) * u0.z, siluf_(g0.w) * u0.w);
                    w.z = pk2(siluf_(g1.x) * u1.x, siluf_(g1.y) * u1.y); w.w = pk2(siluf_(g1.z) * u1.z, siluf_(g1.w) * u1.w);
                    *(GAS v4u*)(HB + (size_t)(u.r0 + r) * FF + col) = w; } }
    }
};
struct EpiDown {
    static constexpr bool PERM = true;
    bf16* YAS; const float* wgtl;
    __device__ __forceinline__ void operator()(const f32x4 (&acc)[2][2][4][2], const Unit& u, int wr, int wc, int fr, int fq) const {
        const int colu = u.pn * 256 + wc * 32 + 8 * fq;
#pragma unroll
        for (int ai = 0; ai < 2; ++ai)
#pragma unroll
            for (int m = 0; m < 4; ++m) { const int r = ai * 128 + wr * 64 + m * 16 + fr;
                if (r < u.nv) { const float wg = wgtl[u.lb + r];
#pragma unroll
                    for (int bj = 0; bj < 2; ++bj) { const f32x4 v0 = acc[ai][bj][m][0] * wg, v1 = acc[ai][bj][m][1] * wg;
                        v4u w; w.x = pk2(v0.x, v0.y); w.y = pk2(v0.z, v0.w); w.z = pk2(v1.x, v1.y); w.w = pk2(v1.z, v1.w);
                        *(GAS v4u*)(YAS + (size_t)(u.r0 + r) * D + colu + bj * 128) = w; } } }
    }
};
struct MoeOrder {
    const LAS int* units; const int* tokl;
    __device__ __forceinline__ bool next(int i, Unit& u) const {
        if (i >= 16) return false;
        const LAS int* p = units + i * 8; const int pm = p[0]; if (pm < 0) return false;
        u.pm = pm; u.pn = p[1]; u.arow = p[2]; u.brow = p[3]; u.r0 = p[4]; u.nv = p[5]; u.e = p[6]; u.lb = p[7]; return true;
    }
    __device__ __forceinline__ int row_of(const Unit& u, int r) const { return r < u.nv ? tokl[u.lb + r] : 0; }
};
__device__ __forceinline__ void moe_tables(Frame& F, int NT, int brows) {
    LAS int* tpref = (LAS int*)(F.lds + LDS_TAB); LAS int* rbase = tpref + 72; LAS int* cnts = rbase + 72;
    __syncthreads();
    if (F.wave == 0) {
        const int c = (int)__hip_atomic_load(F.ctl + CW_CNT + 64 * F.lane, RLX_AGENT);
        int tl = (c + 255) >> 8, tp = tl, rb = c;
#pragma unroll
        for (int o = 1; o < 64; o <<= 1) { const int a = __shfl_up(tp, o), b = __shfl_up(rb, o); if (F.lane >= o) { tp += a; rb += b; } }
        tpref[F.lane] = tp - tl; rbase[F.lane] = rb - c; cnts[F.lane] = c;
        if (F.lane == 63) { tpref[64] = tp; rbase[64] = rb; cnts[64] = T; tpref[65] = tp + T / 256; rbase[65] = rb + T; }
    }
    __syncthreads();
    if (NT > 0 && F.tid < 16) {
        LAS int* p = (LAS int*)(F.lds + LDS_TAB + 1024) + F.tid * 8; const int L = F.tid * F.G + (int)blockIdx.x;
        if (L >= tpref[NEX] * NT) p[0] = -1;
        else { const int tg = L / NT, nt = L % NT; int e = 0;
            while (tpref[e + 1] <= tg) ++e;
            const int mt = tg - tpref[e], rem = cnts[e] - mt * 256, r0 = rbase[e] + mt * 256;
            p[0] = mt; p[1] = nt; p[2] = r0; p[3] = e * brows + nt * 256; p[4] = r0; p[5] = rem < 256 ? rem : 256; p[6] = e; p[7] = e * T + mt * 256; }
    }
    __syncthreads();
}
#ifndef DUP_PHASE
#define DUP_PHASE -1
#endif

__device__ __forceinline__ int t5_bucket(int rel) {
    const int n = rel < 0 ? -rel : rel; int b;
    if (n < 8) b = n; else if (n < 12) b = 8; else if (n < 16) b = 9; else if (n < 23) b = 10; else if (n < 32) b = 11; else if (n < 46) b = 12; else if (n < 64) b = 13; else if (n < 91) b = 14; else b = 15;
    return b + (rel > 0 ? 16 : 0);
}
typedef float f32x16 __attribute__((ext_vector_type(16)));
__device__ __forceinline__ bf16x8 cvt8(const f32x16& x, int s) {
    v4u w;
    if (s == 0) { w.x = pk2(x[0], x[1]); w.y = pk2(x[2], x[3]); w.z = pk2(x[4], x[5]); w.w = pk2(x[6], x[7]); }
    else { w.x = pk2(x[8], x[9]); w.y = pk2(x[10], x[11]); w.z = pk2(x[12], x[13]); w.w = pk2(x[14], x[15]); }
    return __builtin_bit_cast(bf16x8, w);
}
constexpr int AT_KP = 272, AT_VP = 144, AT_KB = 64 * AT_KP, AT_VB = 128 * AT_VP, AT_BUF = AT_KB + AT_VB;
constexpr float AT_C1 = 0.125f * 1.4426950408889634f, LOG2E = 1.4426950408889634f;
template <int QOFF> __device__ __forceinline__ void attn_v2(Frame& F) {
    LAS unsigned char* lds = F.lds;
    LAS float* relb = (LAS float*)(F.lds + 2 * AT_BUF);
    LAS int* qslot = (LAS int*)(relb + 256);
    const bf16* Pq = (const bf16*)(F.ws + WS_P); const bf16* Pk = Pq + PBUF; const bf16* VT = Pq + 2 * PBUF;
    bf16* ya = (bf16*)(F.ws + WS_YA);
    float lam;
    { const float* dl = F.in[6]; float s01 = 0.f, s23 = 0.f;
      for (int d = 0; d < 64; ++d) { s01 += dl[d] * dl[64 + d]; s23 += dl[128 + d] * dl[192 + d]; }
      lam = expf(s01) - expf(s23) + LAMBDA_INIT; }
    for (;;) {
        int tid = F.tid; asm volatile("" : "+v"(tid));
        __syncthreads();
        if (tid == 0) qslot[0] = (int)__hip_atomic_fetch_add(F.ctl + CW_AQ + QOFF, 1u, RLX_AGENT);
        __syncthreads();
        const int L = qslot[0];
        if (L >= NH * 64) break;
        const int h = L & 7, qb = 63 - (L >> 3), lane = tid & 63, i31 = lane & 31, hh = lane >> 5, sb = F.wave & 3, map = F.wave >> 2;
        const int cw = 2 * qb + (sb >> 1), ntile = 2 * qb + 2;
        if (tid < 256) relb[tid] = F.in[8][t5_bucket(tid - 191) * 8 + h] * LOG2E;
        const int qrow = qb * 128 + 32 * sb + i31;
        bf16x8 qf[4];
#pragma unroll
        for (int ks = 0; ks < 4; ++ks) qf[ks] = *(const GAS bf16x8*)(Pq + (size_t)qrow * 1024 + h * 128 + map * 64 + 16 * ks + 8 * hh);
        const int kr0 = tid >> 4, kc0 = tid & 15, vr0 = tid >> 3, vc0 = tid & 7;
        const bf16* kg = Pk + (size_t)kr0 * 1024 + h * 128 + kc0 * 8;
        const bf16* vg = VT + (size_t)(h * 128 + vr0) * T + vc0 * 8;
        const int klo = kr0 * AT_KP + kc0 * 16, vlo = AT_KB + vr0 * AT_VP + vc0 * 16;
        v4u st[4];
        st[0] = *(const GAS v4u*)kg; st[1] = *(const GAS v4u*)(kg + 32 * 1024); st[2] = *(const GAS v4u*)vg; st[3] = *(const GAS v4u*)(vg + (size_t)64 * T);
        *(LAS v4u*)(lds + klo) = st[0]; *(LAS v4u*)(lds + klo + 32 * AT_KP) = st[1]; *(LAS v4u*)(lds + vlo) = st[2]; *(LAS v4u*)(lds + vlo + 64 * AT_VP) = st[3];
        f32x16 O[4];
#pragma unroll
        for (int db = 0; db < 4; ++db)
#pragma unroll
            for (int r = 0; r < 16; ++r) O[db][r] = 0.f;
        float mrun = -INFINITY, lrun = 0.f;
        __syncthreads();
#pragma unroll 1
        for (int j = 0; j < ntile; ++j) {
            const LAS unsigned char* buf = lds + (j & 1) * AT_BUF;
            if (j + 1 < ntile) { const size_t ko = (size_t)(j + 1) * 64 * 1024; const int vo = (j + 1) * 64;
                st[0] = *(const GAS v4u*)(kg + ko); st[1] = *(const GAS v4u*)(kg + ko + 32 * 1024); st[2] = *(const GAS v4u*)(vg + vo); st[3] = *(const GAS v4u*)(vg + (size_t)64 * T + vo); }
            if (j <= cw) {
                f32x16 S[2]; bf16x8 kf[8], vf[8];
#pragma unroll
                for (int kb = 0; kb < 2; ++kb)
#pragma unroll
                    for (int ks = 0; ks < 4; ++ks) kf[4 * kb + ks] = *(const LAS bf16x8*)(buf + (32 * kb + i31) * AT_KP + map * 128 + (16 * ks + 8 * hh) * 2);
#pragma unroll
                for (int kb = 0; kb < 2; ++kb) {
#pragma unroll
                    for (int r = 0; r < 16; ++r) S[kb][r] = 0.f;
#pragma unroll
                    for (int ks = 0; ks < 4; ++ks) S[kb] = __builtin_amdgcn_mfma_f32_32x32x16_bf16(kf[4 * kb + ks], qf[ks], S[kb], 0, 0, 0); }
#pragma unroll
                for (int db = 0; db < 2; ++db)
#pragma unroll
                    for (int ks = 0; ks < 4; ++ks) vf[4 * db + ks] = *(const LAS bf16x8*)(buf + AT_KB + (32 * db + i31) * AT_VP + (16 * ks + 8 * hh) * 2);
                float tmax = -INFINITY;
                if (j >= cw - 2) { const int rb = (j * 64) - (qb * 128 + 32 * sb + i31) + 191 + 4 * hh;
#pragma unroll
                    for (int kb = 0; kb < 2; ++kb)
#pragma unroll
                        for (int r = 0; r < 16; ++r) { S[kb][r] = S[kb][r] * AT_C1 + relb[rb + 32 * kb + (r & 3) + 8 * (r >> 2)]; tmax = fmaxf(tmax, S[kb][r]); }
                } else { const float bfar = relb[0];
#pragma unroll
                    for (int kb = 0; kb < 2; ++kb)
#pragma unroll
                        for (int r = 0; r < 16; ++r) { S[kb][r] = S[kb][r] * AT_C1 + bfar; tmax = fmaxf(tmax, S[kb][r]); } }
                tmax = fmaxf(tmax, __shfl_xor(tmax, 32));
                if (__any(tmax > mrun + 8.f)) { const float mn = fmaxf(mrun, tmax), corr = __builtin_amdgcn_exp2f(mrun - mn); mrun = mn; lrun *= corr;
#pragma unroll
                    for (int db = 0; db < 4; ++db) O[db] = O[db] * corr; }
                float ps = 0.f;
#pragma unroll
                for (int kb = 0; kb < 2; ++kb)
#pragma unroll
                    for (int r = 0; r < 16; ++r) { S[kb][r] = __builtin_amdgcn_exp2f(S[kb][r] - mrun); ps += S[kb][r]; }
                lrun += ps;
                bf16x8 pf[4];
#pragma unroll
                for (int kb = 0; kb < 2; ++kb) { pf[2 * kb] = cvt8(S[kb], 0); pf[2 * kb + 1] = cvt8(S[kb], 1); }
#pragma unroll
                for (int db = 0; db < 4; ++db) {
#pragma unroll
                    for (int ks = 0; ks < 4; ++ks) O[db] = __builtin_amdgcn_mfma_f32_32x32x16_bf16(vf[4 * (db & 1) + ks], pf[ks], O[db], 0, 0, 0);
                    if (db < 2) {
#pragma unroll
                        for (int ks = 0; ks < 4; ++ks) vf[4 * (db & 1) + ks] = *(const LAS bf16x8*)(buf + AT_KB + (32 * (db + 2) + i31) * AT_VP + (16 * ks + 8 * hh) * 2); } }
            }
            if (j + 1 < ntile) { LAS unsigned char* nb = lds + ((j + 1) & 1) * AT_BUF;
                *(LAS v4u*)(nb + klo) = st[0]; *(LAS v4u*)(nb + klo + 32 * AT_KP) = st[1]; *(LAS v4u*)(nb + vlo) = st[2]; *(LAS v4u*)(nb + vlo + 64 * AT_VP) = st[3]; }
            __syncthreads();
        }
        lrun += __shfl_xor(lrun, 32);
        const float inv = 1.f / lrun;
        LAS float* X = (LAS float*)lds + sb * 4096;
        if (map == 1) {
#pragma unroll
            for (int db = 0; db < 4; ++db)
#pragma unroll
                for (int r = 0; r < 16; ++r) X[(db * 16 + r) * 64 + lane] = O[db][r] * inv; }
        __syncthreads();
        if (map == 0) { float ss = 0.f;
#pragma unroll
            for (int db = 0; db < 4; ++db)
#pragma unroll
                for (int r = 0; r < 16; ++r) { const float a = O[db][r] * inv - lam * X[(db * 16 + r) * 64 + lane]; O[db][r] = a; ss += a * a; }
            ss += __shfl_xor(ss, 32);
            const float rn = rsqrtf(ss * (1.f / 128.f) + NORM_EPS) * (1.f - LAMBDA_INIT);
            bf16* op = ya + (size_t)qrow * 1024 + h * 128 + 4 * hh;
#pragma unroll
            for (int db = 0; db < 4; ++db)
#pragma unroll
                for (int q4 = 0; q4 < 4; ++q4) { const int dv = 32 * db + 8 * q4 + 4 * hh; const f32x4 sw = *(const GAS f32x4*)(F.in[7] + dv);
                    *(GAS v2u*)(op + 32 * db + 8 * q4) = (v2u){pk2(O[db][4 * q4] * rn * sw.x, O[db][4 * q4 + 1] * rn * sw.y), pk2(O[db][4 * q4 + 2] * rn * sw.z, O[db][4 * q4 + 3] * rn * sw.w)}; } }
    }
}

__device__ __forceinline__ int swap23(int x) { return (x & ~12) | ((x & 4) << 1) | ((x & 8) >> 1); }
__device__ __forceinline__ void gdn_prep_v1(Frame& F) {
    LAS float* Ks = (LAS float*)F.lds;
    LAS float* Qs = Ks + 64 * 129;
    LAS float* Vs = Qs + 64 * 129;
    LAS float* As = Vs + 64 * 128;
    LAS float* Tm = As + 64 * 68;
    LAS float* gcs = Tm + 64 * 68;
    LAS float* bts = gcs + 64;
    LAS float* egs = bts + 64;
    const bf16* P3 = (const bf16*)(F.ws + WS_P) + 3 * PBUF;
    const float* gab = (const float*)(F.ws + WS_GAB);
    float* GLg = (float*)(F.ws + WS_GL);
    const int tid = F.tid, lane = F.lane;
    for (int L = blockIdx.x; L < NH * NCHUNK; L += F.G) {
        const int n = L >> 3, h = L & 7, t0 = n * 64;
        __syncthreads();
        for (int idx = tid; idx < 64 * 384; idx += NTHR) { const int t = idx / 384, ch = idx % 384, which = ch >> 7, i = ch & 127, cg = which * 1024 + h * 128 + i;
            const bf16* src = P3 + (size_t)which * PBUF + h * 128 + i; float a = 0.f;
#pragma unroll
            for (int j = 0; j < 4; ++j) { const int tt = t0 + t - 3 + j; if (tt >= 0) a += bf2f(src[(size_t)tt * 1024]) * F.in[2][j * 3072 + cg]; }
            a = siluf_(a);
            if (which == 0) Qs[t * 129 + i] = a; else if (which == 1) Ks[t * 129 + i] = a; else Vs[t * 128 + i] = a; }
        __syncthreads();
        for (int t = F.wave * 8; t < F.wave * 8 + 8; ++t) {
            const float q0 = Qs[t * 129 + lane], q1 = Qs[t * 129 + 64 + lane], k0 = Ks[t * 129 + lane], k1 = Ks[t * 129 + 64 + lane];
            const float rq = rsqrtf(wave_sum(q0 * q0 + q1 * q1) + NORM_EPS) * 0.08838834764831845f, rk = rsqrtf(wave_sum(k0 * k0 + k1 * k1) + NORM_EPS);
            Qs[t * 129 + lane] = q0 * rq; Qs[t * 129 + 64 + lane] = q1 * rq; Ks[t * 129 + lane] = k0 * rk; Ks[t * 129 + 64 + lane] = k1 * rk; }
        if (F.wave == 0) { const int tok = t0 + lane; const float ga = gab[(size_t)tok * 16 + h] + F.in[4][h], gb = gab[(size_t)tok * 16 + 8 + h];
            const float sp = fmaxf(ga, 0.f) + log1pf(expf(-fabsf(ga))); float g = -expf(F.in[3][h]) * sp;
#pragma unroll
            for (int o = 1; o < 64; o <<= 1) { const float v = __shfl_up(g, o); if (lane >= o) g += v; }
            gcs[lane] = g; bts[lane] = 1.f / (1.f + expf(-gb)); egs[lane] = expf(g); }
        __syncthreads();
        for (int idx = tid; idx < 4096; idx += NTHR) { const int c = idx >> 6, s = idx & 63; float kk = 0.f, qk = 0.f;
            if (s <= c) { for (int i = 0; i < 128; ++i) { const float ks = Ks[s * 129 + i]; kk += Ks[c * 129 + i] * ks; qk += Qs[c * 129 + i] * ks; }
                const float dec = expf(gcs[c] - gcs[s]); kk *= dec * bts[c]; qk *= dec; }
            As[c * 68 + s] = (s < c) ? kk : 0.f; ((bf16*)(F.ws + WS_PK + (size_t)(h * NCHUNK + n) * PK_BYTES + PK_AQ))[c * 72 + swap23(s)] = (bf16)f2bf((s <= c) ? qk : 0.f); }
        __syncthreads();
        if (F.wave == 0) {
            for (int i = 0; i < 64; ++i) { float a = (i == lane) ? 1.f : 0.f;
#pragma unroll 4
                for (int j = 0; j < i; ++j) a -= As[i * 68 + j] * Tm[j * 68 + lane];
                Tm[i * 68 + lane] = a; }
        }
        __syncthreads();
        unsigned char* pk = F.ws + WS_PK + (size_t)(h * NCHUNK + n) * PK_BYTES; float* ul = (float*)(F.ws + WS_UL) + (size_t)(h * NCHUNK + n) * 4 * 64 * 32;
        for (int idx = tid; idx < 64 * 256; idx += NTHR) { const int c = idx >> 8, col = idx & 255; float a = 0.f;
            if (col < 128) { for (int s = 0; s <= c; ++s) a += Tm[c * 68 + s] * bts[s] * Vs[s * 128 + col];
                const int cp = c & 31; ul[(((col >> 5) * 64) + (col & 31) + 32 * ((cp >> 2) & 1)) * 32 + (c >> 5) * 16 + (cp & 3) + 4 * (cp >> 3)] = a; }
            else { const int i = col - 128; for (int s = 0; s <= c; ++s) a += Tm[c * 68 + s] * bts[s] * egs[s] * Ks[s * 129 + i];
                ((bf16*)(pk + PK_WN))[c * 136 + swap23(i)] = (bf16)f2bf(-a); } }
        const float glast = gcs[63];
        for (int idx = tid; idx < 64 * 128; idx += NTHR) { const int t = idx >> 7, i = idx & 127;
            ((bf16*)(pk + PK_QD))[t * 136 + swap23(i)] = (bf16)f2bf(Qs[t * 129 + i] * egs[t]);
            ((bf16*)(pk + PK_KDT))[i * 72 + swap23(t)] = (bf16)f2bf(Ks[t * 129 + i] * expf(glast - gcs[t])); }
        if (tid == 0) GLg[L] = expf(glast);
    }
}
__device__ __forceinline__ void gdn_prep_v2(Frame& F) {
    typedef float f32x16_ __attribute__((ext_vector_type(16)));
    LAS bf16* Kb = (LAS bf16*)F.lds;
    LAS bf16* Qb = Kb + 64 * 136;
    LAS bf16* Vt = Qb + 64 * 136;
    LAS bf16* KBt = Vt + 128 * 72;
    LAS float* As = (LAS float*)(KBt + 128 * 72);
    LAS float* Tm = As + 64 * 68;
    LAS float* Tp = Tm + 64 * 68;
    LAS bf16* Tmb = (LAS bf16*)(Tp + 32 * 36);
    LAS float* gcs = (LAS float*)(Tmb + 64 * 72);
    LAS float* bts = gcs + 64;
    LAS float* egs = bts + 64;
    LAS float* eks = egs + 64;
    const bf16* P3 = (const bf16*)(F.ws + WS_P) + 3 * PBUF;
    const float* gab = (const float*)(F.ws + WS_GAB);
    float* GLg = (float*)(F.ws + WS_GL);
    for (int L = blockIdx.x; L < NH * NCHUNK; L += F.G) {
        int tid = F.tid; asm volatile("" : "+v"(tid));
        const int lane = tid & 63, i31 = lane & 31, hh = lane >> 5;
        const int n = L >> 3, h = L & 7, t0 = n * 64;
        unsigned char* pk = F.ws + WS_PK + (size_t)(h * NCHUNK + n) * PK_BYTES; float* ul = (float*)(F.ws + WS_UL) + (size_t)(h * NCHUNK + n) * 4 * 64 * 32;
        __syncthreads();
        if (F.wave == 0) { const int tok = t0 + lane; const float ga = gab[(size_t)tok * 16 + h] + F.in[4][h], gb = gab[(size_t)tok * 16 + 8 + h];
            const float sp = fmaxf(ga, 0.f) + log1pf(expf(-fabsf(ga))); float g = -expf(F.in[3][h]) * sp;
#pragma unroll
            for (int o = 1; o < 64; o <<= 1) { const float v = __shfl_up(g, o); if (lane >= o) g += v; }
            const float glast = __shfl(g, 63);
            gcs[lane] = g; bts[lane] = 1.f / (1.f + expf(-gb)); egs[lane] = expf(g); eks[lane] = expf(glast - g);
            if (lane == 0) GLg[L] = expf(glast); }
        for (int idx = tid; idx < 64 * 68; idx += NTHR) Tm[idx] = 0.f;
        const int seg = tid & 63, trow = tid >> 6, which = seg >> 4, sc = (seg & 15) * 8;
        float ov[8][8];
        if (seg < 48) {
            const int cg = which * 1024 + h * 128 + sc; float cw[4][8];
#pragma unroll
            for (int j = 0; j < 4; ++j) { const f32x4 a = *(const GAS f32x4*)(F.in[2] + j * 3072 + cg), b = *(const GAS f32x4*)(F.in[2] + j * 3072 + cg + 4);
                cw[j][0] = a.x; cw[j][1] = a.y; cw[j][2] = a.z; cw[j][3] = a.w; cw[j][4] = b.x; cw[j][5] = b.y; cw[j][6] = b.z; cw[j][7] = b.w; }
            const bf16* src = P3 + (size_t)which * PBUF + h * 128 + sc; v4u xw[11];
#pragma unroll
            for (int m = 0; m < 11; ++m) { const int tt = t0 + 8 * trow - 3 + m; xw[m] = (v4u){0u, 0u, 0u, 0u}; if (tt >= 0) xw[m] = *(const GAS v4u*)(src + (size_t)tt * 1024); }
#pragma unroll
            for (int ti = 0; ti < 8; ++ti) {
#pragma unroll
                for (int c2 = 0; c2 < 4; ++c2) { float a0 = 0.f, a1 = 0.f;
#pragma unroll
                    for (int j = 0; j < 4; ++j) { const unsigned w = xw[ti + j][c2]; a0 += bflo(w) * cw[j][2 * c2]; a1 += bfhi(w) * cw[j][2 * c2 + 1]; }
                    ov[ti][2 * c2] = siluf_(a0); ov[ti][2 * c2 + 1] = siluf_(a1); } }
        } else {
#pragma unroll
            for (int ti = 0; ti < 8; ++ti)
#pragma unroll
                for (int ch = 0; ch < 8; ++ch) ov[ti][ch] = 0.f; }
#pragma unroll
        for (int ti = 0; ti < 8; ++ti) { float ss = 0.f;
#pragma unroll
            for (int ch = 0; ch < 8; ++ch) ss += ov[ti][ch] * ov[ti][ch];
            ss += __shfl_xor(ss, 1); ss += __shfl_xor(ss, 2); ss += __shfl_xor(ss, 4); ss += __shfl_xor(ss, 8);
            const float rn = which == 0 ? rsqrtf(ss + NORM_EPS) * 0.08838834764831845f : (which == 1 ? rsqrtf(ss + NORM_EPS) : 1.f);
#pragma unroll
            for (int ch = 0; ch < 8; ++ch) ov[ti][ch] *= rn; }
        __syncthreads();
        if (seg < 48) {
            const int a = (sc >> 3) & 1, g16 = sc & ~15;
            if (which == 0) {
#pragma unroll
                for (int ti = 0; ti < 8; ++ti) { const int t = 8 * trow + ti; const float e = egs[t];
                    *(LAS v4u*)(Qb + t * 136 + sc) = (v4u){pk2(ov[ti][0], ov[ti][1]), pk2(ov[ti][2], ov[ti][3]), pk2(ov[ti][4], ov[ti][5]), pk2(ov[ti][6], ov[ti][7])};
                    bf16* qd = (bf16*)(pk + PK_QD) + t * 136 + g16 + 4 * a;
                    *(GAS v2u*)qd = (v2u){pk2(ov[ti][0] * e, ov[ti][1] * e), pk2(ov[ti][2] * e, ov[ti][3] * e)};
                    *(GAS v2u*)(qd + 8) = (v2u){pk2(ov[ti][4] * e, ov[ti][5] * e), pk2(ov[ti][6] * e, ov[ti][7] * e)}; }
            } else if (which == 1) {
                float be[8], ek[8];
#pragma unroll
                for (int ti = 0; ti < 8; ++ti) { const int t = 8 * trow + ti; be[ti] = bts[t] * egs[t]; ek[ti] = eks[t];
                    *(LAS v4u*)(Kb + t * 136 + sc) = (v4u){pk2(ov[ti][0], ov[ti][1]), pk2(ov[ti][2], ov[ti][3]), pk2(ov[ti][4], ov[ti][5]), pk2(ov[ti][6], ov[ti][7])}; }
                const int ta = trow & 1, tg16 = (8 * trow) & ~15;
#pragma unroll
                for (int ch = 0; ch < 8; ++ch) {
                    *(LAS v4u*)(KBt + (sc + ch) * 72 + 8 * trow) = (v4u){pk2(ov[0][ch] * be[0], ov[1][ch] * be[1]), pk2(ov[2][ch] * be[2], ov[3][ch] * be[3]), pk2(ov[4][ch] * be[4], ov[5][ch] * be[5]), pk2(ov[6][ch] * be[6], ov[7][ch] * be[7])};
                    bf16* kd = (bf16*)(pk + PK_KDT) + (sc + ch) * 72 + tg16 + 4 * ta;
                    *(GAS v2u*)kd = (v2u){pk2(ov[0][ch] * ek[0], ov[1][ch] * ek[1]), pk2(ov[2][ch] * ek[2], ov[3][ch] * ek[3])};
                    *(GAS v2u*)(kd + 8) = (v2u){pk2(ov[4][ch] * ek[4], ov[5][ch] * ek[5]), pk2(ov[6][ch] * ek[6], ov[7][ch] * ek[7])}; }
            } else {
                float be[8];
#pragma unroll
                for (int ti = 0; ti < 8; ++ti) be[ti] = bts[8 * trow + ti];
#pragma unroll
                for (int ch = 0; ch < 8; ++ch)
                    *(LAS v4u*)(Vt + (sc + ch) * 72 + 8 * trow) = (v4u){pk2(ov[0][ch] * be[0], ov[1][ch] * be[1]), pk2(ov[2][ch] * be[2], ov[3][ch] * be[3]), pk2(ov[4][ch] * be[4], ov[5][ch] * be[5]), pk2(ov[6][ch] * be[6], ov[7][ch] * be[7])};
            }
        }
        __syncthreads();
        { const int kind = F.wave >> 2, mb = (F.wave >> 1) & 1, nb = F.wave & 1; const LAS bf16* Am = kind ? Qb : Kb; f32x16_ acc;
#pragma unroll
          for (int r = 0; r < 16; ++r) acc[r] = 0.f;
#pragma unroll
          for (int ks = 0; ks < 8; ++ks) { const bf16x8 a = *(const LAS bf16x8*)(Am + (32 * mb + i31) * 136 + 16 * ks + 8 * hh), b = *(const LAS bf16x8*)(Kb + (32 * nb + i31) * 136 + 16 * ks + 8 * hh);
              acc = __builtin_amdgcn_mfma_f32_32x32x16_bf16(a, b, acc, 0, 0, 0); }
          const int s = 32 * nb + i31; const float gs = gcs[s];
#pragma unroll
          for (int r = 0; r < 16; ++r) { const int c = 32 * mb + (r & 3) + 8 * (r >> 2) + 4 * hh; const float dec = expf(s <= c ? gcs[c] - gs : 0.f);
              if (kind == 0) As[c * 68 + s] = (s < c) ? bts[c] * acc[r] * dec : 0.f;
              else ((bf16*)(pk + PK_AQ))[c * 72 + swap23(s)] = (bf16)f2bf((s <= c) ? acc[r] * dec : 0.f); } }
        __syncthreads();
        if (F.wave < 4 && lane < 16) { const int b0 = 16 * F.wave; float tc[16];
#pragma unroll
            for (int i = 0; i < 16; ++i) { float a = (i == lane) ? 1.f : 0.f;
#pragma unroll
                for (int m = 0; m < i; ++m) a -= As[(b0 + i) * 68 + b0 + m] * tc[m];
                tc[i] = a; Tm[(b0 + i) * 68 + b0 + lane] = a; } }
        __syncthreads();
        { const int p = tid >> 8, o = tid & 255, r = o >> 4, cc = o & 15, rb = 16 + 32 * p, cbs = 32 * p; float a = 0.f;
#pragma unroll
          for (int m = 0; m < 16; ++m) a += As[(rb + r) * 68 + cbs + m] * Tm[(cbs + m) * 68 + cbs + cc];
          Tp[p * 256 + o] = a;
          __syncthreads();
          float b = 0.f;
#pragma unroll
          for (int m = 0; m < 16; ++m) b += Tm[(rb + r) * 68 + rb + m] * Tp[p * 256 + m * 16 + cc];
          __syncthreads();
          Tm[(rb + r) * 68 + cbs + cc] = -b; }
        __syncthreads();
        { float a[2];
#pragma unroll
          for (int q = 0; q < 2; ++q) { const int o = tid + 512 * q, r = o >> 5, cc = o & 31; a[q] = 0.f;
#pragma unroll 8
              for (int m = 0; m < 32; ++m) a[q] += As[(32 + r) * 68 + m] * Tm[m * 68 + cc]; }
          __syncthreads();
#pragma unroll
          for (int q = 0; q < 2; ++q) { const int o = tid + 512 * q; Tp[(o >> 5) * 36 + (o & 31)] = a[q]; }
          __syncthreads();
#pragma unroll
          for (int q = 0; q < 2; ++q) { const int o = tid + 512 * q, r = o >> 5, cc = o & 31; a[q] = 0.f;
#pragma unroll 8
              for (int m = 0; m < 32; ++m) a[q] += Tm[(32 + r) * 68 + 32 + m] * Tp[m * 36 + cc]; }
#pragma unroll
          for (int q = 0; q < 2; ++q) { const int o = tid + 512 * q; Tm[(32 + (o >> 5)) * 68 + (o & 31)] = -a[q]; } }
        __syncthreads();
        for (int idx = tid; idx < 64 * 32; idx += NTHR) { const int c = idx >> 5, s2 = (idx & 31) * 2; *(LAS unsigned*)(Tmb + c * 72 + s2) = pk2(Tm[c * 68 + s2], Tm[c * 68 + s2 + 1]); }
        __syncthreads();
        if (F.wave < 4) { const int cb = F.wave;
#pragma unroll
            for (int mb = 0; mb < 2; ++mb) { f32x16_ acc;
#pragma unroll
                for (int r = 0; r < 16; ++r) acc[r] = 0.f;
#pragma unroll
                for (int ks = 0; ks < 4; ++ks) { const bf16x8 a = *(const LAS bf16x8*)(Tmb + (32 * mb + i31) * 72 + 16 * ks + 8 * hh), b = *(const LAS bf16x8*)(Vt + (32 * cb + i31) * 72 + 16 * ks + 8 * hh);
                    acc = __builtin_amdgcn_mfma_f32_32x32x16_bf16(a, b, acc, 0, 0, 0); }
                float* up = ul + (cb * 64 + lane) * 32 + mb * 16;
#pragma unroll
                for (int q = 0; q < 4; ++q) *(GAS f32x4*)(up + 4 * q) = (f32x4){acc[4 * q], acc[4 * q + 1], acc[4 * q + 2], acc[4 * q + 3]}; }
        } else { const int db = F.wave - 4;
#pragma unroll
            for (int nb = 0; nb < 2; ++nb) { f32x16_ acc;
#pragma unroll
                for (int r = 0; r < 16; ++r) acc[r] = 0.f;
#pragma unroll
                for (int ks = 0; ks < 4; ++ks) { const bf16x8 a = *(const LAS bf16x8*)(KBt + (32 * db + i31) * 72 + 16 * ks + 8 * hh), b = *(const LAS bf16x8*)(Tmb + (32 * nb + i31) * 72 + 16 * ks + 8 * hh);
                    acc = __builtin_amdgcn_mfma_f32_32x32x16_bf16(a, b, acc, 0, 0, 0); }
                bf16* wp = (bf16*)(pk + PK_WN) + (32 * nb + i31) * 136 + 32 * db + 8 * hh;
#pragma unroll
                for (int q = 0; q < 4; ++q) *(GAS v2u*)(wp + 16 * (q >> 1) + 4 * (q & 1)) = (v2u){pk2(-acc[4 * q], -acc[4 * q + 1]), pk2(-acc[4 * q + 2], -acc[4 * q + 3])}; }
        }
    }
}
__device__ __forceinline__ void gdn_scan_helper(Frame& F) {
    const int hb = blockIdx.x - 8; if (hb < 0 || hb >= 16) return;
    const int h = hb & 7, par = hb >> 3;
    const unsigned char* PK = F.ws + WS_PK + (size_t)(h * NCHUNK) * PK_BYTES + F.tid * 16;
#pragma unroll 1
    for (int n = par; n < NCHUNK; n += 2) {
        if (n > 8) { unsigned spin = 0; while ((int)__hip_atomic_load(F.ctl + CW_SP + 64 * h, RLX_AGENT) + 8 < n && ++spin < (1u << 16)) __builtin_amdgcn_s_sleep(8); }
        v4u x[12]; const unsigned char* UL = F.ws + WS_UL + (size_t)(h * NCHUNK + n) * 32768 + F.tid * 16;
#pragma unroll
        for (int q = 0; q < 8; ++q) x[q] = *(const GAS v4u*)(PK + (size_t)n * PK_BYTES + q * 8192);
#pragma unroll
        for (int q = 0; q < 4; ++q) x[8 + q] = *(const GAS v4u*)(UL + q * 8192);
#pragma unroll
        for (int q = 0; q < 12; ++q) asm volatile("" :: "v"(x[q]));
    }
}
__device__ __forceinline__ void gdn_scan_v2(Frame& F) {
    if (blockIdx.x >= 8) return;
    const int h = blockIdx.x, lane = F.lane;
    const unsigned char* PK = F.ws + WS_PK + (size_t)(h * NCHUNK) * PK_BYTES;
    if (F.wave >= 4) {
        const int lw = F.wave - 4;
        bf16* ogb = (bf16*)(F.ws + WS_OG) + h * 128;
#pragma unroll 1
        for (int n = -1; n <= NCHUNK; ++n) {
            if (n + 1 < NCHUNK) { const unsigned char* src = PK + (size_t)(n + 1) * PK_BYTES + lane * 16; LAS unsigned char* dst = F.lds + ((n + 1) & 1) * PKL;
#pragma unroll
                for (int q = 0; q < 16; ++q) { const int p = lw + 4 * q; if (p < 61) __builtin_amdgcn_global_load_lds((const unsigned*)(src + p * 1024), (LAS unsigned*)(dst + p * 1024), 16, 0, 0); } }
            if (n >= 1) { const LAS unsigned char* ost = F.lds + OST_OFF + ((n - 1) & 1) * OST_BYTES;
#pragma unroll
                for (int it = 0; it < 4; ++it) { const int id = it * 64 + lane, row = 16 * lw + (id >> 4), c16 = id & 15;
                    const v4u v = *(const LAS v4u*)(ost + row * OST_P + c16 * 16);
                    *(GAS v4u*)(ogb + (size_t)((n - 1) * 64 + row) * 1024 + c16 * 8) = v; } }
            if (n == NCHUNK) break;
            if (n >= 1) asm volatile("s_waitcnt vmcnt(4) lgkmcnt(0)" ::: "memory");
            else asm volatile("s_waitcnt vmcnt(0) lgkmcnt(0)" ::: "memory");
            __builtin_amdgcn_s_barrier(); asm volatile("" ::: "memory");
        }
    } else {
        const int cb = F.wave, i31 = lane & 31, hh = lane >> 5;
        const float* GLg = (const float*)(F.ws + WS_GL);
        const float* ul = (const float*)(F.ws + WS_UL) + ((size_t)(h * NCHUNK) * 4 + cb) * 64 * 32 + lane * 32;
        f32x16 S[4], vn[2], O[2];
#pragma unroll
        for (int b = 0; b < 4; ++b)
#pragma unroll
            for (int r = 0; r < 16; ++r) S[b][r] = 0.f;
#pragma unroll
        for (int mb = 0; mb < 2; ++mb)
#pragma unroll
            for (int q = 0; q < 4; ++q) { const f32x4 v = *(const GAS f32x4*)(ul + mb * 16 + 4 * q); vn[mb][4 * q] = v.x; vn[mb][4 * q + 1] = v.y; vn[mb][4 * q + 2] = v.z; vn[mb][4 * q + 3] = v.w; }
        __builtin_amdgcn_s_barrier(); asm volatile("" ::: "memory");
#pragma unroll 1
        for (int n = 0; n < NCHUNK; ++n) {
            const LAS unsigned char* buf = F.lds + (n & 1) * PKL;
            const float gl = GLg[n * 8 + h];
            f32x16 un[2];
            { const float* unp = ul + (size_t)(n + 1 < NCHUNK ? n + 1 : n) * 4 * 64 * 32;
#pragma unroll
              for (int mb = 0; mb < 2; ++mb)
#pragma unroll
                  for (int q = 0; q < 4; ++q) { const f32x4 v = *(const GAS f32x4*)(unp + mb * 16 + 4 * q); un[mb][4 * q] = v.x; un[mb][4 * q + 1] = v.y; un[mb][4 * q + 2] = v.z; un[mb][4 * q + 3] = v.w; } }
            const LAS unsigned char* a136 = buf + i31 * 272 + hh * 16;
            const LAS unsigned char* a72 = buf + i31 * 144 + hh * 16;
            bf16x8 sf[8], fa[8], fb[8];
#define SC_LD136(dst, off, mb) do { _Pragma("unroll") for (int ks = 0; ks < 8; ++ks) dst[ks] = *(const LAS bf16x8*)(a136 + (off) + (mb) * 32 * 272 + ks * 32); } while (0)
            SC_LD136(fa, PK_WN, 0); SC_LD136(fb, PK_WN, 1);
#pragma unroll
            for (int b = 0; b < 4; ++b) { sf[2 * b] = cvt8(S[b], 0); sf[2 * b + 1] = cvt8(S[b], 1); }
#pragma unroll
            for (int ks = 0; ks < 8; ++ks) vn[0] = __builtin_amdgcn_mfma_f32_32x32x16_bf16(fa[ks], sf[ks], vn[0], 0, 0, 0);
            SC_LD136(fa, PK_QD, 0);
#pragma unroll
            for (int ks = 0; ks < 8; ++ks) vn[1] = __builtin_amdgcn_mfma_f32_32x32x16_bf16(fb[ks], sf[ks], vn[1], 0, 0, 0);
            SC_LD136(fb, PK_QD, 1);
#pragma unroll
            for (int mb = 0; mb < 2; ++mb)
#pragma unroll
                for (int r = 0; r < 16; ++r) O[mb][r] = 0.f;
#pragma unroll
            for (int ks = 0; ks < 8; ++ks) O[0] = __builtin_amdgcn_mfma_f32_32x32x16_bf16(fa[ks], sf[ks], O[0], 0, 0, 0);
#pragma unroll
            for (int q = 0; q < 8; ++q) fa[q] = *(const LAS bf16x8*)(a72 + PK_AQ + (q >> 2) * 32 * 144 + (q & 3) * 32);
#pragma unroll
            for (int ks = 0; ks < 8; ++ks) O[1] = __builtin_amdgcn_mfma_f32_32x32x16_bf16(fb[ks], sf[ks], O[1], 0, 0, 0);
#ifdef SCAN_PROBE
            { f32x16 dm = O[0];
#pragma unroll
              for (int rr = 0; rr < 3; ++rr)
#pragma unroll
                  for (int ks = 0; ks < 8; ++ks) dm = __builtin_amdgcn_mfma_f32_32x32x16_bf16(fb[ks], sf[ks], dm, 0, 0, 0);
              asm volatile("" :: "v"(dm)); }
#endif
#pragma unroll
            for (int q = 0; q < 8; ++q) fb[q] = *(const LAS bf16x8*)(a72 + PK_KDT + (q >> 2) * 32 * 144 + (q & 3) * 32);
            bf16x8 vf[4];
#pragma unroll
            for (int mb = 0; mb < 2; ++mb) { vf[2 * mb] = cvt8(vn[mb], 0); vf[2 * mb + 1] = cvt8(vn[mb], 1); }
            vn[0] = un[0]; vn[1] = un[1];
#pragma unroll
            for (int q = 0; q < 8; ++q) O[q >> 2] = __builtin_amdgcn_mfma_f32_32x32x16_bf16(fa[q], vf[q & 3], O[q >> 2], 0, 0, 0);
#pragma unroll
            for (int q = 0; q < 8; ++q) fa[q] = *(const LAS bf16x8*)(a72 + PK_KDT + (2 + (q >> 2)) * 32 * 144 + (q & 3) * 32);
            if (cb == 0 && lane == 0) __hip_atomic_store(F.ctl + CW_SP + 64 * h, (unsigned)(n + 1), RLX_AGENT);
#pragma unroll
            for (int b = 0; b < 2; ++b) { S[b] = S[b] * gl;
#pragma unroll
                for (int ks = 0; ks < 4; ++ks) S[b] = __builtin_amdgcn_mfma_f32_32x32x16_bf16(fb[4 * b + ks], vf[ks], S[b], 0, 0, 0); }
            { LAS bf16* ost = (LAS bf16*)(F.lds + OST_OFF + (n & 1) * OST_BYTES) + cb * 32 + i31;
#pragma unroll
              for (int mb = 0; mb < 2; ++mb)
#pragma unroll
                  for (int r = 0; r < 16; ++r) ost[(32 * mb + (r & 3) + 8 * (r >> 2) + 4 * hh) * (OST_P / 2)] = (bf16)(pk2(O[mb][r], 0.f) & 0xffffu); }
#pragma unroll
            for (int b = 2; b < 4; ++b) { S[b] = S[b] * gl;
#pragma unroll
                for (int ks = 0; ks < 4; ++ks) S[b] = __builtin_amdgcn_mfma_f32_32x32x16_bf16(fa[4 * (b - 2) + ks], vf[ks], S[b], 0, 0, 0); }
#undef SC_LD136
            asm volatile("s_waitcnt lgkmcnt(0)" ::: "memory"); __builtin_amdgcn_s_barrier(); asm volatile("" ::: "memory");
        }
    }
}
__device__ __forceinline__ void gdn_norm(Frame& F) {
    const bf16* og = (const bf16*)(F.ws + WS_OG); const bf16* Pz = (const bf16*)(F.ws + WS_P) + 6 * PBUF; bf16* yb = (bf16*)(F.ws + WS_YB);
    const int lane = F.lane, col = lane * 16;
    for (int tok = F.vcu * NWAVES + F.wave; tok < T; tok += F.G * NWAVES) {
        const size_t o = (size_t)tok * 1024 + col; float v[16], ss = 0.f;
        { const v4u x0 = *(const GAS v4u*)(og + o), x1 = *(const GAS v4u*)(og + o + 8); const unsigned xw[8] = {x0.x, x0.y, x0.z, x0.w, x1.x, x1.y, x1.z, x1.w};
#pragma unroll
          for (int q = 0; q < 8; ++q) { v[2 * q] = bflo(xw[q]); v[2 * q + 1] = bfhi(xw[q]); ss += v[2 * q] * v[2 * q] + v[2 * q + 1] * v[2 * q + 1]; } }
        ss += __shfl_xor(ss, 1); ss += __shfl_xor(ss, 2); ss += __shfl_xor(ss, 4);
        const float r = rsqrtf(ss * (1.f / 128.f) + NORM_EPS);
        const v4u z0 = *(const GAS v4u*)(Pz + o), z1 = *(const GAS v4u*)(Pz + o + 8);
        const float zz[16] = {bflo(z0.x), bfhi(z0.x), bflo(z0.y), bfhi(z0.y), bflo(z0.z), bfhi(z0.z), bflo(z0.w), bfhi(z0.w), bflo(z1.x), bfhi(z1.x), bflo(z1.y), bfhi(z1.y), bflo(z1.z), bfhi(z1.z), bflo(z1.w), bfhi(z1.w)};
        unsigned w[8];
#pragma unroll
        for (int x = 0; x < 8; ++x) { const int c0 = (col & 127) + 2 * x; w[x] = pk2(v[2 * x] * r * F.in[5][c0] * siluf_(zz[2 * x]), v[2 * x + 1] * r * F.in[5][c0 + 1] * siluf_(zz[2 * x + 1])); }
        *(GAS v4u*)(yb + o) = (v4u){w[0], w[1], w[2], w[3]}; *(GAS v4u*)(yb + o + 8) = (v4u){w[4], w[5], w[6], w[7]};
    }
}

__device__ __forceinline__ void ln_router(Frame& F) {
    constexpr int XS = 2052;
    LAS float* X1s = (LAS float*)F.lds;
    LAS float* LG = (LAS float*)(F.lds + 131584);
    LAS int* hist = (LAS int*)(LG + 1024);
    LAS int* gbs = hist + 64;
    const float* y1 = (const float*)(F.ws + WS_Y1); float* x1f = (float*)(F.ws + WS_X1F); bf16* x1b = (bf16*)(F.ws + WS_X1B);
    int* tokl = (int*)(F.ws + WS_TOKL); float* wgtl = (float*)(F.ws + WS_WGTL); unsigned* info = (unsigned*)(F.ws + WS_INFO);
    const float* g1 = F.in[12]; const float* b1 = F.in[13]; const float* wr = F.in[14]; const float* rb = F.in[15];
    const int tid = F.tid, lane = F.lane;
    for (int blk = blockIdx.x; blk < T / 16; blk += F.G) {
        const int tb = blk * 16;
        __syncthreads();
        if (tid < 64) hist[tid] = 0;
        for (int rep8 = 0; rep8 < (DUP_PHASE == 8 ? 2 : 1); ++rep8) { if (rep8) __syncthreads();
#pragma unroll 1
        for (int tt = 0; tt < 2; ++tt) { const int tl = F.wave * 2 + tt, tok = tb + tl;
            const GAS f32x4* yr = (const GAS f32x4*)(y1 + (size_t)tok * D) + lane; f32x4 v[8]; float s = 0.f;
#pragma unroll
            for (int j = 0; j < 8; ++j) { v[j] = yr[64 * j]; s += (v[j].x + v[j].y) + (v[j].z + v[j].w); }
            const float mean = wave_sum(s) * (1.f / D); float s2 = 0.f;
#pragma unroll
            for (int j = 0; j < 8; ++j) { v[j] = v[j] - mean; s2 += (v[j].x * v[j].x + v[j].y * v[j].y) + (v[j].z * v[j].z + v[j].w * v[j].w); }
            const float rstd = rsqrtf(wave_sum(s2) * (1.f / D) + LN_EPS);
#pragma unroll
            for (int j = 0; j < 8; ++j) { const int col = j * 256 + lane * 4; const f32x4 gg = *(const GAS f32x4*)(g1 + col), bb = *(const GAS f32x4*)(b1 + col);
                const f32x4 xo = v[j] * rstd * gg + bb;
                *(GAS f32x4*)(x1f + (size_t)tok * D + col) = xo; *(GAS v2u*)(x1b + (size_t)tok * D + col) = (v2u){pk2(xo.x, xo.y), pk2(xo.z, xo.w)};
                *(LAS f32x4*)(X1s + tl * XS + col) = xo; }
            if (lane == 0) { tokl[NE * T + tok] = tok; wgtl[NE * T + tok] = 1.f; } }
        __syncthreads();
        { const int eg = lane & 15, tg = lane >> 4; f32x4 acc[4];
#pragma unroll
          for (int ti = 0; ti < 4; ++ti) acc[ti] = (f32x4){0.f, 0.f, 0.f, 0.f};
          const float* wp = wr + (size_t)(256 * F.wave) * NE + 4 * eg; const LAS float* xp = X1s + (4 * tg) * XS + 256 * F.wave;
#pragma unroll 4
          for (int d0 = 0; d0 < 256; d0 += 4) { f32x4 xv[4], wv[4];
#pragma unroll
              for (int dd = 0; dd < 4; ++dd) wv[dd] = *(const GAS f32x4*)(wp + (size_t)(d0 + dd) * NE);
#pragma unroll
              for (int ti = 0; ti < 4; ++ti) xv[ti] = *(const LAS f32x4*)(xp + ti * XS + d0);
#pragma unroll
              for (int ti = 0; ti < 4; ++ti) { acc[ti] = acc[ti] + wv[0] * xv[ti].x; acc[ti] = acc[ti] + wv[1] * xv[ti].y; acc[ti] = acc[ti] + wv[2] * xv[ti].z; acc[ti] = acc[ti] + wv[3] * xv[ti].w; } }
          __syncthreads();
#pragma unroll
          for (int ti = 0; ti < 4; ++ti) *(LAS f32x4*)(X1s + ((F.wave * 16 + 4 * tg + ti) * 64 + 4 * eg)) = acc[ti];
          __syncthreads();
          { const int o = tid * 2; float a0 = 0.f, a1 = 0.f;
#pragma unroll
            for (int w = 0; w < 8; ++w) { const f32x2 p = *(const LAS f32x2*)(X1s + w * 1024 + o); a0 += p.x; a1 += p.y; }
            LG[o] = a0; LG[o + 1] = a1; } }
        __syncthreads();
        }
        bool sel[2]; int loc[2]; float wsl[2]; unsigned long long msk[2];
#pragma unroll
        for (int tt = 0; tt < 2; ++tt) { const int tl = F.wave * 2 + tt;
            const float score = 1.f / (1.f + expf(-LG[tl * 64 + lane])), ch = score + rb[lane];
            int rk = 0;
#pragma unroll
            for (int x = 1; x < 8; ++x) { const float cj = __shfl_xor(ch, x); rk += (cj > ch || (cj == ch && (lane ^ x) < lane)) ? 1 : 0; }
            float gs = rk < 2 ? ch : 0.f; gs += __shfl_xor(gs, 1); gs += __shfl_xor(gs, 2); gs += __shfl_xor(gs, 4);
            const int g = lane >> 3; int grk = 0;
#pragma unroll
            for (int x = 1; x < 8; ++x) { const float gj = __shfl_xor(gs, 8 * x); grk += (gj > gs || (gj == gs && (g ^ x) < g)) ? 1 : 0; }
            const float mk = grk < 4 ? ch : -INFINITY; int erk = 0;
#pragma unroll
            for (int j = 0; j < 64; ++j) { const float mj = __builtin_bit_cast(float, __builtin_amdgcn_readlane(__builtin_bit_cast(int, mk), j)); erk += (mj > mk || (mj == mk && j < lane)) ? 1 : 0; }
            sel[tt] = (grk < 4) && (erk < TOPK);
            const float ssum = wave_sum(sel[tt] ? score : 0.f); wsl[tt] = score / ssum * ROUTED_SCALE;
            msk[tt] = __ballot(sel[tt]);
            loc[tt] = sel[tt] ? atomicAdd((int*)&hist[lane], 1) : 0; }
        __syncthreads();
        if (tid < 64) { const int hc = hist[tid]; gbs[tid] = hc ? (int)__hip_atomic_fetch_add(F.ctl + CW_CNT + 64 * tid, (unsigned)hc, RLX_AGENT) : 0; }
        __syncthreads();
#pragma unroll
        for (int tt = 0; tt < 2; ++tt) if (sel[tt]) { const int tok = tb + F.wave * 2 + tt, slot = gbs[lane] + loc[tt];
            tokl[lane * T + slot] = tok; wgtl[lane * T + slot] = wsl[tt];
            const int k = __popcll(msk[tt] & ((1ull << lane) - 1ull)); info[tok * 8 + k] = ((unsigned)lane << 16) | (unsigned)slot; info[T * 8 + tok * 8 + k] = __builtin_bit_cast(unsigned, wsl[tt]); }
    }
}
__device__ __forceinline__ void final_ln(Frame& F) {
    moe_tables(F, 0, 0);
    const LAS int* rbase = (const LAS int*)(F.lds + LDS_TAB) + 72;
    const float* x1f = (const float*)(F.ws + WS_X1F); const bf16* yas = (const bf16*)(F.ws + WS_YAS); const unsigned* info = (const unsigned*)(F.ws + WS_INFO);
    const float* g2 = F.in[22]; const float* b2 = F.in[23];
    const int lane = F.lane;
    for (int tok = F.vcu * NWAVES + F.wave; tok < T; tok += F.G * NWAVES) {
        f32x4 v[8];
        const GAS f32x4* xr = (const GAS f32x4*)(x1f + (size_t)tok * D) + lane;
#pragma unroll
        for (int j = 0; j < 8; ++j) v[j] = xr[64 * j] * ALPHA;
        const v4u i0 = *(const GAS v4u*)(info + tok * 8), i1 = *(const GAS v4u*)(info + tok * 8 + 4);
        const unsigned iw[8] = {i0.x, i0.y, i0.z, i0.w, i1.x, i1.y, i1.z, i1.w};
        int rows[9];
#pragma unroll
        for (int k = 0; k < 8; ++k) rows[k] = rbase[iw[k] >> 16] + (int)(iw[k] & 0xffffu);
        rows[8] = 65536 + tok;
        const v4u g0 = *(const GAS v4u*)(info + T * 8 + tok * 8), g1 = *(const GAS v4u*)(info + T * 8 + tok * 8 + 4);
        const float gw[9] = {__builtin_bit_cast(float, g0.x), __builtin_bit_cast(float, g0.y), __builtin_bit_cast(float, g0.z), __builtin_bit_cast(float, g0.w), __builtin_bit_cast(float, g1.x), __builtin_bit_cast(float, g1.y), __builtin_bit_cast(float, g1.z), __builtin_bit_cast(float, g1.w), 1.f};
#pragma unroll
        for (int kb = 0; kb < 3; ++kb) { v2u w[3][8];
#pragma unroll
            for (int kk = 0; kk < 3; ++kk) { const GAS v2u* yr = (const GAS v2u*)(yas + (size_t)rows[3 * kb + kk] * D) + lane;
#pragma unroll
                for (int j = 0; j < 8; ++j) w[kk][j] = yr[64 * j]; }
#pragma unroll
            for (int kk = 0; kk < 3; ++kk)
#pragma unroll
                for (int j = 0; j < 8; ++j) v[j] = v[j] + (f32x4){bflo(w[kk][j].x), bfhi(w[kk][j].x), bflo(w[kk][j].y), bfhi(w[kk][j].y)}; }
        float s = 0.f;
#pragma unroll
        for (int j = 0; j < 8; ++j) s += (v[j].x + v[j].y) + (v[j].z + v[j].w);
        const float mean = wave_sum(s) * (1.f / D); float s2 = 0.f;
#pragma unroll
        for (int j = 0; j < 8; ++j) { v[j] = v[j] - mean; s2 += (v[j].x * v[j].x + v[j].y * v[j].y) + (v[j].z * v[j].z + v[j].w * v[j].w); }
        const float rstd = rsqrtf(wave_sum(s2) * (1.f / D) + LN_EPS);
#pragma unroll
        for (int j = 0; j < 8; ++j) { const int col = j * 256 + lane * 4; const f32x4 gg = *(const GAS f32x4*)(g2 + col), bb = *(const GAS f32x4*)(b2 + col);
            *(GAS f32x4*)(F.out + (size_t)tok * D + col) = v[j] * rstd * gg + bb; }
    }
}

struct Args { const float* in[24]; float* out; unsigned char* ws; int ph_lo, ph_hi; };
__global__ void __launch_bounds__(NTHR, 2) fwd(Args args) {
    extern __shared__ __attribute__((aligned(16))) unsigned char lds[];
    Frame F;
    F.lds = (LAS unsigned char*)lds;
    F.tid = threadIdx.x; F.lane = F.tid & 63; F.wave = __builtin_amdgcn_readfirstlane(F.tid >> 6);
    F.G = gridDim.x; { const int bx = blockIdx.x; F.vcu = (F.G % 8 == 0) ? (bx % 8) * (F.G / 8) + bx / 8 : bx; }
    F.ws = args.ws; F.ctl = (gu32*)(args.ws + WS_CTL); F.out = args.out;
#pragma unroll
    for (int i = 0; i < 24; ++i) F.in[i] = args.in[i];
    volatile LAS unsigned* MISC = (volatile LAS unsigned*)(F.lds + MISC_OFF);
    if (F.tid < 64) MISC[F.tid] = 0u;
    __syncthreads();
    const int lo = args.ph_lo, hi = args.ph_hi;
    const bool multi = (hi - lo) > 1;
    XcdBarrier bar; bar.bar = (unsigned*)(F.ctl + CW_BAR); bar.x = 0; bar.st = nullptr;
    if (multi) bar = xcd_barrier_post((unsigned*)(F.ctl + CW_BAR), MISC + 8);
#ifndef ONLY_PHASE
#define ONLY_PHASE -1
#endif
#define IN(k) ((ONLY_PHASE < 0 || ONLY_PHASE == (k)) && lo <= (k) && (k) < hi)
#define SEAM(k) do { if (IN(k) && IN((k) + 1)) xcd_barrier(bar); } while (0)
    unsigned char* ws = args.ws;
#define DUPBAR() do { VM_WAIT(); if (multi) xcd_barrier(bar); else __syncthreads(); } while (0)
    if (IN(0)) { p0_prologue(F); if (DUP_PHASE == 0) { __syncthreads(); p0_prologue(F); } SEAM(0); }
    if (IN(1)) {

        pg8::Gemm g{(const bf16*)(ws + WS_XB), (const bf16*)(ws + WS_WIN), T, NPROJ, D}; pg8::StaticOrder S; S.init(T, NPROJ, F.G, (int)blockIdx.x);
        EpiProj E{(bf16*)(ws + WS_P)};
        pg8::gemm_phase<EpiProj, pg8::StaticOrder, true, false>(F.lds, g, S, E);
        if (DUP_PHASE == 1) { VM_WAIT(); __syncthreads(); pg8::gemm_phase<EpiProj, pg8::StaticOrder, true, false>(F.lds, g, S, E); }
        if ((int)blockIdx.x >= 128 && F.G == 256) p0_items(F, P0_NITEMS - P1_TAIL_ITEMS, P0_NITEMS, ((int)blockIdx.x - 128) * NWAVES + F.wave, 128 * NWAVES);
        else if (F.G != 256) p0_items(F, P0_NITEMS - P1_TAIL_ITEMS, P0_NITEMS, F.vcu * NWAVES + F.wave, F.G * NWAVES);
        SEAM(1);
    }
    if (IN(2)) { gdn_prep_v2(F); if (DUP_PHASE == 2) { __syncthreads(); gdn_prep_v2(F); } SEAM(2); }
    if (IN(3)) { gdn_scan_v2(F); gdn_scan_helper(F); __syncthreads(); attn_v2<0>(F); if (DUP_PHASE == 3) { xcd_barrier(bar); attn_v2<64>(F); } SEAM(3); }
    if (IN(4)) { gdn_norm(F); if (DUP_PHASE == 4) { __syncthreads(); gdn_norm(F); } SEAM(4); }
    if (IN(6)) {

        { pg8::Gemm g{(const bf16*)(ws + WS_YA), (const bf16*)(ws + WS_WA), T, D, 1024}; pg8::StaticOrder S; S.init(T, D, F.G, (int)blockIdx.x);
          EpiBranch<0> E{(const bf16*)(ws + WS_P) + 7 * PBUF, (float*)(ws + WS_TMP), (bf16*)(ws + WS_MRG)};
          pg8::gemm_phase<EpiBranch<0>, pg8::StaticOrder, true, false>(F.lds, g, S, E); }
        VM_WAIT(); __syncthreads();
        { pg8::Gemm g{(const bf16*)(ws + WS_YB), (const bf16*)(ws + WS_WB), T, D, 1024}; pg8::StaticOrder S; S.init(T, D, F.G, (int)blockIdx.x);
          EpiBranch<1> E{(const bf16*)(ws + WS_P) + 9 * PBUF, (float*)(ws + WS_TMP), (bf16*)(ws + WS_MRG)};
          pg8::gemm_phase<EpiBranch<1>, pg8::StaticOrder, true, false>(F.lds, g, S, E); }
        SEAM(6);
    }
    if (IN(7)) {

        pg8::Gemm g{(const bf16*)(ws + WS_MRG), (const bf16*)(ws + WS_WO), T, D, D}; pg8::StaticOrder S; S.init(T, D, F.G, (int)blockIdx.x);
        EpiOut E{F.in[0], (float*)(ws + WS_Y1)};
        pg8::gemm_phase<EpiOut, pg8::StaticOrder, true, false>(F.lds, g, S, E);
        if (DUP_PHASE == 7) { VM_WAIT(); __syncthreads(); pg8::gemm_phase<EpiOut, pg8::StaticOrder, true, false>(F.lds, g, S, E); }
        SEAM(7);
    }
    if (IN(8)) { ln_router(F); SEAM(8); }
    if (IN(9)) {

        moe_tables(F, 4, 1024);
        MoeOrder S{(const LAS int*)(F.lds + LDS_TAB + 1024), (const int*)(ws + WS_TOKL)};
        pg8::Gemm g{(const bf16*)(ws + WS_X1B), (const bf16*)(ws + WS_WGU), T, 1024, D};
        EpiGU E{(bf16*)(ws + WS_HB)};
        pg8::gemm_phase<EpiGU, MoeOrder, true, true>(F.lds, g, S, E);
        if (DUP_PHASE == 9) { VM_WAIT(); __syncthreads(); pg8::gemm_phase<EpiGU, MoeOrder, true, true>(F.lds, g, S, E); }
        SEAM(9);
    }
    if (IN(10)) {

        moe_tables(F, 8, D);
        MoeOrder S{(const LAS int*)(F.lds + LDS_TAB + 1024), (const int*)(ws + WS_TOKL)};
        pg8::Gemm g{(const bf16*)(ws + WS_HB), (const bf16*)(ws + WS_WD), T, D, FF};
        EpiDown E{(bf16*)(ws + WS_YAS), (const float*)(ws + WS_WGTL)};
        pg8::gemm_phase<EpiDown, MoeOrder, true, false>(F.lds, g, S, E);
        if (DUP_PHASE == 10) { VM_WAIT(); __syncthreads(); pg8::gemm_phase<EpiDown, MoeOrder, true, false>(F.lds, g, S, E); }
        SEAM(10);
    }
    if (IN(11)) { final_ln(F); if (DUP_PHASE == 11) { VM_WAIT(); __syncthreads(); final_ln(F); } }
#undef IN
#undef SEAM
}

extern "C" void kernel_launch(void* const* d_in, const int* in_sizes, int n_in, void* d_out, int out_size, void* d_ws, size_t ws_size, hipStream_t stream) {
    static int grid = 0;
    if (grid == 0) {
        if (n_in != 24 || in_sizes[0] != T * D || out_size != T * D || ws_size < WS_END) { fprintf(stderr, "kernel_launch: unexpected shapes (n_in %d, ws %zu); nothing launched\n", n_in, ws_size); grid = -1; return; }
        int dev = 0, cus = 0, per_cu = 0;
        if (hipGetDevice(&dev) != hipSuccess || hipDeviceGetAttribute(&cus, hipDeviceAttributeMultiprocessorCount, dev) != hipSuccess) { grid = -1; return; }
        if (hipFuncSetAttribute((const void*)fwd, hipFuncAttributeMaxDynamicSharedMemorySize, LDS_BYTES) != hipSuccess) { fprintf(stderr, "kernel_launch: hipFuncSetAttribute failed\n"); grid = -1; return; }
        if (hipOccupancyMaxActiveBlocksPerMultiprocessor(&per_cu, (const void*)fwd, NTHR, LDS_BYTES) != hipSuccess || per_cu < 1) { fprintf(stderr, "kernel_launch: occupancy query says %d\n", per_cu); }
        (void)hipGetLastError();
        grid = cus;
    }
    if (grid < 0) return;
    if (hipMemsetAsync((char*)d_ws + WS_CTL, 0, CTL_ZERO_BYTES, stream) != hipSuccess) return;
    Args a{};
    for (int i = 0; i < 24; ++i) a.in[i] = (const float*)d_in[i];
    a.out = (float*)d_out; a.ws = (unsigned char*)d_ws;
#if MK_N_LAUNCHES == 1
    a.ph_lo = 0; a.ph_hi = NPHASE;
    hipLaunchKernelGGL(fwd, dim3(grid), dim3(NTHR), LDS_BYTES, stream, a);
#else
    for (int p = 0; p < NPHASE; ++p) { a.ph_lo = p; a.ph_hi = p + 1; hipLaunchKernelGGL(fwd, dim3(grid), dim3(NTHR), LDS_BYTES, stream, a); }
#endif
}
```

```cpp
#include <hip/hip_runtime.h>
#include <cstdio>
#include <cstdint>

#ifndef MK_N_LAUNCHES
#define MK_N_LAUNCHES 1
#endif

namespace pg8 {
#define PG8_LAS __attribute__((address_space(3)))
typedef unsigned short bf16_t;
typedef short bf16x8 __attribute__((ext_vector_type(8)));
typedef float f32x4 __attribute__((ext_vector_type(4)));
typedef unsigned u32x4 __attribute__((ext_vector_type(4)));
typedef unsigned u32x2 __attribute__((ext_vector_type(2)));
constexpr int BM = 256, BK = 64, HALF = 128, HTB = HALF * BK * 2  , STAGE_BYTES = 8 * HTB, NXCD = 8, WGM = 8;

__host__ __device__ __forceinline__ int lds_byte(int r, int c) { const int st = (r >> 4) * 2 + (c >> 5), rr = r & 15, cc = c & 31, ob = rr * 64 + cc * 2; return st * 1024 + (ob ^ (((ob >> 9) & 1) << 5)); }
__host__ __device__ __forceinline__ void stage_rc(int b, int& R, int& C) { const int st = b / 1024, sb = b % 1024, swz = sb ^ (((sb >> 9) & 1) << 5); R = (st >> 1) * 16 + swz / 64; C = (st & 1) * 32 + (swz % 64) / 2; }
__host__ __device__ __forceinline__ int perm32(int rho) { const int n = rho >> 4, i = rho & 15; return 8 * (i >> 2) + 4 * n + (i & 3); }

struct Unit { int pm, pn, arow, brow, r0, nv, e, lb; };
struct Gemm { const bf16_t* A; const bf16_t* Bt; int M, N, K; };

struct StaticOrder {
    int nM, nN, nwg, G, c;
    __host__ __device__ void init(int M, int N, int G_, int c_) { nM = M / BM; nN = N / BM; nwg = nM * nN; G = G_; c = c_; }
    __host__ __device__ bool next(int i, Unit& u) const {
        const long L = (long)i * G + c; if (L >= nwg) return false;
        int wgid = (int)L; { const int q = nwg / NXCD, r = nwg % NXCD, xcd = wgid % NXCD, off = wgid / NXCD; wgid = (xcd < r ? xcd * (q + 1) : r * (q + 1) + (xcd - r) * q) + off; }
        const int nig = WGM * nN, gid = wgid / nig, fm = gid * WGM, gsz = (nM - fm) < WGM ? (nM - fm) : WGM;
        u.pm = fm + ((wgid % nig) % gsz); u.pn = (wgid % nig) / gsz; u.arow = u.pm * BM; u.brow = u.pn * BM; u.r0 = u.arow; u.nv = BM; u.e = 0; u.lb = 0; return true;
    }
    __device__ __forceinline__ int row_of(const Unit&, int) const { return 0; }
};

__device__ __forceinline__ unsigned cvt_pk_bf16(float lo, float hi) { unsigned r; asm volatile("v_cvt_pk_bf16_f32 %0, %1, %2" : "=v"(r) : "v"(lo), "v"(hi)); return r; }

template <class Epi, class Sched, bool ALIGN_EPI, bool GATHER>
__device__ __forceinline__ void gemm_phase(PG8_LAS unsigned char* lds, const Gemm g, const Sched& S, const Epi& E) {
    static_assert(Epi::PERM, "epilogues use the PERM column layout");
    const int tid = threadIdx.x, wid = __builtin_amdgcn_readfirstlane(tid >> 6), lane = tid & 63, wr = wid >> 2, wc = wid & 3, fr = lane & 15, fq = lane >> 4;
    const int K = g.K, nt = K / BK;
    unsigned voffA[2], voffB[2]; int stR[2], stC[2];
#pragma unroll
    for (int i = 0; i < 2; ++i) { int R, C; stage_rc(tid * 16 + i * 8192, R, C); const int Rb = (R & ~31) + perm32(R & 31); stR[i] = R; stC[i] = C;
        voffA[i] = (unsigned)(R * K + C) * 2u; voffB[i] = (unsigned)(Rb * K + C) * 2u; }
    const size_t kstep = (size_t)(BK * 2);
    const size_t hstep = (size_t)HALF * K * 2;
    const size_t rstep = (size_t)K * 2;
    const unsigned ldsw = (unsigned)wid * 1024u;
    const int aoff = lds_byte(wr * 64 + fr, fq * 8), boff = lds_byte(wc * 32 + fr, fq * 8);
#define PG8_SA(b, h) (((b) * 2 + (h)) * HTB)
#define PG8_SB(b, h) ((4 + (b) * 2 + (h)) * HTB)
#define PG8_STAGE(bufoff, gbase, voff) do { _Pragma("unroll") for (int _i = 0; _i < 2; ++_i) \
        __builtin_amdgcn_global_load_lds((const unsigned*)((const char*)(gbase) + (voff)[_i]), (PG8_LAS unsigned*)(lds + (bufoff) + ldsw + _i * 8192), 16, 0, 0); } while (0)
#define PG8_STAGE_A(b, h, P, V) do { if constexpr (GATHER) { PG8_STAGE(PG8_SA(b, h), P, V[h]); } else { PG8_STAGE(PG8_SA(b, h), (P) + (h) * hstep, voffA); } } while (0)
#define PG8_LDA(dst, b, h) do { _Pragma("unroll") for (int m = 0; m < 4; ++m) _Pragma("unroll") for (int k = 0; k < 2; ++k) dst[m][k] = *(const PG8_LAS bf16x8*)(lds + PG8_SA(b, h) + aoff + m * 2048 + k * 1024); } while (0)
#define PG8_LDB(dst, b, h) do { _Pragma("unroll") for (int n = 0; n < 2; ++n) _Pragma("unroll") for (int k = 0; k < 2; ++k) dst[n][k] = *(const PG8_LAS bf16x8*)(lds + PG8_SB(b, h) + boff + n * 2048 + k * 1024); } while (0)
#define PG8_MMA(ai, bj, At, Bt) do { __builtin_amdgcn_s_setprio(1); _Pragma("unroll") for (int m = 0; m < 4; ++m) _Pragma("unroll") for (int n = 0; n < 2; ++n) _Pragma("unroll") for (int k = 0; k < 2; ++k) \
        acc[ai][bj][m][n] = __builtin_amdgcn_mfma_f32_16x16x32_bf16(Bt[n][k], At[m][k], acc[ai][bj][m][n], 0, 0, 0); __builtin_amdgcn_s_setprio(0); } while (0)
#define PG8_WAIT_V(n) asm volatile("s_waitcnt vmcnt(" #n ")" ::: "memory")
#define PG8_WAIT_L(n) asm volatile("s_waitcnt lgkmcnt(" #n ")" ::: "memory")
#define PG8_BAR __builtin_amdgcn_s_barrier()
#define PG8_SCHED __builtin_amdgcn_sched_barrier(0)
#define PG8_GOFF(V, u) do { if constexpr (GATHER) { _Pragma("unroll") for (int _h = 0; _h < 2; ++_h) _Pragma("unroll") for (int _i = 0; _i < 2; ++_i) \
        V[_h][_i] = (unsigned)(S.row_of(u, _h * HALF + stR[_i]) * K + stC[_i]) * 2u; } } while (0)
    Unit cur, nxt; int ui = 0;
    if (!S.next(0, cur)) return;
    f32x4 acc[2][2][4][2];
#pragma unroll
    for (int a = 0; a < 2; ++a)
#pragma unroll
        for (int b = 0; b < 2; ++b)
#pragma unroll
            for (int m = 0; m < 4; ++m)
#pragma unroll
                for (int n = 0; n < 2; ++n) acc[a][b][m][n] = (f32x4){0.f, 0.f, 0.f, 0.f};
    bf16x8 At[4][2], B0[2][2], B1[2][2];
    unsigned vcur[2][2] = {{0u, 0u}, {0u, 0u}}, vnxt[2][2] = {{0u, 0u}, {0u, 0u}}, v2[2][2] = {{0u, 0u}, {0u, 0u}};
    PG8_GOFF(vcur, cur);
    const char* cA = GATHER ? (const char*)g.A : (const char*)g.A + (size_t)cur.arow * rstep; const char* cB = (const char*)g.Bt + (size_t)cur.brow * rstep;
    PG8_STAGE(PG8_SB(0, 0), cB, voffB); PG8_STAGE(PG8_SB(0, 1), cB + hstep, voffB); PG8_STAGE_A(0, 0, cA, vcur); PG8_STAGE_A(0, 1, cA, vcur);
    if (wr == 1) PG8_BAR;
    PG8_WAIT_V(2); PG8_BAR;
    PG8_STAGE(PG8_SB(1, 0), cB + kstep, voffB); PG8_STAGE_A(1, 0, cA + kstep, vcur); PG8_STAGE(PG8_SB(1, 1), cB + hstep + kstep, voffB);
    PG8_WAIT_V(6); PG8_BAR;
    for (;;) {
        const bool has_next = S.next(ui + 1, nxt);
        if constexpr (GATHER) { if (has_next) { PG8_GOFF(vnxt, nxt); } else {
#pragma unroll
            for (int h = 0; h < 2; ++h)
#pragma unroll
                for (int i = 0; i < 2; ++i) vnxt[h][i] = vcur[h][i]; } }
        const char* nA = GATHER ? cA : (has_next ? (const char*)g.A + (size_t)nxt.arow * rstep : cA); const char* nB = has_next ? (const char*)g.Bt + (size_t)nxt.brow * rstep : cB;
        for (int t = 0; t < nt; t += 2) {
            const bool last = (t == nt - 2);
            const char* a1 = cA + (size_t)(t + 1) * kstep;
            const char* a2 = last ? nA : cA + (size_t)(t + 2) * kstep; const char* b2 = last ? nB : cB + (size_t)(t + 2) * kstep;
            const char* a3 = a2 + kstep; const char* b3 = b2 + kstep;
            if constexpr (GATHER) {
#pragma unroll
                for (int h = 0; h < 2; ++h)
#pragma unroll
                    for (int i = 0; i < 2; ++i) v2[h][i] = last ? vnxt[h][i] : vcur[h][i]; }
            PG8_LDB(B0, 0, 0); PG8_LDB(B1, 0, 1); PG8_SCHED; PG8_LDA(At, 0, 0); PG8_STAGE_A(1, 1, a1, vcur);
            PG8_WAIT_V(8); PG8_WAIT_L(0); PG8_BAR; PG8_MMA(0, 0, At, B0); PG8_MMA(0, 1, At, B1); PG8_BAR; PG8_SCHED;
            PG8_LDA(At, 0, 1); PG8_STAGE(PG8_SB(0, 0), b2, voffB); PG8_STAGE(PG8_SB(0, 1), b2 + hstep, voffB); PG8_STAGE_A(0, 0, a2, v2);
            PG8_WAIT_V(8); PG8_WAIT_L(0); PG8_BAR; PG8_MMA(1, 0, At, B0); PG8_MMA(1, 1, At, B1); PG8_BAR; PG8_SCHED;
            PG8_LDB(B0, 1, 0); PG8_LDB(B1, 1, 1); PG8_SCHED; PG8_LDA(At, 1, 0); PG8_STAGE_A(0, 1, a2, v2);
            PG8_WAIT_V(8); PG8_WAIT_L(0); PG8_BAR; PG8_MMA(0, 0, At, B0); PG8_MMA(0, 1, At, B1); PG8_BAR; PG8_SCHED;
            PG8_LDA(At, 1, 1); PG8_STAGE(PG8_SB(1, 0), b3, voffB); PG8_STAGE(PG8_SB(1, 1), b3 + hstep, voffB); PG8_STAGE_A(1, 0, a3, v2);
            PG8_WAIT_V(8); PG8_WAIT_L(0); PG8_BAR; PG8_MMA(1, 0, At, B0); PG8_MMA(1, 1, At, B1); PG8_BAR; PG8_SCHED;
        }
        if constexpr (ALIGN_EPI) { if (wr == 0) PG8_BAR; }
        E(acc, cur, wr, wc, fr, fq);
        if (!has_next) break;
#pragma unroll
        for (int a = 0; a < 2; ++a)
#pragma unroll
            for (int b = 0; b < 2; ++b)
#pragma unroll
                for (int m = 0; m < 4; ++m)
#pragma unroll
                    for (int n = 0; n < 2; ++n) acc[a][b][m][n] = (f32x4){0.f, 0.f, 0.f, 0.f};
        cur = nxt; cA = nA; cB = nB; ++ui;
        if constexpr (GATHER) {
#pragma unroll
            for (int h = 0; h < 2; ++h)
#pragma unroll
                for (int i = 0; i < 2; ++i) vcur[h][i] = vnxt[h][i]; }
        if constexpr (ALIGN_EPI) { if (wr == 1) PG8_BAR; }
    }
    PG8_WAIT_V(0);
    if constexpr (!ALIGN_EPI) { if (wr == 0) PG8_BAR; }
    PG8_BAR;
#undef PG8_SA
#undef PG8_SB
#undef PG8_STAGE
#undef PG8_STAGE_A
#undef PG8_LDA
#undef PG8_LDB
#undef PG8_MMA
#undef PG8_WAIT_V
#undef PG8_WAIT_L
#undef PG8_BAR
#undef PG8_SCHED
#undef PG8_GOFF
}
}

constexpr int NWAVES = 8, NTHR = 512;
constexpr int T = 8192, D = 2048, NPROJ = 11264, WIN_PITCH = 11280, NH = 8, NE = 64, NEX = 65, FF = 512, TOPK = 8, NCHUNK = 128;
constexpr float ALPHA = 1.18920711500272106672f, LN_EPS = 1e-5f, NORM_EPS = 1e-6f, LAMBDA_INIT = 0.2f, ROUTED_SCALE = 2.5f;
constexpr int NPHASE = 12;

constexpr size_t MiB = 1u << 20;
constexpr size_t WS_CTL = 0, CTL_ZERO_BYTES = 1 * MiB;
constexpr size_t WS_WA = 2 * MiB, WS_WB = 6 * MiB, WS_WO = 10 * MiB, WS_WGU = 18 * MiB, WS_WD = 278 * MiB;
constexpr size_t WS_X1F = 408 * MiB, WS_X1B = 472 * MiB, WS_YA = 504 * MiB, WS_YB = 520 * MiB;
constexpr size_t WS_TOKL = 536 * MiB, WS_WGTL = 539 * MiB, WS_INFO = 542 * MiB, WS_GL = 542 * MiB + 512 * 1024, WS_GAB = 543 * MiB;
constexpr size_t WS_WIN = 544 * MiB, WS_XB = 588 * MiB, WS_P = 620 * MiB;
constexpr size_t WS_U = 796 * MiB, WS_W = 828 * MiB, WS_QD = 860 * MiB, WS_KD = 892 * MiB, WS_AQK = 924 * MiB, WS_SST = 940 * MiB, WS_END = 1004 * MiB;
constexpr size_t WS_PK = 796 * MiB, WS_UL = 860 * MiB, WS_OG = 892 * MiB;
constexpr int PKL = 62464, OST_OFF = 2 * PKL, OST_P = 272, OST_BYTES = 64 * OST_P;
constexpr int PK_BYTES = 65536, PK_WN = 0, PK_QD = 17408, PK_KDT = 34816, PK_AQ = 53248;
constexpr size_t WS_TMP = 796 * MiB, WS_MRG = 860 * MiB, WS_Y1 = 892 * MiB;
constexpr size_t WS_HB = 544 * MiB, WS_YAS = 620 * MiB;
constexpr size_t PBUF = (size_t)T * 1024;
constexpr int CW_BAR = 4096;
constexpr int CW_CNT = 32768;
constexpr int CW_AQ = 40960;
constexpr int CW_SP = 41024;

constexpr int RING_BYTES = 131072;
constexpr int LDS_TAB = RING_BYTES;
constexpr int LDS_BYTES = 163840;
constexpr int MISC_OFF = LDS_BYTES - 256;

#define GAS __attribute__((address_space(1)))
#define LAS __attribute__((address_space(3)))
typedef unsigned short bf16;
typedef unsigned v4u __attribute__((ext_vector_type(4)));
typedef unsigned v2u __attribute__((ext_vector_type(2)));
typedef float f32x4 __attribute__((ext_vector_type(4)));
typedef float f32x2 __attribute__((ext_vector_type(2)));
typedef short bf16x8 __attribute__((ext_vector_type(8)));
typedef GAS unsigned gu32;
#define RLX_AGENT __ATOMIC_RELAXED, __HIP_MEMORY_SCOPE_AGENT
#define LDS_WAIT() asm volatile("s_waitcnt lgkmcnt(0)" ::: "memory")
#define VM_WAIT() asm volatile("s_waitcnt vmcnt(0)" ::: "memory")
__device__ __forceinline__ unsigned f2bf(float f) { unsigned u = __builtin_bit_cast(unsigned, f); return (u + 0x7fffu + ((u >> 16) & 1u)) >> 16; }
typedef __bf16 bf16x2_hw __attribute__((ext_vector_type(2)));
__device__ __forceinline__ unsigned pk2(float lo, float hi) { const f32x2 v = {lo, hi}; return __builtin_bit_cast(unsigned, __builtin_convertvector(v, bf16x2_hw)); }
__device__ __forceinline__ float bflo(unsigned w) { return __builtin_bit_cast(float, w << 16); }
__device__ __forceinline__ float bfhi(unsigned w) { return __builtin_bit_cast(float, w & 0xffff0000u); }
__device__ __forceinline__ float bf2f(bf16 b) { return __builtin_bit_cast(float, (unsigned)b << 16); }
__device__ __forceinline__ float sigmoidf_(float x) { return 1.f / (1.f + __expf(-x)); }
__device__ __forceinline__ float siluf_(float x) { return x / (1.f + __expf(-x)); }

#define XB_TMO      128
#define XB_XCNT(j)  (256  + 64 * (j))
#define XB_XSUB(j)  (1280 + 64 * (j))
#define XB_XGEN(j)  (2304 + 64 * (j))
#define XB_TOP      3328
#define XB_TOPGEN   3392
#define XCD_BAR_WORDS 3456
#define XB_SPIN_CAP (1u << 22)

__device__ __forceinline__ unsigned xb_ld(unsigned* p)              { return __hip_atomic_load(p, __ATOMIC_RELAXED, __HIP_MEMORY_SCOPE_AGENT); }
__device__ __forceinline__ unsigned xb_add(unsigned* p, unsigned v) { return __hip_atomic_fetch_add(p, v, __ATOMIC_RELAXED, __HIP_MEMORY_SCOPE_AGENT); }
__device__ __forceinline__ unsigned xb_xcc_id() { return (unsigned)__builtin_amdgcn_s_getreg((3 << 11) | 20) & 0xFu; }
#define XB_SPIN(cond, bar) do { unsigned _sp = 0; while (cond) { __builtin_amdgcn_s_sleep(1); \
    if ((++_sp & 255u) == 0u) { if (xb_ld(&(bar)[XB_TMO])) break; if (_sp > XB_SPIN_CAP) { atomicAdd(&(bar)[XB_TMO], 1u); break; } } } } while (0)

struct XcdBarrier {
    unsigned* bar; unsigned x;
    volatile LAS unsigned* st;
};
__device__ __forceinline__ XcdBarrier xcd_barrier_post(unsigned* bar, volatile LAS unsigned* st) {
    XcdBarrier b; b.bar = bar; b.x = xb_xcc_id(); b.st = st;
    if (threadIdx.x == 0) (void)xb_add(&bar[XB_XCNT(b.x)], 1u);
    return b;
}
__device__ __forceinline__ void xcd_barrier_complete(unsigned* bar, unsigned x, unsigned& nloc, unsigned& nx) {
    const unsigned G = gridDim.x * gridDim.y * gridDim.z;
    unsigned sum, cnt, mine, sp = 0u;
    for (;;) {
        sum = 0u; cnt = 0u; mine = 0u;
#pragma unroll
        for (unsigned j = 0; j < 16; ++j) { const unsigned c = xb_ld(&bar[XB_XCNT(j)]); sum += c; cnt += (c > 0u) ? 1u : 0u; mine = (j == x) ? c : mine; }
        if (sum == G) break;
        __builtin_amdgcn_s_sleep(1);
        if ((++sp & 255u) == 0u) { if (xb_ld(&bar[XB_TMO])) break; if (sp > XB_SPIN_CAP) { atomicAdd(&bar[XB_TMO], 1u); break; } }
    }
    nloc = mine > 0u ? mine : 1u; nx = cnt > 0u ? cnt : 1u;
}
__device__ __forceinline__ void xcd_barrier(const XcdBarrier& b) {
    asm volatile("s_waitcnt vmcnt(0)" ::: "memory");
    __syncthreads();
    if (threadIdx.x == 0) {
        unsigned* bar = b.bar;
        __builtin_amdgcn_s_waitcnt(0);
        unsigned nloc = b.st[0], nx = b.st[1];
        if (nloc == 0u) { xcd_barrier_complete(bar, b.x, nloc, nx); b.st[0] = nloc; b.st[1] = nx; }
        const unsigned old = xb_add(&bar[XB_XSUB(b.x)], 1u);
        const unsigned gen = old / nloc;
        if (old + 1u == (gen + 1u) * nloc) {
            __builtin_amdgcn_fence(__ATOMIC_RELEASE, "agent");
            asm volatile("s_waitcnt vmcnt(0)" ::: "memory");
            const unsigned og = xb_add(&bar[XB_TOP], 1u);
            const unsigned tg = og / nx;
            if (og + 1u == (tg + 1u) * nx) xb_add(&bar[XB_TOPGEN], 1u);
            else XB_SPIN(xb_ld(&bar[XB_TOPGEN]) == tg, bar);
            __builtin_amdgcn_fence(__ATOMIC_ACQUIRE, "agent");
            xb_add(&bar[XB_XGEN(b.x)], 1u);
            asm volatile("s_waitcnt vmcnt(0)" ::: "memory");
        } else {
            XB_SPIN(xb_ld(&bar[XB_XGEN(b.x)]) == gen, bar);
            __builtin_amdgcn_fence(__ATOMIC_ACQUIRE, "agent");
            asm volatile("s_waitcnt vmcnt(0)" ::: "memory");
        }
    }
    __syncthreads();
}

struct Frame {
    LAS unsigned char* lds;
    gu32* ctl;
    int tid, lane, wave;
    int vcu, G;
    const float* in[24]; float* out; unsigned char* ws;
};
__device__ __forceinline__ float wave_sum(float v) {
#pragma unroll
    for (int o = 1; o < 64; o <<= 1) v += __shfl_xor(v, o);
    return v;
}
__device__ __forceinline__ float wave_max(float v) {
#pragma unroll
    for (int o = 1; o < 64; o <<= 1) v = fmaxf(v, __shfl_xor(v, o));
    return v;
}

template <bool NTS> __device__ __forceinline__ void p0_transpose_item(const float* W, int pitch, int sn0, bf16* WT, int dpitch, int dr0, int k0, LAS float* scr, int lane) {
#pragma unroll 8
    for (int i = 0; i < 32; ++i) { const int kk = 2 * i + (lane >> 5); scr[kk * 33 + (lane & 31)] = __builtin_nontemporal_load(W + (size_t)(k0 + kk) * pitch + sn0 + (lane & 31)); }
    LDS_WAIT(); asm volatile("" ::: "memory");
    const int c = lane & 7;
#pragma unroll
    for (int j = 0; j < 4; ++j) { const int n = (lane >> 3) + 8 * j; const LAS float* s = scr + (8 * c) * 33 + n;
        v4u o; o.x = pk2(s[0 * 33], s[1 * 33]); o.y = pk2(s[2 * 33], s[3 * 33]); o.z = pk2(s[4 * 33], s[5 * 33]); o.w = pk2(s[6 * 33], s[7 * 33]);
        if (NTS) __builtin_nontemporal_store(o, (GAS v4u*)(WT + (size_t)(dr0 + n) * dpitch + k0 + 8 * c)); else *(GAS v4u*)(WT + (size_t)(dr0 + n) * dpitch + k0 + 8 * c) = o; }
    LDS_WAIT(); asm volatile("" ::: "memory");
}
constexpr int P0_I_IN = 32 * 352, P0_I_A = 16 * 64, P0_I_O = 32 * 64, P0_I_GU = NEX * 2 * 512, P0_I_D = NEX * 512;
constexpr int P0_NITEMS = P0_I_IN + 2 * P0_I_A + P0_I_O + P0_I_GU + P0_I_D, P1_TAIL_ITEMS = 16384;
__device__ __forceinline__ void p0_items(Frame& F, int lo, int hi, int gw, int NGW) {
    unsigned char* ws = F.ws;
    LAS float* scr = (LAS float*)(F.lds + F.wave * 16384);
    constexpr int I_IN = P0_I_IN, I_A = P0_I_A, I_O = P0_I_O, I_GU = P0_I_GU;
    for (int it = lo + gw; it < hi; it += NGW) {
        int r = it;
        if (r < I_IN) { const int kb = r / 352, nb = r % 352, n0 = 32 * nb; p0_transpose_item<false>(F.in[1], WIN_PITCH, n0 + (n0 >= 7168 ? 16 : 0), (bf16*)(ws + WS_WIN), D, n0, 64 * kb, scr, F.lane); continue; } r -= I_IN;
        if (r < I_A) { const int kb = r / 64, nb = r % 64; p0_transpose_item<false>(F.in[9], D, 32 * nb, (bf16*)(ws + WS_WA), 1024, 32 * nb, 64 * kb, scr, F.lane); continue; } r -= I_A;
        if (r < I_A) { const int kb = r / 64, nb = r % 64; p0_transpose_item<false>(F.in[10], D, 32 * nb, (bf16*)(ws + WS_WB), 1024, 32 * nb, 64 * kb, scr, F.lane); continue; } r -= I_A;
        if (r < I_O) { const int kb = r / 64, nb = r % 64; p0_transpose_item<false>(F.in[11], D, 32 * nb, (bf16*)(ws + WS_WO), D, 32 * nb, 64 * kb, scr, F.lane); continue; } r -= I_O;
        if (r < I_GU) { const int e = r / 1024, which = (r >> 9) & 1, q = r & 511, kb = q & 31, nb = q >> 5;
            const float* src = e < NE ? (which ? F.in[17] : F.in[16]) + (size_t)e * D * FF : (which ? F.in[20] : F.in[19]);
            p0_transpose_item<true>(src, FF, 32 * nb, (bf16*)(ws + WS_WGU) + (size_t)e * 1024 * D, D, 256 * (nb >> 2) + 32 * (nb & 3) + 128 * which, 64 * kb, scr, F.lane); continue; } r -= I_GU;
        { const int e = r / 512, q = r & 511, kb = q & 7, nb = q >> 3;
            const float* src = e < NE ? F.in[18] + (size_t)e * FF * D : F.in[21];
            p0_transpose_item<true>(src, D, 32 * nb, (bf16*)(ws + WS_WD) + (size_t)e * D * FF, FF, 32 * nb, 64 * kb, scr, F.lane); }
    }
}
__device__ __forceinline__ void p0_prologue(Frame& F) {
    unsigned char* ws = F.ws;
    {
        LAS float* w16 = (LAS float*)F.lds;
        for (int idx = F.tid; idx < 2048 * 4; idx += NTHR) { const int k = idx >> 2, q = idx & 3;
            const f32x4 v = *(const GAS f32x4*)(F.in[1] + (size_t)k * WIN_PITCH + 7168 + 4 * q); *(LAS f32x4*)(w16 + k * 16 + 4 * q) = v; }
        __syncthreads();
        float* gab = (float*)(ws + WS_GAB);
        for (int tok = F.vcu * NWAVES + F.wave; tok < T; tok += F.G * NWAVES) {
            float acc[16];
#pragma unroll
            for (int e = 0; e < 16; ++e) acc[e] = 0.f;
            const float* xr = F.in[0] + (size_t)tok * D;
#pragma unroll 2
            for (int j = 0; j < 32; ++j) { const int k = j * 64 + F.lane; const float xv = xr[k];
#pragma unroll
                for (int q = 0; q < 4; ++q) { const f32x4 w = *(const LAS f32x4*)(w16 + k * 16 + 4 * q);
                    acc[4 * q + 0] += xv * w.x; acc[4 * q + 1] += xv * w.y; acc[4 * q + 2] += xv * w.z; acc[4 * q + 3] += xv * w.w; } }
#pragma unroll
            for (int e = 0; e < 16; ++e) acc[e] = wave_sum(acc[e]);
            if (F.lane == 0) {
#pragma unroll
                for (int q = 0; q < 4; ++q) *(GAS f32x4*)(gab + (size_t)tok * 16 + 4 * q) = (f32x4){acc[4 * q], acc[4 * q + 1], acc[4 * q + 2], acc[4 * q + 3]}; }
        }
        __syncthreads();
    }
    p0_items(F, 0, P0_NITEMS - P1_TAIL_ITEMS, F.vcu * NWAVES + F.wave, F.G * NWAVES);
    { const GAS f32x4* x4 = (const GAS f32x4*)F.in[0]; GAS v4u* o = (GAS v4u*)(ws + WS_XB);
#pragma unroll 4
      for (size_t i = (size_t)F.vcu * NTHR + F.tid; i < (size_t)T * D / 8; i += (size_t)F.G * NTHR) { const f32x4 a = __builtin_nontemporal_load(x4 + 2 * i), b = __builtin_nontemporal_load(x4 + 2 * i + 1);
          v4u w; w.x = pk2(a.x, a.y); w.y = pk2(a.z, a.w); w.z = pk2(b.x, b.y); w.w = pk2(b.z, b.w); o[i] = w; } }
}

using pg8::Unit;
struct EpiProj {
    static constexpr bool PERM = true;
    bf16* P;
    __device__ __forceinline__ void operator()(const f32x4 (&acc)[2][2][4][2], const Unit& u, int wr, int wc, int fr, int fq) const {
        const int buf = u.pn >> 2, colt = (u.pn & 3) * 256; bf16* base = P + (size_t)buf * PBUF;
        const int row0 = u.r0 + wr * 64 + fr, col0 = colt + wc * 32 + 8 * fq; const bool sg = buf >= 7;
        if (buf == 2) {
            const int frp = (fr & ~12) | ((fr & 4) << 1) | ((fr & 8) >> 1);
#pragma unroll
            for (int ai = 0; ai < 2; ++ai)
#pragma unroll
                for (int m = 0; m < 4; ++m) { const int tokp = u.r0 + wr * 64 + ai * 128 + m * 16 + frp;
#pragma unroll
                    for (int bj = 0; bj < 2; ++bj)
#pragma unroll
                        for (int n = 0; n < 2; ++n)
#pragma unroll
                            for (int x = 0; x < 4; ++x) base[(size_t)(col0 + bj * 128 + 4 * n + x) * T + tokp] = (bf16)f2bf(acc[ai][bj][m][n][x]); }
            return; }
#pragma unroll
        for (int ai = 0; ai < 2; ++ai)
#pragma unroll
            for (int m = 0; m < 4; ++m) { bf16* rowp = base + (size_t)(row0 + ai * 128 + m * 16) * 1024 + col0;
#pragma unroll
                for (int bj = 0; bj < 2; ++bj) { f32x4 v0 = acc[ai][bj][m][0], v1 = acc[ai][bj][m][1];
                    if (sg) { v0 = (f32x4){sigmoidf_(v0.x), sigmoidf_(v0.y), sigmoidf_(v0.z), sigmoidf_(v0.w)}; v1 = (f32x4){sigmoidf_(v1.x), sigmoidf_(v1.y), sigmoidf_(v1.z), sigmoidf_(v1.w)}; }
                    v4u w; w.x = pk2(v0.x, v0.y); w.y = pk2(v0.z, v0.w); w.z = pk2(v1.x, v1.y); w.w = pk2(v1.z, v1.w);
                    *(GAS v4u*)(rowp + bj * 128) = w; } }
    }
};
template <int STEP> struct EpiBranch {
    static constexpr bool PERM = true;
    const bf16* SG; float* tmp; bf16* mrg;
    __device__ __forceinline__ void operator()(const f32x4 (&acc)[2][2][4][2], const Unit& u, int wr, int wc, int fr, int fq) const {
        const int row0 = u.r0 + wr * 64 + fr, colu = u.pn * 256 + wc * 32 + 8 * fq;
#pragma unroll
        for (int ai = 0; ai < 2; ++ai)
#pragma unroll
            for (int m = 0; m < 4; ++m) { const int row = row0 + ai * 128 + m * 16;
#pragma unroll
                for (int bj = 0; bj < 2; ++bj) { const int col = colu + bj * 128;
                    const v4u g = *(const GAS v4u*)(SG + (size_t)(col >> 10) * PBUF + (size_t)row * 1024 + (col & 1023));
                    f32x4 v0 = acc[ai][bj][m][0], v1 = acc[ai][bj][m][1];
                    v0 = v0 * (f32x4){bflo(g.x), bfhi(g.x), bflo(g.y), bfhi(g.y)}; v1 = v1 * (f32x4){bflo(g.z), bfhi(g.z), bflo(g.w), bfhi(g.w)};
                    float* tp = tmp + (size_t)row * D + col;
                    if (STEP == 0) { *(GAS f32x4*)tp = v0; *(GAS f32x4*)(tp + 4) = v1; }
                    else { v0 = v0 + *(const GAS f32x4*)tp; v1 = v1 + *(const GAS f32x4*)(tp + 4);
                        v4u w; w.x = pk2(v0.x, v0.y); w.y = pk2(v0.z, v0.w); w.z = pk2(v1.x, v1.y); w.w = pk2(v1.z, v1.w);
                        *(GAS v4u*)(mrg + (size_t)row * D + col) = w; } } }
    }
};
struct EpiOut {
    static constexpr bool PERM = true;
    const float* x; float* y1;
    __device__ __forceinline__ void operator()(const f32x4 (&acc)[2][2][4][2], const Unit& u, int wr, int wc, int fr, int fq) const {
        const int row0 = u.r0 + wr * 64 + fr, colu = u.pn * 256 + wc * 32 + 8 * fq;
#pragma unroll
        for (int ai = 0; ai < 2; ++ai)
#pragma unroll
            for (int m = 0; m < 4; ++m) { const size_t ro = (size_t)(row0 + ai * 128 + m * 16) * D;
#pragma unroll
                for (int bj = 0; bj < 2; ++bj) { const size_t o = ro + colu + bj * 128;
                    const f32x4 x0 = *(const GAS f32x4*)(x + o), x1 = *(const GAS f32x4*)(x + o + 4);
                    *(GAS f32x4*)(y1 + o) = x0 * ALPHA + acc[ai][bj][m][0]; *(GAS f32x4*)(y1 + o + 4) = x1 * ALPHA + acc[ai][bj][m][1]; } }
    }
};
struct EpiGU {
    static constexpr bool PERM = true;
    bf16* HB;
    __device__ __forceinline__ void operator()(const f32x4 (&acc)[2][2][4][2], const Unit& u, int wr, int wc, int fr, int fq) const {
        const int col = u.pn * 128 + wc * 32 + 8 * fq;
#pragma unroll
        for (int ai = 0; ai < 2; ++ai)
#pragma unroll
            for (int m = 0; m < 4; ++m) { const int r = ai * 128 + wr * 64 + m * 16 + fr;
                if (r < u.nv) { const f32x4 g0 = acc[ai][0][m][0], g1 = acc[ai][0][m][1], u0 = acc[ai][1][m][0], u1 = acc[ai][1][m][1];
                    v4u w; w.x = pk2(siluf_(g0.x) * u0.x, siluf_(g0.y) * u0.y); w.y = pk2(siluf_(g0.z) * u0.z, siluf_(g0.w) * u0.w);
                    w.z = pk2(siluf_(g1.x) * u1.x, siluf_(g1.y) * u1.y); w.w = pk2(siluf_(g1.z) * u1.z, siluf_(g1.w) * u1.w);
                    *(GAS v4u*)(HB + (size_t)(u.r0 + r) * FF + col) = w; } }
    }
};
struct EpiDown {
    static constexpr bool PERM = true;
    bf16* YAS; const float* wgtl;
    __device__ __forceinline__ void operator()(const f32x4 (&acc)[2][2][4][2], const Unit& u, int wr, int wc, int fr, int fq) const {
        const int colu = u.pn * 256 + wc * 32 + 8 * fq;
#pragma unroll
        for (int ai = 0; ai < 2; ++ai)
#pragma unroll
            for (int m = 0; m < 4; ++m) { const int r = ai * 128 + wr * 64 + m * 16 + fr;
                if (r < u.nv) { const float wg = wgtl[u.lb + r];
#pragma unroll
                    for (int bj = 0; bj < 2; ++bj) { const f32x4 v0 = acc[ai][bj][m][0] * wg, v1 = acc[ai][bj][m][1] * wg;
                        v4u w; w.x = pk2(v0.x, v0.y); w.y = pk2(v0.z, v0.w); w.z = pk2(v1.x, v1.y); w.w = pk2(v1.z, v1.w);
                        *(GAS v4u*)(YAS + (size_t)(u.r0 + r) * D + colu + bj * 128) = w; } } }
    }
};
struct MoeOrder {
    const LAS int* units; const int* tokl;
    __device__ __forceinline__ bool next(int i, Unit& u) const {
        if (i >= 16) return false;
        const LAS int* p = units + i * 8; const int pm = p[0]; if (pm < 0) return false;
        u.pm = pm; u.pn = p[1]; u.arow = p[2]; u.brow = p[3]; u.r0 = p[4]; u.nv = p[5]; u.e = p[6]; u.lb = p[7]; return true;
    }
    __device__ __forceinline__ int row_of(const Unit& u, int r) const { return r < u.nv ? tokl[u.lb + r] : 0; }
};
__device__ __forceinline__ void moe_tables(Frame& F, int NT, int brows) {
    LAS int* tpref = (LAS int*)(F.lds + LDS_TAB); LAS int* rbase = tpref + 72; LAS int* cnts = rbase + 72;
    __syncthreads();
    if (F.wave == 0) {
        const int c = (int)__hip_atomic_load(F.ctl + CW_CNT + 64 * F.lane, RLX_AGENT);
        int tl = (c + 255) >> 8, tp = tl, rb = c;
#pragma unroll
        for (int o = 1; o < 64; o <<= 1) { const int a = __shfl_up(tp, o), b = __shfl_up(rb, o); if (F.lane >= o) { tp += a; rb += b; } }
        tpref[F.lane] = tp - tl; rbase[F.lane] = rb - c; cnts[F.lane] = c;
        if (F.lane == 63) { tpref[64] = tp; rbase[64] = rb; cnts[64] = T; tpref[65] = tp + T / 256; rbase[65] = rb + T; }
    }
    __syncthreads();
    if (NT > 0 && F.tid < 16) {
        LAS int* p = (LAS int*)(F.lds + LDS_TAB + 1024) + F.tid * 8; const int L = F.tid * F.G + (int)blockIdx.x;
        if (L >= tpref[NEX] * NT) p[0] = -1;
        else { const int tg = L / NT, nt = L % NT; int e = 0;
            while (tpref[e + 1] <= tg) ++e;
            const int mt = tg - tpref[e], rem = cnts[e] - mt * 256, r0 = rbase[e] + mt * 256;
            p[0] = mt; p[1] = nt; p[2] = r0; p[3] = e * brows + nt * 256; p[4] = r0; p[5] = rem < 256 ? rem : 256; p[6] = e; p[7] = e * T + mt * 256; }
    }
    __syncthreads();
}
#ifndef DUP_PHASE
#define DUP_PHASE -1
#endif

__device__ __forceinline__ int t5_bucket(int rel) {
    const int n = rel < 0 ? -rel : rel; int b;
    if (n < 8) b = n; else if (n < 12) b = 8; else if (n < 16) b = 9; else if (n < 23) b = 10; else if (n < 32) b = 11; else if (n < 46) b = 12; else if (n < 64) b = 13; else if (n < 91) b = 14; else b = 15;
    return b + (rel > 0 ? 16 : 0);
}
typedef float f32x16 __attribute__((ext_vector_type(16)));
__device__ __forceinline__ bf16x8 cvt8(const f32x16& x, int s) {
    v4u w;
    if (s == 0) { w.x = pk2(x[0], x[1]); w.y = pk2(x[2], x[3]); w.z = pk2(x[4], x[5]); w.w = pk2(x[6], x[7]); }
    else { w.x = pk2(x[8], x[9]); w.y = pk2(x[10], x[11]); w.z = pk2(x[12], x[13]); w.w = pk2(x[14], x[15]); }
    return __builtin_bit_cast(bf16x8, w);
}
constexpr int AT_KP = 272, AT_VP = 144, AT_KB = 64 * AT_KP, AT_VB = 128 * AT_VP, AT_BUF = AT_KB + AT_VB;
constexpr float AT_C1 = 0.125f * 1.4426950408889634f, LOG2E = 1.4426950408889634f;
template <int QOFF> __device__ __forceinline__ void attn_v2(Frame& F) {
    LAS unsigned char* lds = F.lds;
    LAS float* relb = (LAS float*)(F.lds + 2 * AT_BUF);
    LAS int* qslot = (LAS int*)(relb + 256);
    const bf16* Pq = (const bf16*)(F.ws + WS_P); const bf16* Pk = Pq + PBUF; const bf16* VT = Pq + 2 * PBUF;
    bf16* ya = (bf16*)(F.ws + WS_YA);
    float lam;
    { const float* dl = F.in[6]; float s01 = 0.f, s23 = 0.f;
      for (int d = 0; d < 64; ++d) { s01 += dl[d] * dl[64 + d]; s23 += dl[128 + d] * dl[192 + d]; }
      lam = expf(s01) - expf(s23) + LAMBDA_INIT; }
    for (;;) {
        int tid = F.tid; asm volatile("" : "+v"(tid));
        __syncthreads();
        if (tid == 0) qslot[0] = (int)__hip_atomic_fetch_add(F.ctl + CW_AQ + QOFF, 1u, RLX_AGENT);
        __syncthreads();
        const int L = qslot[0];
        if (L >= NH * 64) break;
        const int h = L & 7, qb = 63 - (L >> 3), lane = tid & 63, i31 = lane & 31, hh = lane >> 5, sb = F.wave & 3, map = F.wave >> 2;
        const int cw = 2 * qb + (sb >> 1), ntile = 2 * qb + 2;
        if (tid < 256) relb[tid] = F.in[8][t5_bucket(tid - 191) * 8 + h] * LOG2E;
        const int qrow = qb * 128 + 32 * sb + i31;
        bf16x8 qf[4];
#pragma unroll
        for (int ks = 0; ks < 4; ++ks) qf[ks] = *(const GAS bf16x8*)(Pq + (size_t)qrow * 1024 + h * 128 + map * 64 + 16 * ks + 8 * hh);
        const int kr0 = tid >> 4, kc0 = tid & 15, vr0 = tid >> 3, vc0 = tid & 7;
        const bf16* kg = Pk + (size_t)kr0 * 1024 + h * 128 + kc0 * 8;
        const bf16* vg = VT + (size_t)(h * 128 + vr0) * T + vc0 * 8;
        const int klo = kr0 * AT_KP + kc0 * 16, vlo = AT_KB + vr0 * AT_VP + vc0 * 16;
        v4u st[4];
        st[0] = *(const GAS v4u*)kg; st[1] = *(const GAS v4u*)(kg + 32 * 1024); st[2] = *(const GAS v4u*)vg; st[3] = *(const GAS v4u*)(vg + (size_t)64 * T);
        *(LAS v4u*)(lds + klo) = st[0]; *(LAS v4u*)(lds + klo + 32 * AT_KP) = st[1]; *(LAS v4u*)(lds + vlo) = st[2]; *(LAS v4u*)(lds + vlo + 64 * AT_VP) = st[3];
        f32x16 O[4];
#pragma unroll
        for (int db = 0; db < 4; ++db)
#pragma unroll
            for (int r = 0; r < 16; ++r) O[db][r] = 0.f;
        float mrun = -INFINITY, lrun = 0.f;
        __syncthreads();
#pragma unroll 1
        for (int j = 0; j < ntile; ++j) {
            const LAS unsigned char* buf = lds + (j & 1) * AT_BUF;
            if (j + 1 < ntile) { const size_t ko = (size_t)(j + 1) * 64 * 1024; const int vo = (j + 1) * 64;
                st[0] = *(const GAS v4u*)(kg + ko); st[1] = *(const GAS v4u*)(kg + ko + 32 * 1024); st[2] = *(const GAS v4u*)(vg + vo); st[3] = *(const GAS v4u*)(vg + (size_t)64 * T + vo); }
            if (j <= cw) {
                f32x16 S[2]; bf16x8 kf[8], vf[8];
#pragma unroll
                for (int kb = 0; kb < 2; ++kb)
#pragma unroll
                    for (int ks = 0; ks < 4; ++ks) kf[4 * kb + ks] = *(const LAS bf16x8*)(buf + (32 * kb + i31) * AT_KP + map * 128 + (16 * ks + 8 * hh) * 2);
#pragma unroll
                for (int kb = 0; kb < 2; ++kb) {
#pragma unroll
                    for (int r = 0; r < 16; ++r) S[kb][r] = 0.f;
#pragma unroll
                    for (int ks = 0; ks < 4; ++ks) S[kb] = __builtin_amdgcn_mfma_f32_32x32x16_bf16(kf[4 * kb + ks], qf[ks], S[kb], 0, 0, 0); }
#pragma unroll
                for (int db = 0; db < 2; ++db)
#pragma unroll
                    for (int ks = 0; ks < 4; ++ks) vf[4 * db + ks] = *(const LAS bf16x8*)(buf + AT_KB + (32 * db + i31) * AT_VP + (16 * ks + 8 * hh) * 2);
                float tmax = -INFINITY;
                if (j >= cw - 2) { const int rb = (j * 64) - (qb * 128 + 32 * sb + i31) + 191 + 4 * hh;
#pragma unroll
                    for (int kb = 0; kb < 2; ++kb)
#pragma unroll
                        for (int r = 0; r < 16; ++r) { S[kb][r] = S[kb][r] * AT_C1 + relb[rb + 32 * kb + (r & 3) + 8 * (r >> 2)]; tmax = fmaxf(tmax, S[kb][r]); }
                } else { const float bfar = relb[0];
#pragma unroll
                    for (int kb = 0; kb < 2; ++kb)
#pragma unroll
                        for (int r = 0; r < 16; ++r) { S[kb][r] = S[kb][r] * AT_C1 + bfar; tmax = fmaxf(tmax, S[kb][r]); } }
                tmax = fmaxf(tmax, __shfl_xor(tmax, 32));
                if (__any(tmax > mrun + 8.f)) { const float mn = fmaxf(mrun, tmax), corr = __builtin_amdgcn_exp2f(mrun - mn); mrun = mn; lrun *= corr;
#pragma unroll
                    for (int db = 0; db < 4; ++db) O[db] = O[db] * corr; }
                float ps = 0.f;
#pragma unroll
                for (int kb = 0; kb < 2; ++kb)
#pragma unroll
                    for (int r = 0; r < 16; ++r) { S[kb][r] = __builtin_amdgcn_exp2f(S[kb][r] - mrun); ps += S[kb][r]; }
                lrun += ps;
                bf16x8 pf[4];
#pragma unroll
                for (int kb = 0; kb < 2; ++kb) { pf[2 * kb] = cvt8(S[kb], 0); pf[2 * kb + 1] = cvt8(S[kb], 1); }
#pragma unroll
                for (int db = 0; db < 4; ++db) {
#pragma unroll
                    for (int ks = 0; ks < 4; ++ks) O[db] = __builtin_amdgcn_mfma_f32_32x32x16_bf16(vf[4 * (db & 1) + ks], pf[ks], O[db], 0, 0, 0);
                    if (db < 2) {
#pragma unroll
                        for (int ks = 0; ks < 4; ++ks) vf[4 * (db & 1) + ks] = *(const LAS bf16x8*)(buf + AT_KB + (32 * (db + 2) + i31) * AT_VP + (16 * ks + 8 * hh) * 2); } }
            }
            if (j + 1 < ntile) { LAS unsigned char* nb = lds + ((j + 1) & 1) * AT_BUF;
                *(LAS v4u*)(nb + klo) = st[0]; *(LAS v4u*)(nb + klo + 32 * AT_KP) = st[1]; *(LAS v4u*)(nb + vlo) = st[2]; *(LAS v4u*)(nb + vlo + 64 * AT_VP) = st[3]; }
            __syncthreads();
        }
        lrun += __shfl_xor(lrun, 32);
        const float inv = 1.f / lrun;
        LAS float* X = (LAS float*)lds + sb * 4096;
        if (map == 1) {
#pragma unroll
            for (int db = 0; db < 4; ++db)
#pragma unroll
                for (int r = 0; r < 16; ++r) X[(db * 16 + r) * 64 + lane] = O[db][r] * inv; }
        __syncthreads();
        if (map == 0) { float ss = 0.f;
#pragma unroll
            for (int db = 0; db < 4; ++db)
#pragma unroll
                for (int r = 0; r < 16; ++r) { const float a = O[db][r] * inv - lam * X[(db * 16 + r) * 64 + lane]; O[db][r] = a; ss += a * a; }
            ss += __shfl_xor(ss, 32);
            const float rn = rsqrtf(ss * (1.f / 128.f) + NORM_EPS) * (1.f - LAMBDA_INIT);
            bf16* op = ya + (size_t)qrow * 1024 + h * 128 + 4 * hh;
#pragma unroll
            for (int db = 0; db < 4; ++db)
#pragma unroll
                for (int q4 = 0; q4 < 4; ++q4) { const int dv = 32 * db + 8 * q4 + 4 * hh; const f32x4 sw = *(const GAS f32x4*)(F.in[7] + dv);
                    *(GAS v2u*)(op + 32 * db + 8 * q4) = (v2u){pk2(O[db][4 * q4] * rn * sw.x, O[db][4 * q4 + 1] * rn * sw.y), pk2(O[db][4 * q4 + 2] * rn * sw.z, O[db][4 * q4 + 3] * rn * sw.w)}; } }
    }
}

__device__ __forceinline__ int swap23(int x) { return (x & ~12) | ((x & 4) << 1) | ((x & 8) >> 1); }
__device__ __forceinline__ void gdn_prep_v1(Frame& F) {
    LAS float* Ks = (LAS float*)F.lds;
    LAS float* Qs = Ks + 64 * 129;
    LAS float* Vs = Qs + 64 * 129;
    LAS float* As = Vs + 64 * 128;
    LAS float* Tm = As + 64 * 68;
    LAS float* gcs = Tm + 64 * 68;
    LAS float* bts = gcs + 64;
    LAS float* egs = bts + 64;
    const bf16* P3 = (const bf16*)(F.ws + WS_P) + 3 * PBUF;
    const float* gab = (const float*)(F.ws + WS_GAB);
    float* GLg = (float*)(F.ws + WS_GL);
    const int tid = F.tid, lane = F.lane;
    for (int L = blockIdx.x; L < NH * NCHUNK; L += F.G) {
        const int n = L >> 3, h = L & 7, t0 = n * 64;
        __syncthreads();
        for (int idx = tid; idx < 64 * 384; idx += NTHR) { const int t = idx / 384, ch = idx % 384, which = ch >> 7, i = ch & 127, cg = which * 1024 + h * 128 + i;
            const bf16* src = P3 + (size_t)which * PBUF + h * 128 + i; float a = 0.f;
#pragma unroll
            for (int j = 0; j < 4; ++j) { const int tt = t0 + t - 3 + j; if (tt >= 0) a += bf2f(src[(size_t)tt * 1024]) * F.in[2][j * 3072 + cg]; }
            a = siluf_(a);
            if (which == 0) Qs[t * 129 + i] = a; else if (which == 1) Ks[t * 129 + i] = a; else Vs[t * 128 + i] = a; }
        __syncthreads();
        for (int t = F.wave * 8; t < F.wave * 8 + 8; ++t) {
            const float q0 = Qs[t * 129 + lane], q1 = Qs[t * 129 + 64 + lane], k0 = Ks[t * 129 + lane], k1 = Ks[t * 129 + 64 + lane];
            const float rq = rsqrtf(wave_sum(q0 * q0 + q1 * q1) + NORM_EPS) * 0.08838834764831845f, rk = rsqrtf(wave_sum(k0 * k0 + k1 * k1) + NORM_EPS);
            Qs[t * 129 + lane] = q0 * rq; Qs[t * 129 + 64 + lane] = q1 * rq; Ks[t * 129 + lane] = k0 * rk; Ks[t * 129 + 64 + lane] = k1 * rk; }
        if (F.wave == 0) { const int tok = t0 + lane; const float ga = gab[(size_t)tok * 16 + h] + F.in[4][h], gb = gab[(size_t)tok * 16 + 8 + h];
            const float sp = fmaxf(ga, 0.f) + log1pf(expf(-fabsf(ga))); float g = -expf(F.in[3][h]) * sp;
#pragma unroll
            for (int o = 1; o < 64; o <<= 1) { const float v = __shfl_up(g, o); if (lane >= o) g += v; }
            gcs[lane] = g; bts[lane] = 1.f / (1.f + expf(-gb)); egs[lane] = expf(g); }
        __syncthreads();
        for (int idx = tid; idx < 4096; idx += NTHR) { const int c = idx >> 6, s = idx & 63; float kk = 0.f, qk = 0.f;
            if (s <= c) { for (int i = 0; i < 128; ++i) { const float ks = Ks[s * 129 + i]; kk += Ks[c * 129 + i] * ks; qk += Qs[c * 129 + i] * ks; }
                const float dec = expf(gcs[c] - gcs[s]); kk *= dec * bts[c]; qk *= dec; }
            As[c * 68 + s] = (s < c) ? kk : 0.f; ((bf16*)(F.ws + WS_PK + (size_t)(h * NCHUNK + n) * PK_BYTES + PK_AQ))[c * 72 + swap23(s)] = (bf16)f2bf((s <= c) ? qk : 0.f); }
        __syncthreads();
        if (F.wave == 0) {
            for (int i = 0; i < 64; ++i) { float a = (i == lane) ? 1.f : 0.f;
#pragma unroll 4
                for (int j = 0; j < i; ++j) a -= As[i * 68 + j] * Tm[j * 68 + lane];
                Tm[i * 68 + lane] = a; }
        }
        __syncthreads();
        unsigned char* pk = F.ws + WS_PK + (size_t)(h * NCHUNK + n) * PK_BYTES; float* ul = (float*)(F.ws + WS_UL) + (size_t)(h * NCHUNK + n) * 4 * 64 * 32;
        for (int idx = tid; idx < 64 * 256; idx += NTHR) { const int c = idx >> 8, col = idx & 255; float a = 0.f;
            if (col < 128) { for (int s = 0; s <= c; ++s) a += Tm[c * 68 + s] * bts[s] * Vs[s * 128 + col];
                const int cp = c & 31; ul[(((col >> 5) * 64) + (col & 31) + 32 * ((cp >> 2) & 1)) * 32 + (c >> 5) * 16 + (cp & 3) + 4 * (cp >> 3)] = a; }
            else { const int i = col - 128; for (int s = 0; s <= c; ++s) a += Tm[c * 68 + s] * bts[s] * egs[s] * Ks[s * 129 + i];
                ((bf16*)(pk + PK_WN))[c * 136 + swap23(i)] = (bf16)f2bf(-a); } }
        const float glast = gcs[63];
        for (int idx = tid; idx < 64 * 128; idx += NTHR) { const int t = idx >> 7, i = idx & 127;
            ((bf16*)(pk + PK_QD))[t * 136 + swap23(i)] = (bf16)f2bf(Qs[t * 129 + i] * egs[t]);
            ((bf16*)(pk + PK_KDT))[i * 72 + swap23(t)] = (bf16)f2bf(Ks[t * 129 + i] * expf(glast - gcs[t])); }
        if (tid == 0) GLg[L] = expf(glast);
    }
}
__device__ __forceinline__ void gdn_prep_v2(Frame& F) {
    typedef float f32x16_ __attribute__((ext_vector_type(16)));
    LAS bf16* Kb = (LAS bf16*)F.lds;
    LAS bf16* Qb = Kb + 64 * 136;
    LAS bf16* Vt = Qb + 64 * 136;
    LAS bf16* KBt = Vt + 128 * 72;
    LAS float* As = (LAS float*)(KBt + 128 * 72);
    LAS float* Tm = As + 64 * 68;
    LAS float* Tp = Tm + 64 * 68;
    LAS bf16* Tmb = (LAS bf16*)(Tp + 32 * 36);
    LAS float* gcs = (LAS float*)(Tmb + 64 * 72);
    LAS float* bts = gcs + 64;
    LAS float* egs = bts + 64;
    LAS float* eks = egs + 64;
    const bf16* P3 = (const bf16*)(F.ws + WS_P) + 3 * PBUF;
    const float* gab = (const float*)(F.ws + WS_GAB);
    float* GLg = (float*)(F.ws + WS_GL);
    for (int L = blockIdx.x; L < NH * NCHUNK; L += F.G) {
        int tid = F.tid; asm volatile("" : "+v"(tid));
        const int lane = tid & 63, i31 = lane & 31, hh = lane >> 5;
        const int n = L >> 3, h = L & 7, t0 = n * 64;
        unsigned char* pk = F.ws + WS_PK + (size_t)(h * NCHUNK + n) * PK_BYTES; float* ul = (float*)(F.ws + WS_UL) + (size_t)(h * NCHUNK + n) * 4 * 64 * 32;
        __syncthreads();
        if (F.wave == 0) { const int tok = t0 + lane; const float ga = gab[(size_t)tok * 16 + h] + F.in[4][h], gb = gab[(size_t)tok * 16 + 8 + h];
            const float sp = fmaxf(ga, 0.f) + log1pf(expf(-fabsf(ga))); float g = -expf(F.in[3][h]) * sp;
#pragma unroll
            for (int o = 1; o < 64; o <<= 1) { const float v = __shfl_up(g, o); if (lane >= o) g += v; }
            const float glast = __shfl(g, 63);
            gcs[lane] = g; bts[lane] = 1.f / (1.f + expf(-gb)); egs[lane] = expf(g); eks[lane] = expf(glast - g);
            if (lane == 0) GLg[L] = expf(glast); }
        for (int idx = tid; idx < 64 * 68; idx += NTHR) Tm[idx] = 0.f;
        const int seg = tid & 63, trow = tid >> 6, which = seg >> 4, sc = (seg & 15) * 8;
        float ov[8][8];
        if (seg < 48) {
            const int cg = which * 1024 + h * 128 + sc; float cw[4][8];
#pragma unroll
            for (int j = 0; j < 4; ++j) { const f32x4 a = *(const GAS f32x4*)(F.in[2] + j * 3072 + cg), b = *(const GAS f32x4*)(F.in[2] + j * 3072 + cg + 4);
                cw[j][0] = a.x; cw[j][1] = a.y; cw[j][2] = a.z; cw[j][3] = a.w; cw[j][4] = b.x; cw[j][5] = b.y; cw[j][6] = b.z; cw[j][7] = b.w; }
            const bf16* src = P3 + (size_t)which * PBUF + h * 128 + sc; v4u xw[11];
#pragma unroll
            for (int m = 0; m < 11; ++m) { const int tt = t0 + 8 * trow - 3 + m; xw[m] = (v4u){0u, 0u, 0u, 0u}; if (tt >= 0) xw[m] = *(const GAS v4u*)(src + (size_t)tt * 1024); }
#pragma unroll
            for (int ti = 0; ti < 8; ++ti) {
#pragma unroll
                for (int c2 = 0; c2 < 4; ++c2) { float a0 = 0.f, a1 = 0.f;
#pragma unroll
                    for (int j = 0; j < 4; ++j) { const unsigned w = xw[ti + j][c2]; a0 += bflo(w) * cw[j][2 * c2]; a1 += bfhi(w) * cw[j][2 * c2 + 1]; }
                    ov[ti][2 * c2] = siluf_(a0); ov[ti][2 * c2 + 1] = siluf_(a1); } }
        } else {
#pragma unroll
            for (int ti = 0; ti < 8; ++ti)
#pragma unroll
                for (int ch = 0; ch < 8; ++ch) ov[ti][ch] = 0.f; }
#pragma unroll
        for (int ti = 0; ti < 8; ++ti) { float ss = 0.f;
#pragma unroll
            for (int ch = 0; ch < 8; ++ch) ss += ov[ti][ch] * ov[ti][ch];
            ss += __shfl_xor(ss, 1); ss += __shfl_xor(ss, 2); ss += __shfl_xor(ss, 4); ss += __shfl_xor(ss, 8);
            const float rn = which == 0 ? rsqrtf(ss + NORM_EPS) * 0.08838834764831845f : (which == 1 ? rsqrtf(ss + NORM_EPS) : 1.f);
#pragma unroll
            for (int ch = 0; ch < 8; ++ch) ov[ti][ch] *= rn; }
        __syncthreads();
        if (seg < 48) {
            const int a = (sc >> 3) & 1, g16 = sc & ~15;
            if (which == 0) {
#pragma unroll
                for (int ti = 0; ti < 8; ++ti) { const int t = 8 * trow + ti; const float e = egs[t];
                    *(LAS v4u*)(Qb + t * 136 + sc) = (v4u){pk2(ov[ti][0], ov[ti][1]), pk2(ov[ti][2], ov[ti][3]), pk2(ov[ti][4], ov[ti][5]), pk2(ov[ti][6], ov[ti][7])};
                    bf16* qd = (bf16*)(pk + PK_QD) + t * 136 + g16 + 4 * a;
                    *(GAS v2u*)qd = (v2u){pk2(ov[ti][0] * e, ov[ti][1] * e), pk2(ov[ti][2] * e, ov[ti][3] * e)};
                    *(GAS v2u*)(qd + 8) = (v2u){pk2(ov[ti][4] * e, ov[ti][5] * e), pk2(ov[ti][6] * e, ov[ti][7] * e)}; }
            } else if (which == 1) {
                float be[8], ek[8];
#pragma unroll
                for (int ti = 0; ti < 8; ++ti) { const int t = 8 * trow + ti; be[ti] = bts[t] * egs[t]; ek[ti] = eks[t];
                    *(LAS v4u*)(Kb + t * 136 + sc) = (v4u){pk2(ov[ti][0], ov[ti][1]), pk2(ov[ti][2], ov[ti][3]), pk2(ov[ti][4], ov[ti][5]), pk2(ov[ti][6], ov[ti][7])}; }
                const int ta = trow & 1, tg16 = (8 * trow) & ~15;
#pragma unroll
                for (int ch = 0; ch < 8; ++ch) {
                    *(LAS v4u*)(KBt + (sc + ch) * 72 + 8 * trow) = (v4u){pk2(ov[0][ch] * be[0], ov[1][ch] * be[1]), pk2(ov[2][ch] * be[2], ov[3][ch] * be[3]), pk2(ov[4][ch] * be[4], ov[5][ch] * be[5]), pk2(ov[6][ch] * be[6], ov[7][ch] * be[7])};
                    bf16* kd = (bf16*)(pk + PK_KDT) + (sc + ch) * 72 + tg16 + 4 * ta;
                    *(GAS v2u*)kd = (v2u){pk2(ov[0][ch] * ek[0], ov[1][ch] * ek[1]), pk2(ov[2][ch] * ek[2], ov[3][ch] * ek[3])};
                    *(GAS v2u*)(kd + 8) = (v2u){pk2(ov[4][ch] * ek[4], ov[5][ch] * ek[5]), pk2(ov[6][ch] * ek[6], ov[7][ch] * ek[7])}; }
            } else {
                float be[8];
#pragma unroll
                for (int ti = 0; ti < 8; ++ti) be[ti] = bts[8 * trow + ti];
#pragma unroll
                for (int ch = 0; ch < 8; ++ch)
                    *(LAS v4u*)(Vt + (sc + ch) * 72 + 8 * trow) = (v4u){pk2(ov[0][ch] * be[0], ov[1][ch] * be[1]), pk2(ov[2][ch] * be[2], ov[3][ch] * be[3]), pk2(ov[4][ch] * be[4], ov[5][ch] * be[5]), pk2(ov[6][ch] * be[6], ov[7][ch] * be[7])};
            }
        }
        __syncthreads();
        { const int kind = F.wave >> 2, mb = (F.wave >> 1) & 1, nb = F.wave & 1; const LAS bf16* Am = kind ? Qb : Kb; f32x16_ acc;
#pragma unroll
          for (int r = 0; r < 16; ++r) acc[r] = 0.f;
#pragma unroll
          for (int ks = 0; ks < 8; ++ks) { const bf16x8 a = *(const LAS bf16x8*)(Am + (32 * mb + i31) * 136 + 16 * ks + 8 * hh), b = *(const LAS bf16x8*)(Kb + (32 * nb + i31) * 136 + 16 * ks + 8 * hh);
              acc = __builtin_amdgcn_mfma_f32_32x32x16_bf16(a, b, acc, 0, 0, 0); }
          const int s = 32 * nb + i31; const float gs = gcs[s];
#pragma unroll
          for (int r = 0; r < 16; ++r) { const int c = 32 * mb + (r & 3) + 8 * (r >> 2) + 4 * hh; const float dec = expf(s <= c ? gcs[c] - gs : 0.f);
              if (kind == 0) As[c * 68 + s] = (s < c) ? bts[c] * acc[r] * dec : 0.f;
              else ((bf16*)(pk + PK_AQ))[c * 72 + swap23(s)] = (bf16)f2bf((s <= c) ? acc[r] * dec : 0.f); } }
        __syncthreads();
        if (F.wave < 4 && lane < 16) { const int b0 = 16 * F.wave; float tc[16];
#pragma unroll
            for (int i = 0; i < 16; ++i) { float a = (i == lane) ? 1.f : 0.f;
#pragma unroll
                for (int m = 0; m < i; ++m) a -= As[(b0 + i) * 68 + b0 + m] * tc[m];
                tc[i] = a; Tm[(b0 + i) * 68 + b0 + lane] = a; } }
        __syncthreads();
        { const int p = tid >> 8, o = tid & 255, r = o >> 4, cc = o & 15, rb = 16 + 32 * p, cbs = 32 * p; float a = 0.f;
#pragma unroll
          for (int m = 0; m < 16; ++m) a += As[(rb + r) * 68 + cbs + m] * Tm[(cbs + m) * 68 + cbs + cc];
          Tp[p * 256 + o] = a;
          __syncthreads();
          float b = 0.f;
#pragma unroll
          for (int m = 0; m < 16; ++m) b += Tm[(rb + r) * 68 + rb + m] * Tp[p * 256 + m * 16 + cc];
          __syncthreads();
          Tm[(rb + r) * 68 + cbs + cc] = -b; }
        __syncthreads();
        { float a[2];
#pragma unroll
          for (int q = 0; q < 2; ++q) { const int o = tid + 512 * q, r = o >> 5, cc = o & 31; a[q] = 0.f;
#pragma unroll 8
              for (int m = 0; m < 32; ++m) a[q] += As[(32 + r) * 68 + m] * Tm[m * 68 + cc]; }
          __syncthreads();
#pragma unroll
          for (int q = 0; q < 2; ++q) { const int o = tid + 512 * q; Tp[(o >> 5) * 36 + (o & 31)] = a[q]; }
          __syncthreads();
#pragma unroll
          for (int q = 0; q < 2; ++q) { const int o = tid + 512 * q, r = o >> 5, cc = o & 31; a[q] = 0.f;
#pragma unroll 8
              for (int m = 0; m < 32; ++m) a[q] += Tm[(32 + r) * 68 + 32 + m] * Tp[m * 36 + cc]; }
#pragma unroll
          for (int q = 0; q < 2; ++q) { const int o = tid + 512 * q; Tm[(32 + (o >> 5)) * 68 + (o & 31)] = -a[q]; } }
        __syncthreads();
        for (int idx = tid; idx < 64 * 32; idx += NTHR) { const int c = idx >> 5, s2 = (idx & 31) * 2; *(LAS unsigned*)(Tmb + c * 72 + s2) = pk2(Tm[c * 68 + s2], Tm[c * 68 + s2 + 1]); }
        __syncthreads();
        if (F.wave < 4) { const int cb = F.wave;
#pragma unroll
            for (int mb = 0; mb < 2; ++mb) { f32x16_ acc;
#pragma unroll
                for (int r = 0; r < 16; ++r) acc[r] = 0.f;
#pragma unroll
                for (int ks = 0; ks < 4; ++ks) { const bf16x8 a = *(const LAS bf16x8*)(Tmb + (32 * mb + i31) * 72 + 16 * ks + 8 * hh), b = *(const LAS bf16x8*)(Vt + (32 * cb + i31) * 72 + 16 * ks + 8 * hh);
                    acc = __builtin_amdgcn_mfma_f32_32x32x16_bf16(a, b, acc, 0, 0, 0); }
                float* up = ul + (cb * 64 + lane) * 32 + mb * 16;
#pragma unroll
                for (int q = 0; q < 4; ++q) *(GAS f32x4*)(up + 4 * q) = (f32x4){acc[4 * q], acc[4 * q + 1], acc[4 * q + 2], acc[4 * q + 3]}; }
        } else { const int db = F.wave - 4;
#pragma unroll
            for (int nb = 0; nb < 2; ++nb) { f32x16_ acc;
#pragma unroll
                for (int r = 0; r < 16; ++r) acc[r] = 0.f;
#pragma unroll
                for (int ks = 0; ks < 4; ++ks) { const bf16x8 a = *(const LAS bf16x8*)(KBt + (32 * db + i31) * 72 + 16 * ks + 8 * hh), b = *(const LAS bf16x8*)(Tmb + (32 * nb + i31) * 72 + 16 * ks + 8 * hh);
                    acc = __builtin_amdgcn_mfma_f32_32x32x16_bf16(a, b, acc, 0, 0, 0); }
                bf16* wp = (bf16*)(pk + PK_WN) + (32 * nb + i31) * 136 + 32 * db + 8 * hh;
#pragma unroll
                for (int q = 0; q < 4; ++q) *(GAS v2u*)(wp + 16 * (q >> 1) + 4 * (q & 1)) = (v2u){pk2(-acc[4 * q], -acc[4 * q + 1]), pk2(-acc[4 * q + 2], -acc[4 * q + 3])}; }
        }
    }
}
__device__ __forceinline__ void gdn_scan_helper(Frame& F) {
    const int hb = blockIdx.x - 8; if (hb < 0 || hb >= 16) return;
    const int h = hb & 7, par = hb >> 3;
    const unsigned char* PK = F.ws + WS_PK + (size_t)(h * NCHUNK) * PK_BYTES + F.tid * 16;
#pragma unroll 1
    for (int n = par; n < NCHUNK; n += 2) {
        if (n > 8) { unsigned spin = 0; while ((int)__hip_atomic_load(F.ctl + CW_SP + 64 * h, RLX_AGENT) + 8 < n && ++spin < (1u << 16)) __builtin_amdgcn_s_sleep(8); }
        v4u x[12]; const unsigned char* UL = F.ws + WS_UL + (size_t)(h * NCHUNK + n) * 32768 + F.tid * 16;
#pragma unroll
        for (int q = 0; q < 8; ++q) x[q] = *(const GAS v4u*)(PK + (size_t)n * PK_BYTES + q * 8192);
#pragma unroll
        for (int q = 0; q < 4; ++q) x[8 + q] = *(const GAS v4u*)(UL + q * 8192);
#pragma unroll
        for (int q = 0; q < 12; ++q) asm volatile("" :: "v"(x[q]));
    }
}
__device__ __forceinline__ void gdn_scan_v2(Frame& F) {
    if (blockIdx.x >= 8) return;
    const int h = blockIdx.x, lane = F.lane;
    const unsigned char* PK = F.ws + WS_PK + (size_t)(h * NCHUNK) * PK_BYTES;
    if (F.wave >= 4) {
        const int lw = F.wave - 4;
        bf16* ogb = (bf16*)(F.ws + WS_OG) + h * 128;
#pragma unroll 1
        for (int n = -1; n <= NCHUNK; ++n) {
            if (n + 1 < NCHUNK) { const unsigned char* src = PK + (size_t)(n + 1) * PK_BYTES + lane * 16; LAS unsigned char* dst = F.lds + ((n + 1) & 1) * PKL;
#pragma unroll
                for (int q = 0; q < 16; ++q) { const int p = lw + 4 * q; if (p < 61) __builtin_amdgcn_global_load_lds((const unsigned*)(src + p * 1024), (LAS unsigned*)(dst + p * 1024), 16, 0, 0); } }
            if (n >= 1) { const LAS unsigned char* ost = F.lds + OST_OFF + ((n - 1) & 1) * OST_BYTES;
#pragma unroll
                for (int it = 0; it < 4; ++it) { const int id = it * 64 + lane, row = 16 * lw + (id >> 4), c16 = id & 15;
                    const v4u v = *(const LAS v4u*)(ost + row * OST_P + c16 * 16);
                    *(GAS v4u*)(ogb + (size_t)((n - 1) * 64 + row) * 1024 + c16 * 8) = v; } }
            if (n == NCHUNK) break;
            if (n >= 1) asm volatile("s_waitcnt vmcnt(4) lgkmcnt(0)" ::: "memory");
            else asm volatile("s_waitcnt vmcnt(0) lgkmcnt(0)" ::: "memory");
            __builtin_amdgcn_s_barrier(); asm volatile("" ::: "memory");
        }
    } else {
        const int cb = F.wave, i31 = lane & 31, hh = lane >> 5;
        const float* GLg = (const float*)(F.ws + WS_GL);
        const float* ul = (const float*)(F.ws + WS_UL) + ((size_t)(h * NCHUNK) * 4 + cb) * 64 * 32 + lane * 32;
        f32x16 S[4], vn[2], O[2];
#pragma unroll
        for (int b = 0; b < 4; ++b)
#pragma unroll
            for (int r = 0; r < 16; ++r) S[b][r] = 0.f;
#pragma unroll
        for (int mb = 0; mb < 2; ++mb)
#pragma unroll
            for (int q = 0; q < 4; ++q) { const f32x4 v = *(const GAS f32x4*)(ul + mb * 16 + 4 * q); vn[mb][4 * q] = v.x; vn[mb][4 * q + 1] = v.y; vn[mb][4 * q + 2] = v.z; vn[mb][4 * q + 3] = v.w; }
        __builtin_amdgcn_s_barrier(); asm volatile("" ::: "memory");
#pragma unroll 1
        for (int n = 0; n < NCHUNK; ++n) {
            const LAS unsigned char* buf = F.lds + (n & 1) * PKL;
            const float gl = GLg[n * 8 + h];
            f32x16 un[2];
            { const float* unp = ul + (size_t)(n + 1 < NCHUNK ? n + 1 : n) * 4 * 64 * 32;
#pragma unroll
              for (int mb = 0; mb < 2; ++mb)
#pragma unroll
                  for (int q = 0; q < 4; ++q) { const f32x4 v = *(const GAS f32x4*)(unp + mb * 16 + 4 * q); un[mb][4 * q] = v.x; un[mb][4 * q + 1] = v.y; un[mb][4 * q + 2] = v.z; un[mb][4 * q + 3] = v.w; } }
            const LAS unsigned char* a136 = buf + i31 * 272 + hh * 16;
            const LAS unsigned char* a72 = buf + i31 * 144 + hh * 16;
            bf16x8 sf[8], fa[8], fb[8];
#define SC_LD136(dst, off, mb) do { _Pragma("unroll") for (int ks = 0; ks < 8; ++ks) dst[ks] = *(const LAS bf16x8*)(a136 + (off) + (mb) * 32 * 272 + ks * 32); } while (0)
            SC_LD136(fa, PK_WN, 0); SC_LD136(fb, PK_WN, 1);
#pragma unroll
            for (int b = 0; b < 4; ++b) { sf[2 * b] = cvt8(S[b], 0); sf[2 * b + 1] = cvt8(S[b], 1); }
#pragma unroll
            for (int ks = 0; ks < 8; ++ks) vn[0] = __builtin_amdgcn_mfma_f32_32x32x16_bf16(fa[ks], sf[ks], vn[0], 0, 0, 0);
            SC_LD136(fa, PK_QD, 0);
#pragma unroll
            for (int ks = 0; ks < 8; ++ks) vn[1] = __builtin_amdgcn_mfma_f32_32x32x16_bf16(fb[ks], sf[ks], vn[1], 0, 0, 0);
            SC_LD136(fb, PK_QD, 1);
#pragma unroll
            for (int mb = 0; mb < 2; ++mb)
#pragma unroll
                for (int r = 0; r < 16; ++r) O[mb][r] = 0.f;
#pragma unroll
            for (int ks = 0; ks < 8; ++ks) O[0] = __builtin_amdgcn_mfma_f32_32x32x16_bf16(fa[ks], sf[ks], O[0], 0, 0, 0);
#pragma unroll
            for (int q = 0; q < 8; ++q) fa[q] = *(const LAS bf16x8*)(a72 + PK_AQ + (q >> 2) * 32 * 144 + (q & 3) * 32);
#pragma unroll
            for (int ks = 0; ks < 8; ++ks) O[1] = __builtin_amdgcn_mfma_f32_32x32x16_bf16(fb[ks], sf[ks], O[1], 0, 0, 0);
#ifdef SCAN_PROBE
            { f32x16 dm = O[0];
#pragma unroll
              for (int rr = 0; rr < 3; ++rr)
#pragma unroll
                  for (int ks = 0; ks < 8; ++ks) dm = __builtin_amdgcn_mfma_f32_32x32x16_bf16(fb[ks], sf[ks], dm, 0, 0, 0);
              asm volatile("" :: "v"(dm)); }
#endif
#pragma unroll
            for (int q = 0; q < 8; ++q) fb[q] = *(const LAS bf16x8*)(a72 + PK_KDT + (q >> 2) * 32 * 144 + (q & 3) * 32);
            bf16x8 vf[4];
#pragma unroll
            for (int mb = 0; mb < 2; ++mb) { vf[2 * mb] = cvt8(vn[mb], 0); vf[2 * mb + 1] = cvt8(vn[mb], 1); }
            vn[0] = un[0]; vn[1] = un[1];
#pragma unroll
            for (int q = 0; q < 8; ++q) O[q >> 2] = __builtin_amdgcn_mfma_f32_32x32x16_bf16(fa[q], vf[q & 3], O[q >> 2], 0, 0, 0);
#pragma unroll
            for (int q = 0; q < 8; ++q) fa[q] = *(const LAS bf16x8*)(a72 + PK_KDT + (2 + (q >> 2)) * 32 * 144 + (q & 3) * 32);
            if (cb == 0 && lane == 0) __hip_atomic_store(F.ctl + CW_SP + 64 * h, (unsigned)(n + 1), RLX_AGENT);
#pragma unroll
            for (int b = 0; b < 2; ++b) { S[b] = S[b] * gl;
#pragma unroll
                for (int ks = 0; ks < 4; ++ks) S[b] = __builtin_amdgcn_mfma_f32_32x32x16_bf16(fb[4 * b + ks], vf[ks], S[b], 0, 0, 0); }
            { LAS bf16* ost = (LAS bf16*)(F.lds + OST_OFF + (n & 1) * OST_BYTES) + cb * 32 + i31;
#pragma unroll
              for (int mb = 0; mb < 2; ++mb)
#pragma unroll
                  for (int r = 0; r < 16; ++r) ost[(32 * mb + (r & 3) + 8 * (r >> 2) + 4 * hh) * (OST_P / 2)] = (bf16)(pk2(O[mb][r], 0.f) & 0xffffu); }
#pragma unroll
            for (int b = 2; b < 4; ++b) { S[b] = S[b] * gl;
#pragma unroll
                for (int ks = 0; ks < 4; ++ks) S[b] = __builtin_amdgcn_mfma_f32_32x32x16_bf16(fa[4 * (b - 2) + ks], vf[ks], S[b], 0, 0, 0); }
#undef SC_LD136
            asm volatile("s_waitcnt lgkmcnt(0)" ::: "memory"); __builtin_amdgcn_s_barrier(); asm volatile("" ::: "memory");
        }
    }
}
__device__ __forceinline__ void gdn_norm(Frame& F) {
    const bf16* og = (const bf16*)(F.ws + WS_OG); const bf16* Pz = (const bf16*)(F.ws + WS_P) + 6 * PBUF; bf16* yb = (bf16*)(F.ws + WS_YB);
    const int lane = F.lane, col = lane * 16;
    for (int tok = F.vcu * NWAVES + F.wave; tok < T; tok += F.G * NWAVES) {
        const size_t o = (size_t)tok * 1024 + col; float v[16], ss = 0.f;
        { const v4u x0 = *(const GAS v4u*)(og + o), x1 = *(const GAS v4u*)(og + o + 8); const unsigned xw[8] = {x0.x, x0.y, x0.z, x0.w, x1.x, x1.y, x1.z, x1.w};
#pragma unroll
          for (int q = 0; q < 8; ++q) { v[2 * q] = bflo(xw[q]); v[2 * q + 1] = bfhi(xw[q]); ss += v[2 * q] * v[2 * q] + v[2 * q + 1] * v[2 * q + 1]; } }
        ss += __shfl_xor(ss, 1); ss += __shfl_xor(ss, 2); ss += __shfl_xor(ss, 4);
        const float r = rsqrtf(ss * (1.f / 128.f) + NORM_EPS);
        const v4u z0 = *(const GAS v4u*)(Pz + o), z1 = *(const GAS v4u*)(Pz + o + 8);
        const float zz[16] = {bflo(z0.x), bfhi(z0.x), bflo(z0.y), bfhi(z0.y), bflo(z0.z), bfhi(z0.z), bflo(z0.w), bfhi(z0.w), bflo(z1.x), bfhi(z1.x), bflo(z1.y), bfhi(z1.y), bflo(z1.z), bfhi(z1.z), bflo(z1.w), bfhi(z1.w)};
        unsigned w[8];
#pragma unroll
        for (int x = 0; x < 8; ++x) { const int c0 = (col & 127) + 2 * x; w[x] = pk2(v[2 * x] * r * F.in[5][c0] * siluf_(zz[2 * x]), v[2 * x + 1] * r * F.in[5][c0 + 1] * siluf_(zz[2 * x + 1])); }
        *(GAS v4u*)(yb + o) = (v4u){w[0], w[1], w[2], w[3]}; *(GAS v4u*)(yb + o + 8) = (v4u){w[4], w[5], w[6], w[7]};
    }
}

__device__ __forceinline__ void ln_router(Frame& F) {
    constexpr int XS = 2052;
    LAS float* X1s = (LAS float*)F.lds;
    LAS float* LG = (LAS float*)(F.lds + 131584);
    LAS int* hist = (LAS int*)(LG + 1024);
    LAS int* gbs = hist + 64;
    const float* y1 = (const float*)(F.ws + WS_Y1); float* x1f = (float*)(F.ws + WS_X1F); bf16* x1b = (bf16*)(F.ws + WS_X1B);
    int* tokl = (int*)(F.ws + WS_TOKL); float* wgtl = (float*)(F.ws + WS_WGTL); unsigned* info = (unsigned*)(F.ws + WS_INFO);
    const float* g1 = F.in[12]; const float* b1 = F.in[13]; const float* wr = F.in[14]; const float* rb = F.in[15];
    const int tid = F.tid, lane = F.lane;
    for (int blk = blockIdx.x; blk < T / 16; blk += F.G) {
        const int tb = blk * 16;
        __syncthreads();
        if (tid < 64) hist[tid] = 0;
        for (int rep8 = 0; rep8 < (DUP_PHASE == 8 ? 2 : 1); ++rep8) { if (rep8) __syncthreads();
#pragma unroll 1
        for (int tt = 0; tt < 2; ++tt) { const int tl = F.wave * 2 + tt, tok = tb + tl;
            const GAS f32x4* yr = (const GAS f32x4*)(y1 + (size_t)tok * D) + lane; f32x4 v[8]; float s = 0.f;
#pragma unroll
            for (int j = 0; j < 8; ++j) { v[j] = yr[64 * j]; s += (v[j].x + v[j].y) + (v[j].z + v[j].w); }
            const float mean = wave_sum(s) * (1.f / D); float s2 = 0.f;
#pragma unroll
            for (int j = 0; j < 8; ++j) { v[j] = v[j] - mean; s2 += (v[j].x * v[j].x + v[j].y * v[j].y) + (v[j].z * v[j].z + v[j].w * v[j].w); }
            const float rstd = rsqrtf(wave_sum(s2) * (1.f / D) + LN_EPS);
#pragma unroll
            for (int j = 0; j < 8; ++j) { const int col = j * 256 + lane * 4; const f32x4 gg = *(const GAS f32x4*)(g1 + col), bb = *(const GAS f32x4*)(b1 + col);
                const f32x4 xo = v[j] * rstd * gg + bb;
                *(GAS f32x4*)(x1f + (size_t)tok * D + col) = xo; *(GAS v2u*)(x1b + (size_t)tok * D + col) = (v2u){pk2(xo.x, xo.y), pk2(xo.z, xo.w)};
                *(LAS f32x4*)(X1s + tl * XS + col) = xo; }
            if (lane == 0) { tokl[NE * T + tok] = tok; wgtl[NE * T + tok] = 1.f; } }
        __syncthreads();
        { const int eg = lane & 15, tg = lane >> 4; f32x4 acc[4];
#pragma unroll
          for (int ti = 0; ti < 4; ++ti) acc[ti] = (f32x4){0.f, 0.f, 0.f, 0.f};
          const float* wp = wr + (size_t)(256 * F.wave) * NE + 4 * eg; const LAS float* xp = X1s + (4 * tg) * XS + 256 * F.wave;
#pragma unroll 4
          for (int d0 = 0; d0 < 256; d0 += 4) { f32x4 xv[4], wv[4];
#pragma unroll
              for (int dd = 0; dd < 4; ++dd) wv[dd] = *(const GAS f32x4*)(wp + (size_t)(d0 + dd) * NE);
#pragma unroll
              for (int ti = 0; ti < 4; ++ti) xv[ti] = *(const LAS f32x4*)(xp + ti * XS + d0);
#pragma unroll
              for (int ti = 0; ti < 4; ++ti) { acc[ti] = acc[ti] + wv[0] * xv[ti].x; acc[ti] = acc[ti] + wv[1] * xv[ti].y; acc[ti] = acc[ti] + wv[2] * xv[ti].z; acc[ti] = acc[ti] + wv[3] * xv[ti].w; } }
          __syncthreads();
#pragma unroll
          for (int ti = 0; ti < 4; ++ti) *(LAS f32x4*)(X1s + ((F.wave * 16 + 4 * tg + ti) * 64 + 4 * eg)) = acc[ti];
          __syncthreads();
          { const int o = tid * 2; float a0 = 0.f, a1 = 0.f;
#pragma unroll
            for (int w = 0; w < 8; ++w) { const f32x2 p = *(const LAS f32x2*)(X1s + w * 1024 + o); a0 += p.x; a1 += p.y; }
            LG[o] = a0; LG[o + 1] = a1; } }
        __syncthreads();
        }
        bool sel[2]; int loc[2]; float wsl[2]; unsigned long long msk[2];
#pragma unroll
        for (int tt = 0; tt < 2; ++tt) { const int tl = F.wave * 2 + tt;
            const float score = 1.f / (1.f + expf(-LG[tl * 64 + lane])), ch = score + rb[lane];
            int rk = 0;
#pragma unroll
            for (int x = 1; x < 8; ++x) { const float cj = __shfl_xor(ch, x); rk += (cj > ch || (cj == ch && (lane ^ x) < lane)) ? 1 : 0; }
            float gs = rk < 2 ? ch : 0.f; gs += __shfl_xor(gs, 1); gs += __shfl_xor(gs, 2); gs += __shfl_xor(gs, 4);
            const int g = lane >> 3; int grk = 0;
#pragma unroll
            for (int x = 1; x < 8; ++x) { const float gj = __shfl_xor(gs, 8 * x); grk += (gj > gs || (gj == gs && (g ^ x) < g)) ? 1 : 0; }
            const float mk = grk < 4 ? ch : -INFINITY; int erk = 0;
#pragma unroll
            for (int j = 0; j < 64; ++j) { const float mj = __builtin_bit_cast(float, __builtin_amdgcn_readlane(__builtin_bit_cast(int, mk), j)); erk += (mj > mk || (mj == mk && j < lane)) ? 1 : 0; }
            sel[tt] = (grk < 4) && (erk < TOPK);
            const float ssum = wave_sum(sel[tt] ? score : 0.f); wsl[tt] = score / ssum * ROUTED_SCALE;
            msk[tt] = __ballot(sel[tt]);
            loc[tt] = sel[tt] ? atomicAdd((int*)&hist[lane], 1) : 0; }
        __syncthreads();
        if (tid < 64) { const int hc = hist[tid]; gbs[tid] = hc ? (int)__hip_atomic_fetch_add(F.ctl + CW_CNT + 64 * tid, (unsigned)hc, RLX_AGENT) : 0; }
        __syncthreads();
#pragma unroll
        for (int tt = 0; tt < 2; ++tt) if (sel[tt]) { const int tok = tb + F.wave * 2 + tt, slot = gbs[lane] + loc[tt];
            tokl[lane * T + slot] = tok; wgtl[lane * T + slot] = wsl[tt];
            const int k = __popcll(msk[tt] & ((1ull << lane) - 1ull)); info[tok * 8 + k] = ((unsigned)lane << 16) | (unsigned)slot; info[T * 8 + tok * 8 + k] = __builtin_bit_cast(unsigned, wsl[tt]); }
    }
}
__device__ __forceinline__ void final_ln(Frame& F) {
    moe_tables(F, 0, 0);
    const LAS int* rbase = (const LAS int*)(F.lds + LDS_TAB) + 72;
    const float* x1f = (const float*)(F.ws + WS_X1F); const bf16* yas = (const bf16*)(F.ws + WS_YAS); const unsigned* info = (const unsigned*)(F.ws + WS_INFO);
    const float* g2 = F.in[22]; const float* b2 = F.in[23];
    const int lane = F.lane;
    for (int tok = F.vcu * NWAVES + F.wave; tok < T; tok += F.G * NWAVES) {
        f32x4 v[8];
        const GAS f32x4* xr = (const GAS f32x4*)(x1f + (size_t)tok * D) + lane;
#pragma unroll
        for (int j = 0; j < 8; ++j) v[j] = xr[64 * j] * ALPHA;
        const v4u i0 = *(const GAS v4u*)(info + tok * 8), i1 = *(const GAS v4u*)(info + tok * 8 + 4);
        const unsigned iw[8] = {i0.x, i0.y, i0.z, i0.w, i1.x, i1.y, i1.z, i1.w};
        int rows[9];
#pragma unroll
        for (int k = 0; k < 8; ++k) rows[k] = rbase[iw[k] >> 16] + (int)(iw[k] & 0xffffu);
        rows[8] = 65536 + tok;
        const v4u g0 = *(const GAS v4u*)(info + T * 8 + tok * 8), g1 = *(const GAS v4u*)(info + T * 8 + tok * 8 + 4);
        const float gw[9] = {__builtin_bit_cast(float, g0.x), __builtin_bit_cast(float, g0.y), __builtin_bit_cast(float, g0.z), __builtin_bit_cast(float, g0.w), __builtin_bit_cast(float, g1.x), __builtin_bit_cast(float, g1.y), __builtin_bit_cast(float, g1.z), __builtin_bit_cast(float, g1.w), 1.f};
#pragma unroll
        for (int kb = 0; kb < 3; ++kb) { v2u w[3][8];
#pragma unroll
            for (int kk = 0; kk < 3; ++kk) { const GAS v2u* yr = (const GAS v2u*)(yas + (size_t)rows[3 * kb + kk] * D) + lane;
#pragma unroll
                for (int j = 0; j < 8; ++j) w[kk][j] = yr[64 * j]; }
#pragma unroll
            for (int kk = 0; kk < 3; ++kk)
#pragma unroll
                for (int j = 0; j < 8; ++j) v[j] = v[j] + (f32x4){bflo(w[kk][j].x), bfhi(w[kk][j].x), bflo(w[kk][j].y), bfhi(w[kk][j].y)}; }
        float s = 0.f;
#pragma unroll
        for (int j = 0; j < 8; ++j) s += (v[j].x + v[j].y) + (v[j].z + v[j].w);
        const float mean = wave_sum(s) * (1.f / D); float s2 = 0.f;
#pragma unroll
        for (int j = 0; j < 8; ++j) { v[j] = v[j] - mean; s2 += (v[j].x * v[j].x + v[j].y * v[j].y) + (v[j].z * v[j].z + v[j].w * v[j].w); }
        const float rstd = rsqrtf(wave_sum(s2) * (1.f / D) + LN_EPS);
#pragma unroll
        for (int j = 0; j < 8; ++j) { const int col = j * 256 + lane * 4; const f32x4 gg = *(const GAS f32x4*)(g2 + col), bb = *(const GAS f32x4*)(b2 + col);
            *(GAS f32x4*)(F.out + (size_t)tok * D + col) = v[j] * rstd * gg + bb; }
    }
}

struct Args { const float* in[24]; float* out; unsigned char* ws; int ph_lo, ph_hi; };
__global__ void __launch_bounds__(NTHR, 2) fwd(Args args) {
    extern __shared__ __attribute__((aligned(16))) unsigned char lds[];
    Frame F;
    F.lds = (LAS unsigned char*)lds;
    F.tid = threadIdx.x; F.lane = F.tid & 63; F.wave = __builtin_amdgcn_readfirstlane(F.tid >> 6);
    F.G = gridDim.x; { const int bx = blockIdx.x; F.vcu = (F.G % 8 == 0) ? (bx % 8) * (F.G / 8) + bx / 8 : bx; }
    F.ws = args.ws; F.ctl = (gu32*)(args.ws + WS_CTL); F.out = args.out;
#pragma unroll
    for (int i = 0; i < 24; ++i) F.in[i] = args.in[i];
    volatile LAS unsigned* MISC = (volatile LAS unsigned*)(F.lds + MISC_OFF);
    if (F.tid < 64) MISC[F.tid] = 0u;
    __syncthreads();
    const int lo = args.ph_lo, hi = args.ph_hi;
    const bool multi = (hi - lo) > 1;
    XcdBarrier bar; bar.bar = (unsigned*)(F.ctl + CW_BAR); bar.x = 0; bar.st = nullptr;
    if (multi) bar = xcd_barrier_post((unsigned*)(F.ctl + CW_BAR), MISC + 8);
#ifndef ONLY_PHASE
#define ONLY_PHASE -1
#endif
#define IN(k) ((ONLY_PHASE < 0 || ONLY_PHASE == (k)) && lo <= (k) && (k) < hi)
#define SEAM(k) do { if (IN(k) && IN((k) + 1)) xcd_barrier(bar); } while (0)
    unsigned char* ws = args.ws;
#define DUPBAR() do { VM_WAIT(); if (multi) xcd_barrier(bar); else __syncthreads(); } while (0)
    if (IN(0)) { p0_prologue(F); if (DUP_PHASE == 0) { __syncthreads(); p0_prologue(F); } SEAM(0); }
    if (IN(1)) {

        pg8::Gemm g{(const bf16*)(ws + WS_XB), (const bf16*)(ws + WS_WIN), T, NPROJ, D}; pg8::StaticOrder S; S.init(T, NPROJ, F.G, (int)blockIdx.x);
        EpiProj E{(bf16*)(ws + WS_P)};
        pg8::gemm_phase<EpiProj, pg8::StaticOrder, true, false>(F.lds, g, S, E);
        if (DUP_PHASE == 1) { VM_WAIT(); __syncthreads(); pg8::gemm_phase<EpiProj, pg8::StaticOrder, true, false>(F.lds, g, S, E); }
        if ((int)blockIdx.x >= 128 && F.G == 256) p0_items(F, P0_NITEMS - P1_TAIL_ITEMS, P0_NITEMS, ((int)blockIdx.x - 128) * NWAVES + F.wave, 128 * NWAVES);
        else if (F.G != 256) p0_items(F, P0_NITEMS - P1_TAIL_ITEMS, P0_NITEMS, F.vcu * NWAVES + F.wave, F.G * NWAVES);
        SEAM(1);
    }
    if (IN(2)) { gdn_prep_v2(F); if (DUP_PHASE == 2) { __syncthreads(); gdn_prep_v2(F); } SEAM(2); }
    if (IN(3)) { gdn_scan_v2(F); gdn_scan_helper(F); __syncthreads(); attn_v2<0>(F); if (DUP_PHASE == 3) { xcd_barrier(bar); attn_v2<64>(F); } SEAM(3); }
    if (IN(4)) { gdn_norm(F); if (DUP_PHASE == 4) { __syncthreads(); gdn_norm(F); } SEAM(4); }
    if (IN(6)) {

        { pg8::Gemm g{(const bf16*)(ws + WS_YA), (const bf16*)(ws + WS_WA), T, D, 1024}; pg8::StaticOrder S; S.init(T, D, F.G, (int)blockIdx.x);
          EpiBranch<0> E{(const bf16*)(ws + WS_P) + 7 * PBUF, (float*)(ws + WS_TMP), (bf16*)(ws + WS_MRG)};
          pg8::gemm_phase<EpiBranch<0>, pg8::StaticOrder, true, false>(F.lds, g, S, E); }
        VM_WAIT(); __syncthreads();
        { pg8::Gemm g{(const bf16*)(ws + WS_YB), (const bf16*)(ws + WS_WB), T, D, 1024}; pg8::StaticOrder S; S.init(T, D, F.G, (int)blockIdx.x);
          EpiBranch<1> E{(const bf16*)(ws + WS_P) + 9 * PBUF, (float*)(ws + WS_TMP), (bf16*)(ws + WS_MRG)};
          pg8::gemm_phase<EpiBranch<1>, pg8::StaticOrder, true, false>(F.lds, g, S, E); }
        SEAM(6);
    }
    if (IN(7)) {

        pg8::Gemm g{(const bf16*)(ws + WS_MRG), (const bf16*)(ws + WS_WO), T, D, D}; pg8::StaticOrder S; S.init(T, D, F.G, (int)blockIdx.x);
        EpiOut E{F.in[0], (float*)(ws + WS_Y1)};
        pg8::gemm_phase<EpiOut, pg8::StaticOrder, true, false>(F.lds, g, S, E);
        if (DUP_PHASE == 7) { VM_WAIT(); __syncthreads(); pg8::gemm_phase<EpiOut, pg8::StaticOrder, true, false>(F.lds, g, S, E); }
        SEAM(7);
    }
    if (IN(8)) { ln_router(F); SEAM(8); }
    if (IN(9)) {

        moe_tables(F, 4, 1024);
        MoeOrder S{(const LAS int*)(F.lds + LDS_TAB + 1024), (const int*)(ws + WS_TOKL)};
        pg8::Gemm g{(const bf16*)(ws + WS_X1B), (const bf16*)(ws + WS_WGU), T, 1024, D};
        EpiGU E{(bf16*)(ws + WS_HB)};
        pg8::gemm_phase<EpiGU, MoeOrder, true, true>(F.lds, g, S, E);
        if (DUP_PHASE == 9) { VM_WAIT(); __syncthreads(); pg8::gemm_phase<EpiGU, MoeOrder, true, true>(F.lds, g, S, E); }
        SEAM(9);
    }
    if (IN(10)) {

        moe_tables(F, 8, D);
        MoeOrder S{(const LAS int*)(F.lds + LDS_TAB + 1024), (const int*)(ws + WS_TOKL)};
        pg8::Gemm g{(const bf16*)(ws + WS_HB), (const bf16*)(ws + WS_WD), T, D, FF};
        EpiDown E{(bf16*)(ws + WS_YAS), (const float*)(ws + WS_WGTL)};
        pg8::gemm_phase<EpiDown, MoeOrder, true, false>(F.lds, g, S, E);
        if (DUP_PHASE == 10) { VM_WAIT(); __syncthreads(); pg8::gemm_phase<EpiDown, MoeOrder, true, false>(F.lds, g, S, E); }
        SEAM(10);
    }
    if (IN(11)) { final_ln(F); if (DUP_PHASE == 11) { VM_WAIT(); __syncthreads(); final_ln(F); } }
#undef IN
#undef SEAM
}

extern "C" void kernel_launch(void* const* d_in, const int* in_sizes, int n_in, void* d_out, int out_size, void* d_ws, size_t ws_size, hipStream_t stream) {
    static int grid = 0;
    if (grid == 0) {
        if (n_in != 24 || in_sizes[0] != T * D || out_size != T * D || ws_size < WS_END) { fprintf(stderr, "kernel_launch: unexpected shapes (n_in %d, ws %zu); nothing launched\n", n_in, ws_size); grid = -1; return; }
        int dev = 0, cus = 0, per_cu = 0;
        if (hipGetDevice(&dev) != hipSuccess || hipDeviceGetAttribute(&cus, hipDeviceAttributeMultiprocessorCount, dev) != hipSuccess) { grid = -1; return; }
        if (hipFuncSetAttribute((const void*)fwd, hipFuncAttributeMaxDynamicSharedMemorySize, LDS_BYTES) != hipSuccess) { fprintf(stderr, "kernel_launch: hipFuncSetAttribute failed\n"); grid = -1; return; }
        if (hipOccupancyMaxActiveBlocksPerMultiprocessor(&per_cu, (const void*)fwd, NTHR, LDS_BYTES) != hipSuccess || per_cu < 1) { fprintf(stderr, "kernel_launch: occupancy query says %d\n", per_cu); }
        (void)hipGetLastError();
        grid = cus;
    }
    if (grid < 0) return;
    if (hipMemsetAsync((char*)d_ws + WS_CTL, 0, CTL_ZERO_BYTES, stream) != hipSuccess) return;
    Args a{};
    for (int i = 0; i < 24; ++i) a.in[i] = (const float*)d_in[i];
    a.out = (float*)d_out; a.ws = (unsigned char*)d_ws;
#if MK_N_LAUNCHES == 1
    a.ph_lo = 0; a.ph_hi = NPHASE;
    hipLaunchKernelGGL(fwd, dim3(grid), dim3(NTHR), LDS_BYTES, stream, a);
#else
    for (int p = 0; p < NPHASE; ++p) { a.ph_lo = p; a.ph_hi = p + 1; hipLaunchKernelGGL(fwd, dim3(grid), dim3(NTHR), LDS_BYTES, stream, a); }
#endif
}
```
